# Optimizing an MI355X kernel written in HIP

```python
import jax, jax.numpy as jnp
from jax import lax
import numpy as np

D_MODEL = 1024
BATCH = 1
SEQ = 16384
DEPTH = 2

N_A_LAYERS = DEPTH // 2
N_B_LAYERS = DEPTH - N_A_LAYERS
EXPAND = 2
D_INNER = EXPAND * D_MODEL
RMS_EPS = 1e-6
GLA_HEADS = 4
GLA_DK = D_MODEL // 2
GLA_DK_HEAD = GLA_DK // GLA_HEADS
GLA_DV_HEAD = D_INNER // GLA_HEADS
GLA_GATE_RANK = 16
GLA_GATE_TAU = 16.0
GLA_CHUNK = 64
A_IN = 2 * GLA_DK + 2 * D_INNER + GLA_GATE_RANK
DIL_GROUPS = ((128, 1), (512, 4), (2048, 16))
N_GROUPS = len(DIL_GROUPS)
DIL_HEADS = 16
DIL_HEAD_DIM = D_INNER // DIL_HEADS
DIL_BLOCK = 128
ALIBI_MAX_EXP = 8.0
B_IN = N_GROUPS * D_INNER + D_INNER
KV_OUT = 2 * N_GROUPS * D_INNER

kernel_name = "yoco_gla_dilated_alibi_hybrid"


def rmsnorm(x, g):
    xf = x.astype(jnp.float32)
    y = xf * lax.rsqrt(jnp.mean(xf * xf, axis=-1, keepdims=True) + RMS_EPS)
    return (y * g.astype(jnp.float32)).astype(x.dtype)


def gla_mixer(h, w_in, w_gate_up, b_gate, g_out, w_out):
    B, S, _ = h.shape
    H, dk, dv, C = GLA_HEADS, GLA_DK_HEAD, GLA_DV_HEAD, GLA_CHUNK
    n = S // C
    proj = h @ w_in
    q, k, v, z, lr = jnp.split(proj, [GLA_DK, 2 * GLA_DK, 2 * GLA_DK + D_INNER, 2 * GLA_DK + 2 * D_INNER], axis=-1)
    log_a = jax.nn.log_sigmoid((lr @ w_gate_up + b_gate).astype(jnp.float32)) / GLA_GATE_TAU

    def chunks(t, d):
        return t.astype(jnp.float32).reshape(B, n, C, H, d).transpose(1, 0, 3, 2, 4)

    qc = chunks(q, dk) * (dk ** -0.5)
    kc, vc, gc = chunks(k, dk), chunks(v, dv), chunks(log_a, dk)
    causal = jnp.tril(jnp.ones((C, C), dtype=bool))

    def step(state, inp):
        qi, ki, vi, gi = inp
        b = jnp.cumsum(gi, axis=2)
        o_inter = jnp.einsum('bhtk,bhkv->bhtv', qi * jnp.exp(b), state)
        diff = b[:, :, :, None, :] - b[:, :, None, :, :]
        decay = jnp.exp(jnp.where(causal[None, None, :, :, None], diff, -jnp.inf))
        attn = jnp.einsum('bhtk,bhsk,bhtsk->bhts', qi, ki, decay)
        o_intra = jnp.einsum('bhts,bhsv->bhtv', attn, vi)
        b_last = b[:, :, -1:, :]
        k_dec = ki * jnp.exp(b_last - b)
        new_state = jnp.exp(b_last[:, :, 0, :])[..., None] * state + jnp.einsum('bhsk,bhsv->bhkv', k_dec, vi)
        return new_state, o_inter + o_intra

    state0 = jnp.zeros((B, H, dk, dv), jnp.float32)
    _, o = lax.scan(step, state0, (qc, kc, vc, gc))
    o = o.transpose(1, 0, 3, 2, 4).reshape(B, S, H, dv)
    o = o * lax.rsqrt(jnp.mean(o * o, axis=-1, keepdims=True) + RMS_EPS) * g_out.astype(jnp.float32)
    o = o.reshape(B, S, D_INNER) * jax.nn.silu(z.astype(jnp.float32))
    return o.astype(h.dtype) @ w_out


def dilated_group(q, k, v, slopes, window, dilation):
    B, S, H, Dh = q.shape
    d = dilation
    n_steps = window // d
    L = S // d
    blk = DIL_BLOCK
    nb = -(-L // blk)
    Lp = nb * blk

    def to_sub(t):
        t = t.astype(jnp.float32).reshape(B, L, d, H, Dh).transpose(0, 2, 1, 3, 4).reshape(B * d, L, H, Dh)
        return jnp.pad(t, ((0, 0), (0, Lp - L), (0, 0), (0, 0)))

    qs, ks, vs = to_sub(q), to_sub(k), to_sub(v)
    qb = qs.reshape(B * d, nb, blk, H, Dh)

    def band(t):
        tp = jnp.pad(t, ((0, 0), (blk, 0), (0, 0), (0, 0)))
        prev = tp[:, :Lp].reshape(B * d, nb, blk, H, Dh)
        return jnp.concatenate([prev, t.reshape(B * d, nb, blk, H, Dh)], axis=2)

    kb, vb = band(ks), band(vs)
    s = jnp.einsum('znqhd,znkhd->znhqk', qb, kb) * (Dh ** -0.5)
    qi = jnp.arange(blk)[:, None]
    ki = jnp.arange(2 * blk)[None, :]
    delta = qi + blk - ki
    key_pos = jnp.arange(nb)[:, None, None] * blk - blk + ki[None]
    valid = (delta >= 0)[None] & (delta <= n_steps)[None] & (key_pos >= 0)
    bias = -slopes[:, None, None] * (delta * d).astype(jnp.float32)[None]
    s = jnp.where(valid[None, :, None], s + bias[None, None], -jnp.inf)
    m = jnp.max(s, axis=-1, keepdims=True)
    p = jnp.exp(s - m)
    l = jnp.sum(p, axis=-1, keepdims=True)
    o = jnp.einsum('znhqk,znkhd->znhqd', p, vb) / l
    lse = (m + jnp.log(l))[..., 0]
    o = o.transpose(0, 1, 3, 2, 4).reshape(B * d, Lp, H, Dh)[:, :L]
    o = o.reshape(B, d, L, H, Dh).transpose(0, 2, 1, 3, 4).reshape(B, S, H, Dh)
    lse = lse.transpose(0, 1, 3, 2).reshape(B * d, Lp, H)[:, :L]
    lse = lse.reshape(B, d, L, H).transpose(0, 2, 1, 3).reshape(B, S, H)
    return o, lse


def dilated_mixer(h, w_in, k_shared, v_shared, w_out):
    B, S, _ = h.shape
    proj = h @ w_in
    qs = proj[..., :N_GROUPS * D_INNER].reshape(B, S, N_GROUPS, DIL_HEADS, DIL_HEAD_DIM)
    z = proj[..., N_GROUPS * D_INNER:]
    n_all = N_GROUPS * DIL_HEADS
    slopes = (2.0 ** (-ALIBI_MAX_EXP * (jnp.arange(n_all, dtype=jnp.float32) + 1.0) / n_all)).reshape(N_GROUPS, DIL_HEADS)
    outs, lses = [], []
    for g, (window, dilation) in enumerate(DIL_GROUPS):
        o_g, lse_g = dilated_group(qs[:, :, g], k_shared[:, :, g], v_shared[:, :, g], slopes[g], window, dilation)
        outs.append(o_g)
        lses.append(lse_g)
    wts = jax.nn.softmax(jnp.stack(lses, axis=0), axis=0)
    o = jnp.sum(wts[..., None] * jnp.stack(outs, axis=0), axis=0)
    o = o.reshape(B, S, D_INNER) * jax.nn.silu(z.astype(jnp.float32))
    return o.astype(h.dtype) @ w_out


def setup_inputs(seed: int = 0) -> dict:
    key = jax.random.key(seed)
    ks = jax.random.split(key, 14)
    f32 = jnp.float32
    nrm = lambda k, shape, fan: jax.random.normal(k, shape, f32) * (fan ** -0.5)
    return {
        "x": jax.random.normal(ks[0], (BATCH, SEQ, D_MODEL), f32),
        "a_norm": 1.0 + 0.02 * jax.random.normal(ks[1], (N_A_LAYERS, D_MODEL), f32),
        "a_w_in": nrm(ks[2], (N_A_LAYERS, D_MODEL, A_IN), D_MODEL),
        "a_w_gate_up": nrm(ks[3], (N_A_LAYERS, GLA_GATE_RANK, GLA_DK), GLA_GATE_RANK),
        "a_b_gate": 0.1 * jax.random.normal(ks[4], (N_A_LAYERS, GLA_DK), f32),
        "a_g_out": 1.0 + 0.02 * jax.random.normal(ks[5], (N_A_LAYERS, GLA_DV_HEAD), f32),
        "a_w_out": nrm(ks[6], (N_A_LAYERS, D_INNER, D_MODEL), D_INNER),
        "kv_norm": 1.0 + 0.02 * jax.random.normal(ks[7], (D_MODEL,), f32),
        "w_kv": nrm(ks[8], (D_MODEL, KV_OUT), D_MODEL),
        "b_norm": 1.0 + 0.02 * jax.random.normal(ks[9], (N_B_LAYERS, D_MODEL), f32),
        "b_w_in": nrm(ks[10], (N_B_LAYERS, D_MODEL, B_IN), D_MODEL),
        "b_w_out": nrm(ks[11], (N_B_LAYERS, D_INNER, D_MODEL), D_INNER),
        "final_norm": 1.0 + 0.02 * jax.random.normal(ks[12], (D_MODEL,), f32),
    }


def reference(x, a_norm, a_w_in, a_w_gate_up, a_b_gate, a_g_out, a_w_out, kv_norm, w_kv, b_norm, b_w_in, b_w_out, final_norm):
    B, S, _ = x.shape
    k_shared = None
    v_shared = None
    for i in range(DEPTH):
        if i < N_A_LAYERS:
            h = rmsnorm(x, a_norm[i])
            x = x + gla_mixer(h, a_w_in[i], a_w_gate_up[i], a_b_gate[i], a_g_out[i], a_w_out[i])
            if i == N_A_LAYERS - 1:
                kv = (rmsnorm(x, kv_norm) @ w_kv).reshape(B, S, 2, N_GROUPS, DIL_HEADS, DIL_HEAD_DIM)
                k_shared, v_shared = kv[:, :, 0], kv[:, :, 1]
        else:
            j = i - N_A_LAYERS
            h = rmsnorm(x, b_norm[j])
            x = x + dilated_mixer(h, b_w_in[j], k_shared, v_shared, b_w_out[j])
    return rmsnorm(x, final_norm)
```

```cpp
#include <hip/hip_runtime.h>
#include <hip/hip_cooperative_groups.h>
#include <cstdio>
#include <cstdint>
namespace cg = cooperative_groups;

#define LAS __attribute__((address_space(3)))
#define DI __device__ __forceinline__
typedef unsigned short bf16_t;
typedef short bf16x8 __attribute__((ext_vector_type(8)));
typedef short bf16x4 __attribute__((ext_vector_type(4)));
typedef float f32x2 __attribute__((ext_vector_type(2)));
typedef float f32x4 __attribute__((ext_vector_type(4)));
typedef float f32x16 __attribute__((ext_vector_type(16)));
typedef unsigned u32x2 __attribute__((ext_vector_type(2)));
typedef unsigned u32x4 __attribute__((ext_vector_type(4)));
typedef __bf16 bf16v2 __attribute__((ext_vector_type(2)));

constexpr int SEQ = 16384, DM = 1024, DINNER = 2048;
constexpr int A_IN = 5136, GLA_DK = 512, GLA_H = 4, GLA_DVH = 512;
constexpr int GC = 256, NCH = SEQ / GC;
constexpr int KV_OUT = 12288, B_IN = 8192;
constexpr float RMS_EPS = 1e-6f;
constexpr float LOG2E = 1.4426950408889634f;
constexpr size_t MiB = 1u << 20;
constexpr size_t WS_W1T = 0;
constexpr size_t WS_WOT = 10 * MiB;
constexpr size_t WS_LR = 14 * MiB;
constexpr size_t WS_DCH = 15 * MiB;
constexpr size_t WS_SSQ = 16 * MiB;
constexpr size_t WS_LSE = 17 * MiB;
constexpr size_t WS_WO2T = 18 * MiB;
constexpr size_t WS_WC = 22 * MiB;
constexpr size_t WS_H = 32 * MiB;
constexpr size_t WS_QKZ = 64 * MiB;
constexpr size_t WS_KT = 160 * MiB;
constexpr size_t WS_P = 176 * MiB;
constexpr size_t WS_QC = 128 * MiB, WS_KC = 160 * MiB, WS_ZC = 192 * MiB, WS_VTC = 224 * MiB;

DI unsigned pk2(float lo, float hi) { f32x2 v = {lo, hi}; return __builtin_bit_cast(unsigned, __builtin_convertvector(v, bf16v2)); }
DI float bf_lo(unsigned w) { return __uint_as_float(w << 16); }
DI float bf_hi(unsigned w) { return __uint_as_float(w & 0xffff0000u); }
DI float bf2f(bf16_t b) { return __uint_as_float(((unsigned)b) << 16); }
DI bf16_t f2bf(float f) { return (bf16_t)(pk2(f, 0.f) & 0xffffu); }
#define MFMA32(a, b, c) __builtin_amdgcn_mfma_f32_32x32x16_bf16((a), (b), (c), 0, 0, 0)
DI int crow(int reg, int h) { return (reg & 3) + 8 * (reg >> 2) + 4 * h; }
DI float wave_sum(float v) {
#pragma unroll
  for (int o = 1; o < 64; o <<= 1) v += __shfl_xor(v, o);
  return v;
}
#define LDS_WAIT() asm volatile("s_waitcnt lgkmcnt(0)" ::: "memory")

namespace pg8 {
constexpr int BM = 256, BK = 64, HALF = 128, HTB = HALF * BK * 2, STAGE_BYTES = 8 * HTB, NXCD = 8, WGM = 8;
__host__ __device__ __forceinline__ int lds_byte(int r, int c) { const int st = (r >> 4) * 2 + (c >> 5), rr = r & 15, cc = c & 31, ob = rr * 64 + cc * 2; return st * 1024 + (ob ^ (((ob >> 9) & 1) << 5)); }
__host__ __device__ __forceinline__ void stage_rc(int b, int& R, int& C) { const int st = b / 1024, sb = b % 1024, swz = sb ^ (((sb >> 9) & 1) << 5); R = (st >> 1) * 16 + swz / 64; C = (st & 1) * 32 + (swz % 64) / 2; }
__host__ __device__ __forceinline__ int perm32(int rho) { const int n = rho >> 4, i = rho & 15; return 8 * (i >> 2) + 4 * n + (i & 3); }

struct Unit { int pm, pn, sub; const char* a; const char* b; };
struct Sub { const char* A; const char* Bt; int nM, nN, dil, tpr; };
struct Order {
  Sub s0, s1; int nsub, G, c, K;
  DI bool next(int i, Unit& u) const {
    long L = (long)i * G + c; const int n0 = s0.nM * s0.nN;
    int si = 0;
    if (L >= n0) { if (nsub < 2) return false; L -= n0; si = 1; if (L >= (long)s1.nM * s1.nN) return false; }
    const int nM = si ? s1.nM : s0.nM, nN = si ? s1.nN : s0.nN, dil = si ? s1.dil : s0.dil, tpr = si ? s1.tpr : s0.tpr;
    const char* A = si ? s1.A : s0.A; const char* Bt = si ? s1.Bt : s0.Bt;
    const int nwg = nM * nN;
    int wgid = (int)L; { const int q = nwg / NXCD, r = nwg % NXCD, xcd = wgid % NXCD, off = wgid / NXCD; wgid = (xcd < r ? xcd * (q + 1) : r * (q + 1) + (xcd - r) * q) + off; }
    const int nig = WGM * nN, gid = wgid / nig, fm = gid * WGM, gsz = (nM - fm) < WGM ? (nM - fm) : WGM;
    u.pm = fm + ((wgid % nig) % gsz); u.pn = (wgid % nig) / gsz; u.sub = si;
    u.a = A + (size_t)u.pm * BM * K * 2;
    u.b = Bt + ((size_t)(u.pn / tpr) + (size_t)dil * BM * (u.pn % tpr)) * K * 2;
    return true;
  }
};

template <class Epi, bool ALIGN_EPI, bool SP2>
DI void gemm_phase(LAS unsigned char* lds, const Order& S, const Epi& E, int ldb_mult) {
  int tid = threadIdx.x; asm volatile("" : "+v"(tid));
  const int wid = __builtin_amdgcn_readfirstlane(tid >> 6), lane = tid & 63, wr = wid >> 2, wc = wid & 3, fr = lane & 15, fq = lane >> 4;
  const int K = S.K, nt = K / BK;
  unsigned voffA[2], voffB[2];
#pragma unroll
  for (int i = 0; i < 2; ++i) { int R, C; stage_rc(tid * 16 + i * 8192, R, C); const int Rb = (R & ~31) + perm32(R & 31);
    voffA[i] = (unsigned)(R * K + C) * 2u; voffB[i] = (unsigned)(Rb * K * ldb_mult + C) * 2u; }
  const size_t kstep = (size_t)(BK * 2);
  const size_t hstepA = (size_t)HALF * K * 2, hstepB = (size_t)HALF * K * 2 * ldb_mult;
  const unsigned ldsw = (unsigned)wid * 1024u;
  const int aoff = lds_byte(wr * 64 + fr, fq * 8), boff = lds_byte(wc * 32 + fr, fq * 8);
#define PG8_SA(b, h) (((b) * 2 + (h)) * HTB)
#define PG8_SB(b, h) ((4 + (b) * 2 + (h)) * HTB)
#define PG8_STAGE(bufoff, gbase, voff) do { _Pragma("unroll") for (int _i = 0; _i < 2; ++_i) \
        __builtin_amdgcn_global_load_lds((const unsigned*)((const char*)(gbase) + (voff)[_i]), (LAS unsigned*)(lds + (bufoff) + ldsw + _i * 8192), 16, 0, 0); } while (0)
#define PG8_LDA(dst, b, h) do { _Pragma("unroll") for (int m = 0; m < 4; ++m) _Pragma("unroll") for (int k = 0; k < 2; ++k) dst[m][k] = *(const LAS bf16x8*)(lds + PG8_SA(b, h) + aoff + m * 2048 + k * 1024); } while (0)
#define PG8_LDB(dst, b, h) do { _Pragma("unroll") for (int n = 0; n < 2; ++n) _Pragma("unroll") for (int k = 0; k < 2; ++k) dst[n][k] = *(const LAS bf16x8*)(lds + PG8_SB(b, h) + boff + n * 2048 + k * 1024); } while (0)
#define PG8_MMA(ai, bj, At, Bt) do { __builtin_amdgcn_s_setprio(1); _Pragma("unroll") for (int m = 0; m < 4; ++m) _Pragma("unroll") for (int n = 0; n < 2; ++n) _Pragma("unroll") for (int k = 0; k < 2; ++k) \
        acc[ai][bj][m][n] = __builtin_amdgcn_mfma_f32_16x16x32_bf16(Bt[n][k], At[m][k], acc[ai][bj][m][n], 0, 0, 0); __builtin_amdgcn_s_setprio(0); } while (0)
#define PG8_WAIT_V(n) asm volatile("s_waitcnt vmcnt(" #n ")" ::: "memory")
#define PG8_WAIT_L(n) asm volatile("s_waitcnt lgkmcnt(" #n ")" ::: "memory")
#define PG8_BAR __builtin_amdgcn_s_barrier()
#define PG8_SCHED __builtin_amdgcn_sched_barrier(0)
  Unit cur, nxt; int ui = 0;
  if (!S.next(0, cur)) return;
  f32x4 acc[2][2][4][2];
#pragma unroll
  for (int a = 0; a < 2; ++a)
#pragma unroll
    for (int b = 0; b < 2; ++b)
#pragma unroll
      for (int m = 0; m < 4; ++m)
#pragma unroll
        for (int n = 0; n < 2; ++n) acc[a][b][m][n] = (f32x4){0.f, 0.f, 0.f, 0.f};
  bf16x8 At[4][2], B0[2][2], B1[2][2];
  const char* cA = cur.a; const char* cB = cur.b;
  if constexpr (SP2) {
    PG8_STAGE(PG8_SB(0, 0), cB, voffB); PG8_STAGE(PG8_SB(0, 1), cB + hstepB, voffB); PG8_STAGE(PG8_SA(0, 0), cA, voffA); PG8_STAGE(PG8_SA(0, 1), cA + hstepA, voffA);
    if (wr == 1) PG8_BAR;
    PG8_WAIT_V(2); PG8_BAR;
    PG8_STAGE(PG8_SB(1, 0), cB + kstep, voffB); PG8_STAGE(PG8_SA(1, 0), cA + kstep, voffA); PG8_STAGE(PG8_SB(1, 1), cB + hstepB + kstep, voffB);
    PG8_WAIT_V(6); PG8_BAR;
  } else {
    PG8_STAGE(PG8_SB(0, 0), cB, voffB); PG8_STAGE(PG8_SA(0, 0), cA, voffA); PG8_STAGE(PG8_SB(0, 1), cB + hstepB, voffB); PG8_STAGE(PG8_SA(0, 1), cA + hstepA, voffA);
    if (wr == 1) PG8_BAR;
    PG8_WAIT_V(4); PG8_BAR;
    PG8_STAGE(PG8_SB(1, 0), cB + kstep, voffB); PG8_STAGE(PG8_SA(1, 0), cA + kstep, voffA); PG8_STAGE(PG8_SB(1, 1), cB + hstepB + kstep, voffB);
    PG8_WAIT_V(6); PG8_BAR;
  }
  for (;;) {
    const bool has_next = S.next(ui + 1, nxt);
    const char* nA = has_next ? nxt.a : cA; const char* nB = has_next ? nxt.b : cB;
    for (int t = 0; t < nt; t += 2) {
      const bool last = (t == nt - 2);
      const char* a1 = cA + (size_t)(t + 1) * kstep;
      const char* a2 = last ? nA : cA + (size_t)(t + 2) * kstep; const char* b2 = last ? nB : cB + (size_t)(t + 2) * kstep;
      const char* a3 = a2 + kstep; const char* b3 = b2 + kstep;
      if constexpr (SP2) {
        PG8_LDB(B0, 0, 0); PG8_LDB(B1, 0, 1); PG8_SCHED; PG8_LDA(At, 0, 0); PG8_STAGE(PG8_SA(1, 1), a1 + hstepA, voffA);
        PG8_WAIT_V(8); PG8_WAIT_L(0); PG8_BAR; PG8_MMA(0, 0, At, B0); PG8_MMA(0, 1, At, B1); PG8_BAR; PG8_SCHED;
        PG8_LDA(At, 0, 1); PG8_STAGE(PG8_SB(0, 0), b2, voffB); PG8_STAGE(PG8_SB(0, 1), b2 + hstepB, voffB); PG8_STAGE(PG8_SA(0, 0), a2, voffA);
        PG8_WAIT_V(8); PG8_WAIT_L(0); PG8_BAR; PG8_MMA(1, 0, At, B0); PG8_MMA(1, 1, At, B1); PG8_BAR; PG8_SCHED;
        PG8_LDB(B0, 1, 0); PG8_LDB(B1, 1, 1); PG8_SCHED; PG8_LDA(At, 1, 0); PG8_STAGE(PG8_SA(0, 1), a2 + hstepA, voffA);
        PG8_WAIT_V(8); PG8_WAIT_L(0); PG8_BAR; PG8_MMA(0, 0, At, B0); PG8_MMA(0, 1, At, B1); PG8_BAR; PG8_SCHED;
        PG8_LDA(At, 1, 1); PG8_STAGE(PG8_SB(1, 0), b3, voffB); PG8_STAGE(PG8_SB(1, 1), b3 + hstepB, voffB); PG8_STAGE(PG8_SA(1, 0), a3, voffA);
        PG8_WAIT_V(8); PG8_WAIT_L(0); PG8_BAR; PG8_MMA(1, 0, At, B0); PG8_MMA(1, 1, At, B1); PG8_BAR; PG8_SCHED;
      } else {
        PG8_LDB(B0, 0, 0); PG8_SCHED; PG8_LDA(At, 0, 0); PG8_STAGE(PG8_SA(1, 1), a1 + hstepA, voffA);
        PG8_WAIT_L(8); PG8_BAR; PG8_WAIT_L(0); PG8_MMA(0, 0, At, B0); PG8_BAR; PG8_SCHED;
        PG8_LDB(B1, 0, 1); PG8_STAGE(PG8_SB(0, 0), b2, voffB);
        PG8_BAR; PG8_WAIT_L(0); PG8_MMA(0, 1, At, B1); PG8_BAR;
        PG8_LDA(At, 0, 1); PG8_STAGE(PG8_SA(0, 0), a2, voffA);
        PG8_BAR; PG8_WAIT_L(0); PG8_MMA(1, 0, At, B0); PG8_BAR; PG8_SCHED;
        PG8_STAGE(PG8_SB(0, 1), b2 + hstepB, voffB);
        PG8_WAIT_V(6); PG8_BAR; PG8_MMA(1, 1, At, B1); PG8_BAR;
        PG8_LDB(B0, 1, 0); PG8_SCHED; PG8_LDA(At, 1, 0); PG8_STAGE(PG8_SA(0, 1), a2 + hstepA, voffA);
        PG8_WAIT_L(8); PG8_BAR; PG8_WAIT_L(0); PG8_MMA(0, 0, At, B0); PG8_BAR; PG8_SCHED;
        PG8_LDB(B1, 1, 1); PG8_STAGE(PG8_SB(1, 0), b3, voffB);
        PG8_BAR; PG8_WAIT_L(0); PG8_MMA(0, 1, At, B1); PG8_BAR;
        PG8_LDA(At, 1, 1); PG8_STAGE(PG8_SA(1, 0), a3, voffA);
        PG8_BAR; PG8_WAIT_L(0); PG8_MMA(1, 0, At, B0); PG8_BAR; PG8_SCHED;
        PG8_STAGE(PG8_SB(1, 1), b3 + hstepB, voffB);
        PG8_WAIT_V(6); PG8_BAR; PG8_MMA(1, 1, At, B1); PG8_BAR;
      }
    }
    if constexpr (ALIGN_EPI) { if (wr == 0) PG8_BAR; }
    if constexpr (!Epi::AFTER_DRAIN) { E(acc, cur, wr, wc, fr, fq); }
    if (!has_next) break;
#pragma unroll
    for (int a = 0; a < 2; ++a)
#pragma unroll
      for (int b = 0; b < 2; ++b)
#pragma unroll
        for (int m = 0; m < 4; ++m)
#pragma unroll
          for (int n = 0; n < 2; ++n) acc[a][b][m][n] = (f32x4){0.f, 0.f, 0.f, 0.f};
    cur = nxt; cA = nA; cB = nB; ++ui;
    if constexpr (ALIGN_EPI) { if (wr == 1) PG8_BAR; }
  }
  PG8_WAIT_V(0);
  if constexpr (!ALIGN_EPI) { if (wr == 0) PG8_BAR; }
  PG8_BAR;
  if constexpr (Epi::AFTER_DRAIN) { E.fused(acc, cur, wr, wc, fr, fq, lds, wid, lane); }
#undef PG8_SA
#undef PG8_SB
#undef PG8_STAGE
#undef PG8_LDA
#undef PG8_LDB
#undef PG8_MMA
#undef PG8_WAIT_V
#undef PG8_WAIT_L
#undef PG8_BAR
#undef PG8_SCHED
}

struct EpiBf16Two {
  static constexpr bool AFTER_DRAIN = false;
  bf16_t* O0; int ldc0; bf16_t* O1; int ldc1;
  DI void operator()(const f32x4 (&acc)[2][2][4][2], const Unit& u, int wr, int wc, int fr, int fq) const {
    bf16_t* base = u.sub ? O1 : O0; const int ldc = u.sub ? ldc1 : ldc0;
    const int row0 = u.pm * BM + wr * 64 + fr, col0 = u.pn * BM + wc * 32 + 8 * fq;
#pragma unroll
    for (int ai = 0; ai < 2; ++ai)
#pragma unroll
      for (int m = 0; m < 4; ++m) { bf16_t* rowp = base + (size_t)(row0 + ai * HALF + m * 16) * ldc + col0;
#pragma unroll
        for (int bj = 0; bj < 2; ++bj) { const f32x4 v0 = acc[ai][bj][m][0], v1 = acc[ai][bj][m][1];
          u32x4 w; w.x = pk2(v0[0], v0[1]); w.y = pk2(v0[2], v0[3]); w.z = pk2(v1[0], v1[1]); w.w = pk2(v1[2], v1[3]);
          *(u32x4*)(rowp + bj * HALF) = w; } }
  }
};
struct EpiRowScale3 {
  static constexpr bool AFTER_DRAIN = false;
  bf16_t* O0; const float* ssq;
  DI void operator()(const f32x4 (&acc)[2][2][4][2], const Unit& u, int wr, int wc, int fr, int fq) const {
    const int t = u.pn >> 2; bf16_t* base = O0 + (size_t)t * (16u << 20);
    const int row0 = u.pm * BM + wr * 64 + fr, col0 = (u.pn & 3) * BM + wc * 32 + 8 * fq;
#pragma unroll
    for (int ai = 0; ai < 2; ++ai)
#pragma unroll
      for (int m = 0; m < 4; ++m) { const int row = row0 + ai * HALF + m * 16;
        const f32x4 sq = *(const f32x4*)(ssq + (size_t)row * 4); const float rs = rsqrtf(((sq[0] + sq[1]) + (sq[2] + sq[3])) * (1.0f / DM) + RMS_EPS);
        bf16_t* rowp = base + (size_t)row * 1024 + col0;
#pragma unroll
        for (int bj = 0; bj < 2; ++bj) { const f32x4 v0 = acc[ai][bj][m][0] * rs, v1 = acc[ai][bj][m][1] * rs;
          u32x4 w; w.x = pk2(v0[0], v0[1]); w.y = pk2(v0[2], v0[3]); w.z = pk2(v1[0], v1[1]); w.w = pk2(v1[2], v1[3]);
          *(u32x4*)(rowp + bj * HALF) = w; } }
  }
};
struct EpiColScale {
  static constexpr bool AFTER_DRAIN = false;
  bf16_t* O; const float* ssq; int dil, tpr;
  DI void operator()(const f32x4 (&acc)[2][2][4][2], const Unit& u, int wr, int wc, int fr, int fq) const {
    const int row0 = u.pm * BM + wr * 64 + fr, col0 = u.pn * BM + wc * 32 + 8 * fq;
    const int r = u.pn / tpr, j0 = (u.pn % tpr) * BM + wc * 32 + 8 * fq;
    float rs[2][8];
#pragma unroll
    for (int bj = 0; bj < 2; ++bj)
#pragma unroll
      for (int e = 0; e < 8; ++e) { const int tok = r + dil * (j0 + bj * HALF + e); const f32x4 sq = *(const f32x4*)(ssq + (size_t)tok * 4);
        rs[bj][e] = rsqrtf(((sq[0] + sq[1]) + (sq[2] + sq[3])) * (1.0f / DM) + RMS_EPS); }
#pragma unroll
    for (int ai = 0; ai < 2; ++ai)
#pragma unroll
      for (int m = 0; m < 4; ++m) { bf16_t* rowp = O + (size_t)(row0 + ai * HALF + m * 16) * SEQ + col0;
#pragma unroll
        for (int bj = 0; bj < 2; ++bj) { const f32x4 v0 = acc[ai][bj][m][0], v1 = acc[ai][bj][m][1];
          u32x4 w; w.x = pk2(v0[0] * rs[bj][0], v0[1] * rs[bj][1]); w.y = pk2(v0[2] * rs[bj][2], v0[3] * rs[bj][3]);
          w.z = pk2(v1[0] * rs[bj][4], v1[1] * rs[bj][5]); w.w = pk2(v1[2] * rs[bj][6], v1[3] * rs[bj][7]);
          *(u32x4*)(rowp + bj * HALF) = w; } }
  }
};
struct EpiResidual {
  static constexpr bool AFTER_DRAIN = true;
  const float* base; float* out; bf16_t* outb; float* ssq;
  DI void operator()(const f32x4 (&)[2][2][4][2], const Unit&, int, int, int, int) const {}
  DI void fused(f32x4 (&acc)[2][2][4][2], const Unit& u, int wr, int wc, int fr, int fq, LAS unsigned char* lds, int wid, int lane) const {
    LAS float* part = (LAS float*)lds;
    const int col0 = u.pn * BM + wc * 32 + 8 * fq;
#pragma unroll
    for (int ai = 0; ai < 2; ++ai)
#pragma unroll
      for (int m = 0; m < 4; ++m) { const int rl = ai * HALF + wr * 64 + m * 16 + fr; const size_t off = (size_t)(u.pm * BM + rl) * DM + col0; float s = 0.f;
#pragma unroll
        for (int bj = 0; bj < 2; ++bj) { const f32x4 b0 = *(const f32x4*)(base + off + bj * HALF), b1 = *(const f32x4*)(base + off + bj * HALF + 4);
          const f32x4 v0 = acc[ai][bj][m][0] + b0, v1 = acc[ai][bj][m][1] + b1;
          *(f32x4*)(out + off + bj * HALF) = v0; *(f32x4*)(out + off + bj * HALF + 4) = v1;
          if (outb) { u32x4 w; w.x = pk2(v0[0], v0[1]); w.y = pk2(v0[2], v0[3]); w.z = pk2(v1[0], v1[1]); w.w = pk2(v1[2], v1[3]); *(u32x4*)(outb + off + bj * HALF) = w; }
          s += (v0[0] * v0[0] + v0[1] * v0[1]) + (v0[2] * v0[2] + v0[3] * v0[3]) + (v1[0] * v1[0] + v1[1] * v1[1]) + (v1[2] * v1[2] + v1[3] * v1[3]); }
        s += __shfl_xor(s, 16); s += __shfl_xor(s, 32);
        if (fq == 0) part[rl * 4 + wc] = s; }
    __syncthreads();
    const int tid = wid * 64 + lane;
    if (tid < 256) { const f32x4 p = *(const LAS f32x4*)(part + tid * 4); ssq[(size_t)(u.pm * BM + tid) * 4 + u.pn] = (p[0] + p[1]) + (p[2] + p[3]); }
    __syncthreads();
  }
};
}

struct Params { const float* in[13]; float* out; unsigned char* ws; int ph_lo, ph_hi; };
enum { I_X = 0, I_ANORM, I_AWIN, I_AWGU, I_ABG, I_AGOUT, I_AWOUT, I_KVNORM, I_WKV, I_BNORM, I_BWIN, I_BWOUT, I_FNORM };
constexpr int NPHASE = 21;
constexpr int LDS_BYTES = 147456;

DI void transpose_item(const float* W, int ldw, int c0, const float* gk, float sc, bf16_t* WT, int K, int r0, LAS float* scr, int kb, int nb, int lane) {
  const int k0 = 64 * kb, n0 = 32 * nb;
#pragma unroll 8
  for (int i = 0; i < 32; ++i) { const int kk = 2 * i + (lane >> 5); const float g = gk ? gk[k0 + kk] * sc : sc;
    scr[kk * 33 + (lane & 31)] = W[(size_t)(k0 + kk) * ldw + c0 + n0 + (lane & 31)] * g; }
  LDS_WAIT(); asm volatile("" ::: "memory");
  const int c = lane & 7;
#pragma unroll
  for (int j = 0; j < 4; ++j) { const int n = (lane >> 3) + 8 * j; const LAS float* s = scr + (8 * c) * 33 + n;
    u32x4 o; o.x = pk2(s[0 * 33], s[1 * 33]); o.y = pk2(s[2 * 33], s[3 * 33]); o.z = pk2(s[4 * 33], s[5 * 33]); o.w = pk2(s[6 * 33], s[7 * 33]);
    *(u32x4*)(WT + (size_t)(r0 + n0 + n) * K + k0 + 8 * c) = o; }
  LDS_WAIT(); asm volatile("" ::: "memory");
}
DI void convert_chunk_weights(const float* bwin, const float* wkv, const float* bnorm, const float* kvnorm, bf16_t* WC, int g, int hh, LAS float* scr, int gw, int NGW, int lane) {
  const float qscale = 0.08838834764831845f * LOG2E;
  const int nseg = (g == 2) ? 4 : 3;
  for (int it = gw; it < nseg * 512; it += NGW) {
    const int seg = it >> 9, r = it & 511, kb = r >> 5, nb = r & 31;
    if (seg == 0) transpose_item(bwin, B_IN, g * 2048 + hh * 1024, bnorm, qscale, WC, DM, 0, scr, kb, nb, lane);
    else if (seg == 1) transpose_item(wkv, KV_OUT, g * 2048 + hh * 1024, kvnorm, 1.f, WC, DM, 1024, scr, kb, nb, lane);
    else if (seg == 2) transpose_item(wkv, KV_OUT, 6144 + g * 2048 + hh * 1024, kvnorm, 1.f, WC, DM, 3072, scr, kb, nb, lane);
    else transpose_item(bwin, B_IN, 6144 + hh * 1024, bnorm, 1.f, WC, DM, 2048, scr, kb, nb, lane);
  }
}

#define CAS __attribute__((address_space(4)))
#if defined(__HIP_DEVICE_COMPILE__)
DI const CAS Params& fresh_params() { const CAS Params* q = (const CAS Params*)__builtin_amdgcn_kernarg_segment_ptr(); asm volatile("" : "+s"(q)); return *q; }
#else
DI const Params& fresh_params() { return *(const Params*)nullptr; }
#endif
__global__ void __launch_bounds__(512, 2) yoco_fwd(Params p_unused) {
  extern __shared__ __attribute__((aligned(16))) unsigned char lds_raw[];
  LAS unsigned char* lds = (LAS unsigned char*)lds_raw;
  cg::grid_group grid = cg::this_grid();
  const int tid = threadIdx.x, lane = tid & 63, wave = __builtin_amdgcn_readfirstlane(tid >> 6);
  const int G = gridDim.x, bx = blockIdx.x;
  const int gw = bx * 8 + wave, NGW = G * 8;
  const int lo = fresh_params().ph_lo, hi = fresh_params().ph_hi;
#ifndef PHASE_MASK
#define PHASE_MASK 0xffffffffu
#endif
#define PH_EN(k) (((PHASE_MASK) >> ((k) > 8 && (k) < 19 ? 7 + (((k) - 7) & 1) : ((k) >= 19 ? (k) - 10 : (k)))) & 1u)
#define IN(k) (PH_EN(k) && lo <= (k) && (k) < hi)
#define SEAM(k) do { if (IN(k) && IN((k) + 1)) grid.sync(); } while (0)

  if (IN(0)) {
    const auto& p = fresh_params(); unsigned char* ws = p.ws;
    LAS float* wlrT = (LAS float*)lds;
    LAS float* scr = (LAS float*)(lds + 65536 + wave * 8448);
    const float* awin = p.in[I_AWIN];
    for (int k = tid; k < DM; k += 512) {
      const f32x4* src = (const f32x4*)(awin + (size_t)k * A_IN + 5120);
#pragma unroll
      for (int q = 0; q < 4; ++q) { const f32x4 v = src[q]; wlrT[(4 * q + 0) * DM + k] = v[0]; wlrT[(4 * q + 1) * DM + k] = v[1]; wlrT[(4 * q + 2) * DM + k] = v[2]; wlrT[(4 * q + 3) * DM + k] = v[3]; }
    }
    bf16_t* W1T = (bf16_t*)(ws + WS_W1T); bf16_t* WOT = (bf16_t*)(ws + WS_WOT); bf16_t* WO2T = (bf16_t*)(ws + WS_WO2T);
    for (int it = gw; it < 2560 + 1024 + 1024; it += NGW) {
      if (it < 2560) { const int kb = it / 160, nbb = it % 160; int c0, r0, nb;
        if (nbb < 16) { c0 = 0; r0 = 0; nb = nbb; } else if (nbb < 32) { c0 = 512; r0 = 512; nb = nbb - 16; } else if (nbb < 96) { c0 = 3072; r0 = 1024; nb = nbb - 32; } else { c0 = 1024; r0 = 3072; nb = nbb - 96; }
        transpose_item(awin, A_IN, c0, nullptr, 1.f, W1T, DM, r0, scr, kb, nb, lane); }
      else if (it < 3584) { const int r = it - 2560; transpose_item(p.in[I_AWOUT], DM, 0, nullptr, 1.f, WOT, DINNER, 0, scr, r >> 5, r & 31, lane); }
      else { const int r = it - 3584; transpose_item(p.in[I_BWOUT], DM, 0, nullptr, 1.f, WO2T, DINNER, 0, scr, r >> 5, r & 31, lane); }
    }
    __syncthreads();
    const float* x = p.in[I_X]; const float* gA = p.in[I_ANORM];
    bf16_t* H = (bf16_t*)(ws + WS_H); float* LR = (float*)(ws + WS_LR);
    f32x4 gv[4];
#pragma unroll
    for (int j = 0; j < 4; ++j) gv[j] = *(const f32x4*)(gA + 4 * lane + 256 * j);
    for (int m = gw; m < SEQ; m += NGW) {
      const f32x4* xr = (const f32x4*)(x + (size_t)m * DM) + lane;
      f32x4 v[4]; float s2 = 0.f;
#pragma unroll
      for (int j = 0; j < 4; ++j) { v[j] = xr[64 * j]; s2 += (v[j][0] * v[j][0] + v[j][1] * v[j][1]) + (v[j][2] * v[j][2] + v[j][3] * v[j][3]); }
      const float rstd = rsqrtf(wave_sum(s2) * (1.f / DM) + RMS_EPS);
#pragma unroll
      for (int j = 0; j < 4; ++j) v[j] = v[j] * rstd * gv[j];
      u32x2* o8 = (u32x2*)(H + (size_t)m * DM) + lane;
#pragma unroll
      for (int j = 0; j < 4; ++j) { u32x2 w; w.x = pk2(v[j][0], v[j][1]); w.y = pk2(v[j][2], v[j][3]); o8[64 * j] = w; }
      float mine = 0.f;
#pragma unroll 2
      for (int i = 0; i < 16; ++i) { float a = 0.f;
#pragma unroll
        for (int j = 0; j < 4; ++j) { const f32x4 w = *(const LAS f32x4*)(wlrT + i * DM + 4 * lane + 256 * j); a += (v[j][0] * w[0] + v[j][1] * w[1]) + (v[j][2] * w[2] + v[j][3] * w[3]); }
        a = wave_sum(a); if (lane == i) mine = a; }
      if (lane < 16) LR[(size_t)m * 16 + lane] = mine;
    }
  }
  SEAM(0);

  if (IN(1)) {
    const auto& p = fresh_params(); unsigned char* ws = p.ws;
    pg8::Order S; S.nsub = 2; S.G = G; S.c = bx; S.K = DM;
    S.s0 = pg8::Sub{(const char*)(ws + WS_H), (const char*)(ws + WS_W1T), 64, 12, 1, 12};
    S.s1 = pg8::Sub{(const char*)(ws + WS_W1T) + (size_t)3072 * DM * 2, (const char*)(ws + WS_H), 8, 64, 1, 64};
    pg8::EpiBf16Two E{(bf16_t*)(ws + WS_QKZ), 3072, (bf16_t*)p.out, SEQ};
    pg8::gemm_phase<pg8::EpiBf16Two, true, true>(lds, S, E, 1);
  }
  SEAM(1);

  if (IN(2)) {
    const auto& p = fresh_params(); unsigned char* ws = p.ws;
    LAS float* lrs = (LAS float*)lds;
    LAS float* tot = (LAS float*)(lds + 16384);
    bf16_t* QKZ = (bf16_t*)(ws + WS_QKZ); bf16_t* KT = (bf16_t*)(ws + WS_KT); float* DCH = (float*)(ws + WS_DCH);
    const float* LR = (const float*)(ws + WS_LR);
    const int ch = tid & 127, seg = wave >> 1;
    for (int it = bx; it < NCH * GLA_H; it += G) {
      const int c = it >> 2, hd = it & 3, j = hd * 128 + ch;
      __syncthreads();
      { const f32x4* src = (const f32x4*)(LR + (size_t)c * GC * 16); LAS f32x4* dst = (LAS f32x4*)lrs; dst[tid] = src[tid]; dst[tid + 512] = src[tid + 512]; }
      float wg[16];
#pragma unroll
      for (int e = 0; e < 16; ++e) wg[e] = p.in[I_AWGU][e * GLA_DK + j];
      const float bias = p.in[I_ABG][j];
      __syncthreads();
      float cumv[64]; float cum = 0.f;
#pragma unroll
      for (int i = 0; i < 64; ++i) { const LAS f32x4* r4 = (const LAS f32x4*)(lrs + (seg * 64 + i) * 16); float pre = bias;
#pragma unroll
        for (int q = 0; q < 4; ++q) { const f32x4 v = r4[q]; pre += (v[0] * wg[4 * q] + v[1] * wg[4 * q + 1]) + (v[2] * wg[4 * q + 2] + v[3] * wg[4 * q + 3]); }
        const float ls = fminf(pre, 0.f) - log1pf(expf(-fabsf(pre)));
        cum += ls * (1.f / 16.f); cumv[i] = cum; }
      tot[seg * 128 + ch] = cum;
      __syncthreads();
      float off = 0.f, total = 0.f;
#pragma unroll
      for (int s = 0; s < 4; ++s) { const float t = tot[s * 128 + ch]; total += t; if (s < seg) off += t; }
      const int t0 = c * GC + seg * 64;
#pragma unroll
      for (int i8 = 0; i8 < 8; ++i8) { float kk[8];
#pragma unroll
        for (int e = 0; e < 8; ++e) { const int i = i8 * 8 + e; const float B = off + cumv[i];
          bf16_t* qp = QKZ + (size_t)(t0 + i) * 3072 + j; bf16_t* kp = qp + 512;
          const float qv = bf2f(*qp) * (expf(B) * 0.08838834764831845f), kv = bf2f(*kp) * expf(fminf(-B, 80.f));
          *qp = f2bf(qv); *kp = f2bf(kv); kk[e] = kv; }
        u32x4 w; w.x = pk2(kk[0], kk[1]); w.y = pk2(kk[2], kk[3]); w.z = pk2(kk[4], kk[5]); w.w = pk2(kk[6], kk[7]);
        *(u32x4*)(KT + (size_t)j * SEQ + t0 + i8 * 8) = w; }
      if (seg == 0) DCH[c * GLA_DK + j] = expf(total);
    }
  }
  SEAM(2);

  if (IN(3)) {
    const auto& p = fresh_params(); unsigned char* ws = p.ws;
    const bf16_t* KT = (const bf16_t*)(ws + WS_KT); const bf16_t* VT = (const bf16_t*)p.out; float* P = (float*)(ws + WS_P);
    const int r = lane & 31, h = lane >> 5, mt = wave & 3, nh = wave >> 2;
    for (int it = bx; it < NCH * 16; it += G) {
      const int c = it >> 4, hd = (it >> 2) & 3, ns = it & 3;
      const bf16_t* ap = KT + (size_t)(hd * 128 + 32 * mt + r) * SEQ + c * GC + 8 * h;
      const bf16_t* bp0 = VT + (size_t)(hd * 512 + ns * 128 + nh * 64 + r) * SEQ + c * GC + 8 * h; const bf16_t* bp1 = bp0 + (size_t)32 * SEQ;
      f32x16 a0, a1;
#pragma unroll
      for (int i = 0; i < 16; ++i) { a0[i] = 0.f; a1[i] = 0.f; }
#pragma unroll 4
      for (int s = 0; s < 16; ++s) { const bf16x8 a = *(const bf16x8*)(ap + 16 * s), b0 = *(const bf16x8*)(bp0 + 16 * s), b1 = *(const bf16x8*)(bp1 + 16 * s);
        a0 = MFMA32(a, b0, a0); a1 = MFMA32(a, b1, a1); }
      float* o0 = P + ((size_t)(c * 4 + hd) * 512 + ns * 128 + nh * 64 + r) * 128 + 32 * mt + 4 * h; float* o1 = o0 + 32 * 128;
#pragma unroll
      for (int i4 = 0; i4 < 4; ++i4) { *(f32x4*)(o0 + 8 * i4) = (f32x4){a0[4 * i4], a0[4 * i4 + 1], a0[4 * i4 + 2], a0[4 * i4 + 3]};
        *(f32x4*)(o1 + 8 * i4) = (f32x4){a1[4 * i4], a1[4 * i4 + 1], a1[4 * i4 + 2], a1[4 * i4 + 3]}; }
    }
  }
  SEAM(3);

  if (IN(4)) {
    const auto& p = fresh_params(); unsigned char* ws = p.ws;
    const float* P = (const float*)(ws + WS_P); const float* DCH = (const float*)(ws + WS_DCH); unsigned* SB = (unsigned*)(ws + WS_H);
    for (int idx = bx * 512 + tid; idx < 131072; idx += G * 512) {
      const int e = idx * 2, k = e & 127, hd = e >> 16;
      float s0 = 0.f, s1 = 0.f;
#pragma unroll 8
      for (int c = 0; c < NCH; ++c) { const f32x2 pv = *(const f32x2*)(P + (size_t)c * 262144 + e); const f32x2 dv = *(const f32x2*)(DCH + c * GLA_DK + hd * 128 + k);
        SB[(size_t)c * 131072 + idx] = pk2(s0, s1); s0 = dv[0] * (s0 + pv[0]); s1 = dv[1] * (s1 + pv[1]); }
    }
  }
  SEAM(4);

  if (IN(5)) {
    const auto& p = fresh_params(); unsigned char* ws = p.ws;
    const bf16_t* QKZ = (const bf16_t*)(ws + WS_QKZ); const bf16_t* VT = (const bf16_t*)p.out; const bf16_t* SB = (const bf16_t*)(ws + WS_H);
    bf16_t* OG = (bf16_t*)(ws + WS_P); const float* gout = p.in[I_AGOUT];
    LAS unsigned char* ablk = lds;
    LAS float* red = (LAS float*)(lds + 34816);
    const int r = lane & 31, h = lane >> 5;
    for (int it = bx; it < NCH * 16; it += G) {
      const int c = it >> 4, hd = (it >> 2) & 3, ts = it & 3;
      const int t0 = c * GC + ts * 64, ns = (ts + 1) * 64, ntiles = 4 * (ts + 1);
      __syncthreads();
#pragma unroll
      for (int rep = 0; rep < 2; ++rep) { const int ti = wave + 8 * rep;
        if (ti < ntiles) { const int st = ti >> 1, tt = ti & 1;
          const bf16_t* ap = QKZ + (size_t)(c * GC + 32 * st + r) * 3072 + 512 + hd * 128 + 8 * h;
          const bf16_t* bp = QKZ + (size_t)(t0 + 32 * tt + r) * 3072 + hd * 128 + 8 * h;
          f32x16 acc;
#pragma unroll
          for (int i = 0; i < 16; ++i) acc[i] = 0.f;
#pragma unroll
          for (int ks = 0; ks < 8; ++ks) acc = MFMA32(*(const bf16x8*)(ap + 16 * ks), *(const bf16x8*)(bp + 16 * ks), acc);
          const int tl = ts * 64 + 32 * tt + r;
#pragma unroll
          for (int i4 = 0; i4 < 4; ++i4) { float v[4];
#pragma unroll
            for (int e = 0; e < 4; ++e) { const int sl = 32 * st + 8 * i4 + 4 * h + e; v[e] = (sl <= tl) ? acc[4 * i4 + e] : 0.f; }
            u32x2 w; w.x = pk2(v[0], v[1]); w.y = pk2(v[2], v[3]);
            *(LAS u32x2*)(ablk + (32 * tt + r) * 528 + (32 * st + 8 * i4 + 4 * h) * 2) = w; } } }
      __syncthreads();
      f32x16 acc[2][2];
#pragma unroll
      for (int a = 0; a < 2; ++a)
#pragma unroll
        for (int b = 0; b < 2; ++b)
#pragma unroll
          for (int i = 0; i < 16; ++i) acc[a][b][i] = 0.f;
      { const bf16_t* vp = VT + (size_t)(hd * 512 + 64 * wave + r) * SEQ + c * GC + 8 * h;
        for (int ks = 0; ks < ns / 16; ++ks) {
          const bf16x8 a0 = *(const bf16x8*)(vp + 16 * ks), a1 = *(const bf16x8*)(vp + (size_t)32 * SEQ + 16 * ks);
          const bf16x8 b0 = *(const LAS bf16x8*)(ablk + r * 528 + (16 * ks + 8 * h) * 2), b1 = *(const LAS bf16x8*)(ablk + (32 + r) * 528 + (16 * ks + 8 * h) * 2);
          acc[0][0] = MFMA32(a0, b0, acc[0][0]); acc[0][1] = MFMA32(a0, b1, acc[0][1]); acc[1][0] = MFMA32(a1, b0, acc[1][0]); acc[1][1] = MFMA32(a1, b1, acc[1][1]); } }
      { const bf16_t* sp = SB + ((size_t)(c * 4 + hd) * 512 + 64 * wave + r) * 128 + 8 * h;
        const bf16_t* qp = QKZ + (size_t)(t0 + r) * 3072 + hd * 128 + 8 * h;
#pragma unroll
        for (int ks = 0; ks < 8; ++ks) {
          const bf16x8 a0 = *(const bf16x8*)(sp + 16 * ks), a1 = *(const bf16x8*)(sp + 32 * 128 + 16 * ks);
          const bf16x8 b0 = *(const bf16x8*)(qp + 16 * ks), b1 = *(const bf16x8*)(qp + (size_t)32 * 3072 + 16 * ks);
          acc[0][0] = MFMA32(a0, b0, acc[0][0]); acc[0][1] = MFMA32(a0, b1, acc[0][1]); acc[1][0] = MFMA32(a1, b0, acc[1][0]); acc[1][1] = MFMA32(a1, b1, acc[1][1]); } }
#pragma unroll
      for (int tt = 0; tt < 2; ++tt) { float s = 0.f;
#pragma unroll
        for (int mi = 0; mi < 2; ++mi)
#pragma unroll
          for (int i = 0; i < 16; ++i) s += acc[mi][tt][i] * acc[mi][tt][i];
        s += __shfl_xor(s, 32);
        if (h == 0) red[wave * 64 + 32 * tt + r] = s; }
      __syncthreads();
#pragma unroll
      for (int tt = 0; tt < 2; ++tt) { float s = 0.f;
#pragma unroll
        for (int w = 0; w < 8; ++w) s += red[w * 64 + 32 * tt + r];
        const float rstd = rsqrtf(s * (1.f / GLA_DVH) + RMS_EPS);
        const int t = t0 + 32 * tt + r;
#pragma unroll
        for (int mi = 0; mi < 2; ++mi)
#pragma unroll
          for (int i4 = 0; i4 < 4; ++i4) { const int n0 = 64 * wave + 32 * mi + 8 * i4 + 4 * h;
            const f32x4 g4 = *(const f32x4*)(gout + n0); const u32x2 zz = *(const u32x2*)(QKZ + (size_t)t * 3072 + 1024 + hd * 512 + n0);
            const float z[4] = {bf_lo(zz.x), bf_hi(zz.x), bf_lo(zz.y), bf_hi(zz.y)}; float o[4];
#pragma unroll
            for (int e = 0; e < 4; ++e) { const float sg = z[e] / (1.f + expf(-z[e])); o[e] = acc[mi][tt][4 * i4 + e] * rstd * g4[e] * sg; }
            u32x2 w; w.x = pk2(o[0], o[1]); w.y = pk2(o[2], o[3]);
            *(u32x2*)(OG + (size_t)t * DINNER + hd * 512 + n0) = w; } }
    }
  }
  SEAM(5);

  if (IN(6)) {
    const auto& p = fresh_params(); unsigned char* ws = p.ws;
    convert_chunk_weights(p.in[I_BWIN], p.in[I_WKV], p.in[I_BNORM], p.in[I_KVNORM], (bf16_t*)(ws + WS_WC), 0, 0, (LAS float*)(lds + wave * 8448), gw, NGW, lane);
    __syncthreads();
    pg8::Order S; S.nsub = 1; S.G = G; S.c = bx; S.K = DINNER;
    S.s0 = pg8::Sub{(const char*)(ws + WS_P), (const char*)(ws + WS_WOT), 64, 4, 1, 4}; S.s1 = S.s0;
    pg8::EpiResidual E{p.in[I_X], (float*)(ws + WS_QKZ), (bf16_t*)(ws + WS_H), (float*)(ws + WS_SSQ)};
    pg8::gemm_phase<pg8::EpiResidual, false, true>(lds, S, E, 1);
  }
  SEAM(6);

#pragma unroll 1
  for (int ci = 0; ci < 6; ++ci) {
    const int g = ci >> 1, hh = ci & 1;
    const int dil = (g == 0) ? 1 : (g == 1 ? 4 : 16), L = SEQ / dil;
    const int phG = 7 + 2 * ci, phA = 8 + 2 * ci;
    if (IN(phG)) {
      const auto& p = fresh_params(); unsigned char* ws = p.ws;
      { pg8::Order S; S.nsub = 1; S.G = G; S.c = bx; S.K = DM;
        const int nN = (g == 2) ? 12 : 8;
        S.s0 = pg8::Sub{(const char*)(ws + WS_H), (const char*)(ws + WS_WC), 64, nN, 1, nN}; S.s1 = S.s0;
        static_assert(WS_KC == WS_QC + 32 * MiB && WS_ZC == WS_QC + 64 * MiB, "Q|K|Z chunk buffers 32 MiB apart");
        pg8::EpiRowScale3 E{(bf16_t*)(ws + WS_QC), (const float*)(ws + WS_SSQ)};
        pg8::gemm_phase<pg8::EpiRowScale3, true, true>(lds, S, E, 1); }
      { pg8::Order S; S.nsub = 1; S.G = G; S.c = bx; S.K = DM;
        S.s0 = pg8::Sub{(const char*)(ws + WS_WC) + (size_t)3072 * DM * 2, (const char*)(ws + WS_H), 4, 64, dil, 64 / dil}; S.s1 = S.s0;
        pg8::EpiColScale E{(bf16_t*)(ws + WS_VTC), (const float*)(ws + WS_SSQ), dil, 64 / dil};
        pg8::gemm_phase<pg8::EpiColScale, true, true>(lds, S, E, dil); }
    }
    SEAM(phG);
    if (IN(phA)) {
      const auto& p = fresh_params(); unsigned char* ws = p.ws;
      const bf16_t* QC = (const bf16_t*)(ws + WS_QC); const bf16_t* KC = (const bf16_t*)(ws + WS_KC); const bf16_t* VTC = (const bf16_t*)(ws + WS_VTC); const bf16_t* ZC = (const bf16_t*)(ws + WS_ZC);
      bf16_t* ORUN = (bf16_t*)p.out; float* LSE = (float*)(ws + WS_LSE);
      int lane_a = threadIdx.x & 63; asm volatile("" : "+v"(lane_a));
      const int q = lane_a & 31, h = lane_a >> 5;
      const int nqb = L / 32;
      for (int it = gw; it < 8 * SEQ / 32; it += NGW) {
        const int hl = it / (SEQ / 32), rem = it % (SEQ / 32), rr = rem / nqb, jb = rem % nqb;
        const int hd = hh * 8 + hl;
        const float slope2 = exp2f(-8.f * (float)(g * 16 + hd + 1) / 48.f) * (float)dil * LOG2E;
        const int jq = 32 * jb + q, tq = rr + dil * jq;
        bf16x8 qf[8];
        { const bf16_t* qp = QC + (size_t)tq * 1024 + hl * 128 + 8 * h;
#pragma unroll
          for (int s = 0; s < 8; ++s) qf[s] = *(const bf16x8*)(qp + 16 * s); }
        f32x16 O[4];
#pragma unroll
        for (int ct = 0; ct < 4; ++ct)
#pragma unroll
          for (int i = 0; i < 16; ++i) O[ct][i] = 0.f;
        float mrun = -1e30f, lrun = 0.f;
#pragma unroll 1
        for (int kt = 0; kt < 5; ++kt) {
          const int kb = 32 * jb - 128 + 32 * kt;
          if (kb < 0) continue;
          f32x16 sacc;
#pragma unroll
          for (int i = 0; i < 16; ++i) sacc[i] = 0.f;
          { const bf16_t* kp = KC + (size_t)(rr + dil * (kb + q)) * 1024 + hl * 128 + 8 * h;
#pragma unroll
            for (int s = 0; s < 8; ++s) sacc = MFMA32(*(const bf16x8*)(kp + 16 * s), qf[s], sacc); }
          float tmax = -1e30f;
#pragma unroll
          for (int i = 0; i < 16; ++i) { const int kk = kb + crow(i, h), delta = jq - kk; const bool valid = (delta >= 0) && (delta <= 128);
            const float v = valid ? sacc[i] - slope2 * (float)delta : -1e30f; sacc[i] = v; tmax = fmaxf(tmax, v); }
          tmax = fmaxf(tmax, __shfl_xor(tmax, 32));
          const float mnew = fmaxf(mrun, tmax), alpha = exp2f(mrun - mnew); mrun = mnew;
          float psum = 0.f;
#pragma unroll
          for (int i = 0; i < 16; ++i) { const float pv = exp2f(sacc[i] - mnew); sacc[i] = pv; psum += pv; }
          lrun = lrun * alpha + psum;
#pragma unroll
          for (int ct = 0; ct < 4; ++ct)
#pragma unroll
            for (int i = 0; i < 16; ++i) O[ct][i] *= alpha;
          bf16x8 pf[2];
#pragma unroll
          for (int s2 = 0; s2 < 2; ++s2) { u32x4 w; w.x = pk2(sacc[8 * s2], sacc[8 * s2 + 1]); w.y = pk2(sacc[8 * s2 + 2], sacc[8 * s2 + 3]); w.z = pk2(sacc[8 * s2 + 4], sacc[8 * s2 + 5]); w.w = pk2(sacc[8 * s2 + 6], sacc[8 * s2 + 7]);
            pf[s2] = __builtin_bit_cast(bf16x8, w); }
          const bf16_t* vp = VTC + (size_t)(hl * 128 + q) * SEQ + (size_t)rr * L + kb + 4 * h;
#pragma unroll
          for (int ct = 0; ct < 4; ++ct)
#pragma unroll
            for (int s2 = 0; s2 < 2; ++s2) { const bf16x4 vlo = *(const bf16x4*)(vp + (size_t)ct * 32 * SEQ + 16 * s2), vhi = *(const bf16x4*)(vp + (size_t)ct * 32 * SEQ + 16 * s2 + 8);
              const bf16x8 vf = __builtin_shufflevector(vlo, vhi, 0, 1, 2, 3, 4, 5, 6, 7);
              O[ct] = MFMA32(vf, pf[s2], O[ct]); }
        }
        const float ltot = lrun + __shfl_xor(lrun, 32);
        const float inv = 1.f / ltot; float lse2 = mrun + log2f(ltot);
        float wo = 0.f, wn = inv;
        float* lsep = LSE + (size_t)tq * 16 + hd;
        if (g > 0) { const float lold = *lsep; const float mm = fmaxf(lold, lse2); const float eo = exp2f(lold - mm), en = exp2f(lse2 - mm), den = eo + en;
          wo = eo / den; wn = en / den * inv; lse2 = mm + log2f(den); }
        if (g < 2 && h == 0) *lsep = lse2;
        bf16_t* op = ORUN + (size_t)tq * DINNER + hd * 128 + 4 * h;
        const bf16_t* zp = ZC + (size_t)tq * 1024 + hl * 128 + 4 * h;
#pragma unroll
        for (int ct = 0; ct < 4; ++ct)
#pragma unroll
          for (int i4 = 0; i4 < 4; ++i4) { float o[4];
#pragma unroll
            for (int e = 0; e < 4; ++e) o[e] = O[ct][4 * i4 + e] * wn;
            if (g > 0) { const u32x2 ov = *(const u32x2*)(op + 32 * ct + 8 * i4); o[0] += wo * bf_lo(ov.x); o[1] += wo * bf_hi(ov.x); o[2] += wo * bf_lo(ov.y); o[3] += wo * bf_hi(ov.y); }
            if (g == 2) { const u32x2 zz = *(const u32x2*)(zp + 32 * ct + 8 * i4); const float z[4] = {bf_lo(zz.x), bf_hi(zz.x), bf_lo(zz.y), bf_hi(zz.y)};
#pragma unroll
              for (int e = 0; e < 4; ++e) o[e] *= z[e] / (1.f + expf(-z[e])); }
            u32x2 w; w.x = pk2(o[0], o[1]); w.y = pk2(o[2], o[3]);
            *(u32x2*)(op + 32 * ct + 8 * i4) = w; }
      }
      if (ci < 5) convert_chunk_weights(p.in[I_BWIN], p.in[I_WKV], p.in[I_BNORM], p.in[I_KVNORM], (bf16_t*)(ws + WS_WC), (ci + 1) >> 1, (ci + 1) & 1, (LAS float*)(lds + wave * 8448), gw, NGW, lane);
    }
    SEAM(phA);
  }

  if (IN(19)) {
    const auto& p = fresh_params(); unsigned char* ws = p.ws;
    pg8::Order S; S.nsub = 1; S.G = G; S.c = bx; S.K = DINNER;
    S.s0 = pg8::Sub{(const char*)p.out, (const char*)(ws + WS_WO2T), 64, 4, 1, 4}; S.s1 = S.s0;
    pg8::EpiResidual E{(const float*)(ws + WS_QKZ), (float*)(ws + WS_QKZ), nullptr, (float*)(ws + WS_SSQ)};
    pg8::gemm_phase<pg8::EpiResidual, false, true>(lds, S, E, 1);
  }
  SEAM(19);

  if (IN(20)) {
    const auto& p = fresh_params(); unsigned char* ws = p.ws;
    const float* X2 = (const float*)(ws + WS_QKZ); const float* SSQ = (const float*)(ws + WS_SSQ); const float* gF = p.in[I_FNORM];
    f32x4 gv[4];
#pragma unroll
    for (int j = 0; j < 4; ++j) gv[j] = *(const f32x4*)(gF + 4 * lane + 256 * j);
    for (int m = gw; m < SEQ; m += NGW) {
      const f32x4 sq = *(const f32x4*)(SSQ + (size_t)m * 4); const float rstd = rsqrtf(((sq[0] + sq[1]) + (sq[2] + sq[3])) * (1.f / DM) + RMS_EPS);
      const f32x4* xr = (const f32x4*)(X2 + (size_t)m * DM) + lane; f32x4* orow = (f32x4*)(p.out + (size_t)m * DM) + lane;
#pragma unroll
      for (int j = 0; j < 4; ++j) orow[64 * j] = xr[64 * j] * rstd * gv[j];
    }
  }
#undef IN
#undef SEAM
}

extern "C" void kernel_launch(void* const* d_in, const int* in_sizes, int n_in, void* d_out, int out_size, void* d_ws, size_t ws_size, hipStream_t stream) {
  static int grid = 0;
  if (grid == 0) {
    int dev = 0, cus = 0, per_cu = 0;
    if (n_in != 13 || out_size != SEQ * DM || ws_size < 256 * MiB) { fprintf(stderr, "kernel_launch: unexpected problem (n_in %d out %d ws %zu)\n", n_in, out_size, ws_size); grid = -1; return; }
    (void)hipGetDevice(&dev); (void)hipDeviceGetAttribute(&cus, hipDeviceAttributeMultiprocessorCount, dev);
    if (hipFuncSetAttribute((const void*)yoco_fwd, hipFuncAttributeMaxDynamicSharedMemorySize, LDS_BYTES) != hipSuccess) { fprintf(stderr, "kernel_launch: hipFuncSetAttribute failed\n"); grid = -1; return; }
    if (hipOccupancyMaxActiveBlocksPerMultiprocessor(&per_cu, (const void*)yoco_fwd, 512, LDS_BYTES) != hipSuccess || per_cu < 1) { fprintf(stderr, "kernel_launch: occupancy query says %d\n", per_cu); (void)hipGetLastError(); }
    grid = cus;
    if (grid != 256) fprintf(stderr, "kernel_launch: %d CUs; the residual GEMM epilogues assume 256\n", grid);
  }
  if (grid < 0) return;
  Params p{};
  for (int i = 0; i < 13; ++i) p.in[i] = (const float*)d_in[i];
  p.out = (float*)d_out; p.ws = (unsigned char*)d_ws; p.ph_lo = 0; p.ph_hi = NPHASE;
  void* args[] = {&p};
  hipError_t e = hipLaunchCooperativeKernel((void*)yoco_fwd, dim3(grid), dim3(512), args, LDS_BYTES, stream);
  if (e != hipSuccess) fprintf(stderr, "cooperative launch failed: %s (grid %d)\n", hipGetErrorString(e), grid);
}
```

```cpp
#include <hip/hip_runtime.h>
#include <hip/hip_cooperative_groups.h>
#include <cstdio>
#include <cstdint>
namespace cg = cooperative_groups;

#define LAS __attribute__((address_space(3)))
#define DI __device__ __forceinline__
typedef unsigned short bf16_t;
typedef short bf16x8 __attribute__((ext_vector_type(8)));
typedef short bf16x4 __attribute__((ext_vector_type(4)));
typedef float f32x2 __attribute__((ext_vector_type(2)));
typedef float f32x4 __attribute__((ext_vector_type(4)));
typedef float f32x16 __attribute__((ext_vector_type(16)));
typedef unsigned u32x2 __attribute__((ext_vector_type(2)));
typedef unsigned u32x4 __attribute__((ext_vector_type(4)));
typedef __bf16 bf16v2 __attribute__((ext_vector_type(2)));

constexpr int SEQ = 16384, DM = 1024, DINNER = 2048;
constexpr int A_IN = 5136, GLA_DK = 512, GLA_H = 4, GLA_DVH = 512;
constexpr int GC = 256, NCH = SEQ / GC;
constexpr int KV_OUT = 12288, B_IN = 8192;
constexpr float RMS_EPS = 1e-6f;
constexpr float LOG2E = 1.4426950408889634f;
constexpr size_t MiB = 1u << 20;
constexpr size_t WS_W1T = 0;
constexpr size_t WS_WOT = 22 * MiB;
constexpr size_t WS_LR = 14 * MiB;
constexpr size_t WS_DCH = 15 * MiB;
constexpr size_t WS_SSQ = 16 * MiB;
constexpr size_t WS_LSE = 17 * MiB;
constexpr size_t WS_WO2T = 18 * MiB;
constexpr size_t WS_CTL = 30 * MiB;
constexpr size_t WS_WC = 0;
constexpr size_t WS_H = 32 * MiB;
constexpr size_t WS_QKZ = 64 * MiB;
constexpr size_t WS_KT = 160 * MiB;
constexpr size_t WS_P = 176 * MiB;
constexpr size_t WS_QC = 64 * MiB, WS_VTC = 192 * MiB;

DI unsigned pk2(float lo, float hi) { f32x2 v = {lo, hi}; return __builtin_bit_cast(unsigned, __builtin_convertvector(v, bf16v2)); }
DI float bf_lo(unsigned w) { return __uint_as_float(w << 16); }
DI float bf_hi(unsigned w) { return __uint_as_float(w & 0xffff0000u); }
DI float bf2f(bf16_t b) { return __uint_as_float(((unsigned)b) << 16); }
DI bf16_t f2bf(float f) { return (bf16_t)(pk2(f, 0.f) & 0xffffu); }
#define MFMA32(a, b, c) __builtin_amdgcn_mfma_f32_32x32x16_bf16((a), (b), (c), 0, 0, 0)
DI int lane_id() { int l; asm volatile("v_mbcnt_lo_u32_b32 %0, -1, 0\n\tv_mbcnt_hi_u32_b32 %0, -1, %0" : "=v"(l)); return l; }
DI int crow(int reg, int h) { return (reg & 3) + 8 * (reg >> 2) + 4 * h; }
DI float wave_sum(float v) {
#pragma unroll
  for (int o = 1; o < 64; o <<= 1) v += __shfl_xor(v, o);
  return v;
}
#define LDS_WAIT() asm volatile("s_waitcnt lgkmcnt(0)" ::: "memory")
DI float xh_sum(float x) { const unsigned u = __float_as_uint(x); const u32x2 r = __builtin_amdgcn_permlane32_swap(u, u, false, false); return __uint_as_float(r[0]) + __uint_as_float(r[1]); }
DI float xh_max(float x) { const unsigned u = __float_as_uint(x); const u32x2 r = __builtin_amdgcn_permlane32_swap(u, u, false, false); return fmaxf(__uint_as_float(r[0]), __uint_as_float(r[1])); }

namespace pg8 {
constexpr int BM = 256, BK = 64, HALF = 128, HTB = HALF * BK * 2, STAGE_BYTES = 8 * HTB, NXCD = 8, WGM = 8;
__host__ __device__ __forceinline__ int lds_byte(int r, int c) { const int st = (r >> 4) * 2 + (c >> 5), rr = r & 15, cc = c & 31, ob = rr * 64 + cc * 2; return st * 1024 + (ob ^ (((ob >> 9) & 1) << 5)); }
__host__ __device__ __forceinline__ void stage_rc(int b, int& R, int& C) { const int st = b / 1024, sb = b % 1024, swz = sb ^ (((sb >> 9) & 1) << 5); R = (st >> 1) * 16 + swz / 64; C = (st & 1) * 32 + (swz % 64) / 2; }
__host__ __device__ __forceinline__ int p16(int x) { return x < 4 ? x : (x < 8 ? x + 4 : (x < 12 ? x - 4 : x)); }
__host__ __device__ __forceinline__ int perm32(int rho) { const int n = rho >> 4, i = rho & 15; return 8 * (i >> 2) + 4 * n + (i & 3); }

struct Unit { int pm, pn, sub; const char* a; const char* b; };
struct Sub { const char* A; const char* Bt; int nM, nN, dil, tprsh; };
struct Order {
  Sub s0, s1; int nsub, G, c, K;
  DI bool next(int i, Unit& u) const {
    long L = (long)i * G + c; const int n0 = s0.nM * s0.nN;
    int si = 0;
    if (L >= n0) { if (nsub < 2) return false; L -= n0; si = 1; if (L >= (long)s1.nM * s1.nN) return false; }
    const int nM = si ? s1.nM : s0.nM, nN = si ? s1.nN : s0.nN, dil = si ? s1.dil : s0.dil, tprsh = si ? s1.tprsh : s0.tprsh;
    const char* A = si ? s1.A : s0.A; const char* Bt = si ? s1.Bt : s0.Bt;
    const int nwg = nM * nN;
    int wgid = (int)L; { const int q = nwg / NXCD, r = nwg % NXCD, xcd = wgid % NXCD, off = wgid / NXCD; wgid = (xcd < r ? xcd * (q + 1) : r * (q + 1) + (xcd - r) * q) + off; }
    const int nig = WGM * nN, gid = wgid / nig, fm = gid * WGM, gsz = (nM - fm) < WGM ? (nM - fm) : WGM;
    u.pm = fm + ((wgid % nig) % gsz); u.pn = (wgid % nig) / gsz; u.sub = si;
    u.a = A + (size_t)u.pm * BM * K * 2;
    u.b = Bt + ((size_t)(u.pn >> tprsh) + (size_t)dil * BM * (u.pn & ((1 << tprsh) - 1))) * K * 2;
    return true;
  }
};

template <class Epi, bool ALIGN_EPI, bool SP2>
DI void gemm_phase(LAS unsigned char* lds, const Order& S, const Epi& E, int wave_s, int ldb_mult, int bperm16 = 0, int ldb_mult1 = 1, int bperm16_1 = 0) {
  int tid = wave_s * 64 + lane_id(); asm volatile("" : "+v"(tid));
  const int wid = __builtin_amdgcn_readfirstlane(tid >> 6), lane = tid & 63, wr = wid >> 2, wc = wid & 3, fr = lane & 15, fq = lane >> 4;
  const int K = S.K, nt = K / BK;
  unsigned voffA[2], voffB0[2], voffB1[2];
#pragma unroll
  for (int i = 0; i < 2; ++i) { int R, C; stage_rc(tid * 16 + i * 8192, R, C); const int Rp = (R & ~31) + perm32(R & 31); const int Rb0 = bperm16 ? ((Rp & ~15) | p16(Rp & 15)) : Rp, Rb1 = bperm16_1 ? ((Rp & ~15) | p16(Rp & 15)) : Rp;
    voffA[i] = (unsigned)(R * K + C) * 2u; voffB0[i] = (unsigned)(Rb0 * K * ldb_mult + C) * 2u; voffB1[i] = (unsigned)(Rb1 * K * ldb_mult1 + C) * 2u; }
  const size_t kstep = (size_t)(BK * 2);
  const size_t hstepA = (size_t)HALF * K * 2, hstepB0 = (size_t)HALF * K * 2 * ldb_mult, hstepB1 = (size_t)HALF * K * 2 * ldb_mult1;
  const unsigned ldsw = (unsigned)wid * 1024u;
  const int aoff = lds_byte(wr * 64 + fr, fq * 8), boff = lds_byte(wc * 32 + fr, fq * 8);
#define PG8_SA(b, h) (((b) * 2 + (h)) * HTB)
#define PG8_SB(b, h) ((4 + (b) * 2 + (h)) * HTB)
#define PG8_STAGE(bufoff, gbase, voff) do { _Pragma("unroll") for (int _i = 0; _i < 2; ++_i) \
        __builtin_amdgcn_global_load_lds((const unsigned*)((const char*)(gbase) + (voff)[_i]), (LAS unsigned*)(lds + (bufoff) + ldsw + _i * 8192), 16, 0, 0); } while (0)
#define PG8_LDA(dst, b, h) do { _Pragma("unroll") for (int m = 0; m < 4; ++m) _Pragma("unroll") for (int k = 0; k < 2; ++k) dst[m][k] = *(const LAS bf16x8*)(lds + PG8_SA(b, h) + aoff + m * 2048 + k * 1024); } while (0)
#define PG8_LDB(dst, b, h) do { _Pragma("unroll") for (int n = 0; n < 2; ++n) _Pragma("unroll") for (int k = 0; k < 2; ++k) dst[n][k] = *(const LAS bf16x8*)(lds + PG8_SB(b, h) + boff + n * 2048 + k * 1024); } while (0)
#define PG8_MMA(ai, bj, At, Bt) do { __builtin_amdgcn_s_setprio(1); _Pragma("unroll") for (int m = 0; m < 4; ++m) _Pragma("unroll") for (int n = 0; n < 2; ++n) _Pragma("unroll") for (int k = 0; k < 2; ++k) \
        acc[ai][bj][m][n] = __builtin_amdgcn_mfma_f32_16x16x32_bf16(Bt[n][k], At[m][k], acc[ai][bj][m][n], 0, 0, 0); __builtin_amdgcn_s_setprio(0); } while (0)
#define PG8_WAIT_V(n) asm volatile("s_waitcnt vmcnt(" #n ")" ::: "memory")
#define PG8_WAIT_L(n) asm volatile("s_waitcnt lgkmcnt(" #n ")" ::: "memory")
#define PG8_BAR __builtin_amdgcn_s_barrier()
#define PG8_SCHED __builtin_amdgcn_sched_barrier(0)
  Unit cur, nxt; int ui = 0;
  if (!S.next(0, cur)) return;
  f32x4 acc[2][2][4][2];
#pragma unroll
  for (int a = 0; a < 2; ++a)
#pragma unroll
    for (int b = 0; b < 2; ++b)
#pragma unroll
      for (int m = 0; m < 4; ++m)
#pragma unroll
        for (int n = 0; n < 2; ++n) acc[a][b][m][n] = (f32x4){0.f, 0.f, 0.f, 0.f};
  bf16x8 At[4][2], B0[2][2], B1[2][2];
  const char* cA = cur.a; const char* cB = cur.b;
  unsigned voffB[2] = {cur.sub ? voffB1[0] : voffB0[0], cur.sub ? voffB1[1] : voffB0[1]}; size_t hstepB = cur.sub ? hstepB1 : hstepB0;
  if constexpr (SP2) {
    PG8_STAGE(PG8_SB(0, 0), cB, voffB); PG8_STAGE(PG8_SB(0, 1), cB + hstepB, voffB); PG8_STAGE(PG8_SA(0, 0), cA, voffA); PG8_STAGE(PG8_SA(0, 1), cA + hstepA, voffA);
    if (wr == 1) PG8_BAR;
    PG8_WAIT_V(2); PG8_BAR;
    PG8_STAGE(PG8_SB(1, 0), cB + kstep, voffB); PG8_STAGE(PG8_SA(1, 0), cA + kstep, voffA); PG8_STAGE(PG8_SB(1, 1), cB + hstepB + kstep, voffB);
    PG8_WAIT_V(6); PG8_BAR;
  } else {
    PG8_STAGE(PG8_SB(0, 0), cB, voffB); PG8_STAGE(PG8_SA(0, 0), cA, voffA); PG8_STAGE(PG8_SB(0, 1), cB + hstepB, voffB); PG8_STAGE(PG8_SA(0, 1), cA + hstepA, voffA);
    if (wr == 1) PG8_BAR;
    PG8_WAIT_V(4); PG8_BAR;
    PG8_STAGE(PG8_SB(1, 0), cB + kstep, voffB); PG8_STAGE(PG8_SA(1, 0), cA + kstep, voffA); PG8_STAGE(PG8_SB(1, 1), cB + hstepB + kstep, voffB);
    PG8_WAIT_V(6); PG8_BAR;
  }
  for (;;) {
    const bool has_next = S.next(ui + 1, nxt);
    const char* nA = has_next ? nxt.a : cA; const char* nB = has_next ? nxt.b : cB;
    for (int t = 0; t < nt; t += 2) {
      const bool last = (t == nt - 2);
      if (last && has_next) { voffB[0] = nxt.sub ? voffB1[0] : voffB0[0]; voffB[1] = nxt.sub ? voffB1[1] : voffB0[1]; hstepB = nxt.sub ? hstepB1 : hstepB0; }
      const char* a1 = cA + (size_t)(t + 1) * kstep;
      const char* a2 = last ? nA : cA + (size_t)(t + 2) * kstep; const char* b2 = last ? nB : cB + (size_t)(t + 2) * kstep;
      const char* a3 = a2 + kstep; const char* b3 = b2 + kstep;
      if constexpr (SP2) {
        PG8_LDB(B0, 0, 0); PG8_LDB(B1, 0, 1); PG8_SCHED; PG8_LDA(At, 0, 0); PG8_STAGE(PG8_SA(1, 1), a1 + hstepA, voffA);
        PG8_WAIT_V(8); PG8_WAIT_L(0); PG8_BAR; PG8_MMA(0, 0, At, B0); PG8_MMA(0, 1, At, B1); PG8_BAR; PG8_SCHED;
        PG8_LDA(At, 0, 1); PG8_STAGE(PG8_SB(0, 0), b2, voffB); PG8_STAGE(PG8_SB(0, 1), b2 + hstepB, voffB); PG8_STAGE(PG8_SA(0, 0), a2, voffA);
        PG8_WAIT_V(8); PG8_WAIT_L(0); PG8_BAR; PG8_MMA(1, 0, At, B0); PG8_MMA(1, 1, At, B1); PG8_BAR; PG8_SCHED;
        PG8_LDB(B0, 1, 0); PG8_LDB(B1, 1, 1); PG8_SCHED; PG8_LDA(At, 1, 0); PG8_STAGE(PG8_SA(0, 1), a2 + hstepA, voffA);
        PG8_WAIT_V(8); PG8_WAIT_L(0); PG8_BAR; PG8_MMA(0, 0, At, B0); PG8_MMA(0, 1, At, B1); PG8_BAR; PG8_SCHED;
        PG8_LDA(At, 1, 1); PG8_STAGE(PG8_SB(1, 0), b3, voffB); PG8_STAGE(PG8_SB(1, 1), b3 + hstepB, voffB); PG8_STAGE(PG8_SA(1, 0), a3, voffA);
        PG8_WAIT_V(8); PG8_WAIT_L(0); PG8_BAR; PG8_MMA(1, 0, At, B0); PG8_MMA(1, 1, At, B1); PG8_BAR; PG8_SCHED;
      } else {
        PG8_LDB(B0, 0, 0); PG8_SCHED; PG8_LDA(At, 0, 0); PG8_STAGE(PG8_SA(1, 1), a1 + hstepA, voffA);
        PG8_WAIT_L(8); PG8_BAR; PG8_WAIT_L(0); PG8_MMA(0, 0, At, B0); PG8_BAR; PG8_SCHED;
        PG8_LDB(B1, 0, 1); PG8_STAGE(PG8_SB(0, 0), b2, voffB);
        PG8_BAR; PG8_WAIT_L(0); PG8_MMA(0, 1, At, B1); PG8_BAR;
        PG8_LDA(At, 0, 1); PG8_STAGE(PG8_SA(0, 0), a2, voffA);
        PG8_BAR; PG8_WAIT_L(0); PG8_MMA(1, 0, At, B0); PG8_BAR; PG8_SCHED;
        PG8_STAGE(PG8_SB(0, 1), b2 + hstepB, voffB);
        PG8_WAIT_V(6); PG8_BAR; PG8_MMA(1, 1, At, B1); PG8_BAR;
        PG8_LDB(B0, 1, 0); PG8_SCHED; PG8_LDA(At, 1, 0); PG8_STAGE(PG8_SA(0, 1), a2 + hstepA, voffA);
        PG8_WAIT_L(8); PG8_BAR; PG8_WAIT_L(0); PG8_MMA(0, 0, At, B0); PG8_BAR; PG8_SCHED;
        PG8_LDB(B1, 1, 1); PG8_STAGE(PG8_SB(1, 0), b3, voffB);
        PG8_BAR; PG8_WAIT_L(0); PG8_MMA(0, 1, At, B1); PG8_BAR;
        PG8_LDA(At, 1, 1); PG8_STAGE(PG8_SA(1, 0), a3, voffA);
        PG8_BAR; PG8_WAIT_L(0); PG8_MMA(1, 0, At, B0); PG8_BAR; PG8_SCHED;
        PG8_STAGE(PG8_SB(1, 1), b3 + hstepB, voffB);
        PG8_WAIT_V(6); PG8_BAR; PG8_MMA(1, 1, At, B1); PG8_BAR;
      }
    }
    if constexpr (ALIGN_EPI) { if (wr == 0) PG8_BAR; }
    if constexpr (!Epi::AFTER_DRAIN) { E(acc, cur, wr, wc, fr, fq); }
    if (!has_next) break;
#pragma unroll
    for (int a = 0; a < 2; ++a)
#pragma unroll
      for (int b = 0; b < 2; ++b)
#pragma unroll
        for (int m = 0; m < 4; ++m)
#pragma unroll
          for (int n = 0; n < 2; ++n) acc[a][b][m][n] = (f32x4){0.f, 0.f, 0.f, 0.f};
    cur = nxt; cA = nA; cB = nB; ++ui;
    if constexpr (ALIGN_EPI) { if (wr == 1) PG8_BAR; }
  }
  PG8_WAIT_V(0);
  if constexpr (!ALIGN_EPI) { if (wr == 0) PG8_BAR; }
  PG8_BAR;
  if constexpr (Epi::AFTER_DRAIN) { E.fused(acc, cur, wr, wc, fr, fq, lds, wid, lane); }
#undef PG8_SA
#undef PG8_SB
#undef PG8_STAGE
#undef PG8_LDA
#undef PG8_LDB
#undef PG8_MMA
#undef PG8_WAIT_V
#undef PG8_WAIT_L
#undef PG8_BAR
#undef PG8_SCHED
}

struct EpiBf16Two {
  static constexpr bool AFTER_DRAIN = false;
  bf16_t* O0; int ldc0; bf16_t* O1; int ldc1;
  DI void operator()(const f32x4 (&acc)[2][2][4][2], const Unit& u, int wr, int wc, int fr_, int fq_) const {
    (void)fr_; (void)fq_; const int l_ = lane_id(); const int fr = l_ & 15, fq = l_ >> 4;
    const int row0 = u.pm * BM + wr * 64 + fr, col0 = u.pn * BM + wc * 32 + 8 * fq;
#pragma unroll
    for (int ai = 0; ai < 2; ++ai)
#pragma unroll
      for (int m = 0; m < 4; ++m) { const int row = row0 + ai * HALF + m * 16;
#pragma unroll
        for (int bj = 0; bj < 2; ++bj) { const f32x4 v0 = acc[ai][bj][m][0], v1 = acc[ai][bj][m][1]; const int col = col0 + bj * HALF;
          u32x4 w; w.x = pk2(v0[0], v0[1]); w.y = pk2(v0[2], v0[3]); w.z = pk2(v1[0], v1[1]); w.w = pk2(v1[2], v1[3]);
          bf16_t* dst = u.sub ? O1 + ((size_t)(col >> 5) * ldc1 + row) * 32 + (col & 31)
                              : O0 + (size_t)row * ldc0 + col;
          *(u32x4*)dst = w; } }
  }
};
struct EpiRowScale3 {
  static constexpr bool AFTER_DRAIN = false;
  bf16_t* O0; const float* ssq; int cw, tpbsh; size_t bstride;
  DI void operator()(const f32x4 (&acc)[2][2][4][2], const Unit& u, int wr, int wc, int fr_, int fq_) const {
    (void)fr_; (void)fq_; const int l_ = lane_id(); const int fr = l_ & 15, fq = l_ >> 4;
    const int t = u.pn >> tpbsh; bf16_t* base = O0 + (size_t)t * bstride;
    const int row0 = u.pm * BM + wr * 64 + fr, col0 = (u.pn & ((1 << tpbsh) - 1)) * BM + wc * 32 + 8 * fq;
#pragma unroll
    for (int ai = 0; ai < 2; ++ai)
#pragma unroll
      for (int m = 0; m < 4; ++m) { const int row = row0 + ai * HALF + m * 16;
        const f32x4 sq = *(const f32x4*)(ssq + (size_t)row * 4); const float rs = rsqrtf(((sq[0] + sq[1]) + (sq[2] + sq[3])) * (1.0f / DM) + RMS_EPS);
        bf16_t* rowp = base + (size_t)row * cw + col0;
#pragma unroll
        for (int bj = 0; bj < 2; ++bj) { const f32x4 v0 = acc[ai][bj][m][0] * rs, v1 = acc[ai][bj][m][1] * rs;
          u32x4 w; w.x = pk2(v0[0], v0[1]); w.y = pk2(v0[2], v0[3]); w.z = pk2(v1[0], v1[1]); w.w = pk2(v1[2], v1[3]);
          *(u32x4*)(rowp + bj * HALF) = w; } }
  }
};
struct EpiColScale {
  static constexpr bool AFTER_DRAIN = false;
  bf16_t* O; const float* ssq; int dil, tprsh, cw;
  DI void operator()(const f32x4 (&acc)[2][2][4][2], const Unit& u, int wr, int wc, int fr_, int fq_) const {
    (void)fr_; (void)fq_; const int l_ = lane_id(); const int fr = l_ & 15, fq = l_ >> 4;
    const int row0 = u.pm * BM + wr * 64 + fr, col0 = u.pn * BM + wc * 32 + 8 * fq;
    const int r = u.pn >> tprsh, j0 = (u.pn & ((1 << tprsh) - 1)) * BM + wc * 32 + 8 * fq;
#pragma unroll
    for (int bj = 0; bj < 2; ++bj) {
      float rs[8];
#pragma unroll
      for (int e = 0; e < 8; ++e) { const int cc = j0 + bj * HALF + e; const int tok = r + dil * ((cc & ~15) | p16(cc & 15)); const f32x4 sq = *(const f32x4*)(ssq + (size_t)tok * 4);
        rs[e] = rsqrtf(((sq[0] + sq[1]) + (sq[2] + sq[3])) * (1.0f / DM) + RMS_EPS); }
#pragma unroll
      for (int ai = 0; ai < 2; ++ai)
#pragma unroll
        for (int m = 0; m < 4; ++m) { bf16_t* dst = O + ((size_t)((col0 + bj * HALF) >> 5) * cw + row0 + ai * HALF + m * 16) * 32 + ((col0 + bj * HALF) & 31);
          const f32x4 v0 = acc[ai][bj][m][0], v1 = acc[ai][bj][m][1];
          u32x4 w; w.x = pk2(v0[0] * rs[0], v0[1] * rs[1]); w.y = pk2(v0[2] * rs[2], v0[3] * rs[3]);
          w.z = pk2(v1[0] * rs[4], v1[1] * rs[5]); w.w = pk2(v1[2] * rs[6], v1[3] * rs[7]);
          *(u32x4*)dst = w; }
      __builtin_amdgcn_sched_barrier(0);
    }
  }
};
struct EpiChunk {
  static constexpr bool AFTER_DRAIN = false;
  EpiRowScale3 e0; EpiColScale e1;
  DI void operator()(const f32x4 (&acc)[2][2][4][2], const Unit& u, int wr, int wc, int fr, int fq) const { if (u.sub) e1(acc, u, wr, wc, fr, fq); else e0(acc, u, wr, wc, fr, fq); }
};
template <bool BASE_BF16> struct EpiResidual {
  static constexpr bool AFTER_DRAIN = true;
  const void* base; bf16_t* outb; float* ssq;
  DI void operator()(const f32x4 (&)[2][2][4][2], const Unit&, int, int, int, int) const {}
  DI void fused(f32x4 (&acc)[2][2][4][2], const Unit& u, int wr, int wc, int fr_, int fq_, LAS unsigned char* lds, int wid, int lane_) const {
    (void)fr_; (void)fq_; (void)lane_;
    const int l = lane_id(), fr = l & 15, fq = l >> 4;
#pragma unroll
    for (int ps = 0; ps < 4; ++ps) {
      const int ai = ps >> 1, mh = ps & 1;
#pragma unroll
      for (int m1 = 0; m1 < 2; ++m1) { const int lr = wr * 32 + m1 * 16 + fr;
#pragma unroll
        for (int bj = 0; bj < 2; ++bj)
#pragma unroll
          for (int n = 0; n < 2; ++n) *(LAS f32x4*)(lds + lr * 1040 + (128 * bj + 32 * wc + 8 * fq + 4 * n) * 4) = acc[ai][bj][2 * mh + m1][n]; }
      __syncthreads();
      f32x4 xv[8];
#pragma unroll
      for (int i = 0; i < 8; ++i) { const int lr = 8 * wid + i; const int row = 128 * ai + 64 * (lr >> 5) + 16 * (2 * mh + ((lr >> 4) & 1)) + (lr & 15);
        const size_t off = (size_t)(u.pm * BM + row) * DM + u.pn * BM + 4 * l;
        if constexpr (BASE_BF16) { const u32x2 b2 = *(const u32x2*)((const bf16_t*)base + off); xv[i] = (f32x4){bf_lo(b2.x), bf_hi(b2.x), bf_lo(b2.y), bf_hi(b2.y)}; }
        else xv[i] = *(const f32x4*)((const float*)base + off); }
#pragma unroll
      for (int i = 0; i < 8; ++i) { const int lr = 8 * wid + i; const int row = 128 * ai + 64 * (lr >> 5) + 16 * (2 * mh + ((lr >> 4) & 1)) + (lr & 15);
        const size_t off = (size_t)(u.pm * BM + row) * DM + u.pn * BM + 4 * l;
        const f32x4 a = *(const LAS f32x4*)(lds + lr * 1040 + l * 16);
        const f32x4 v = a + xv[i];
        { u32x2 w; w.x = pk2(v[0], v[1]); w.y = pk2(v[2], v[3]); *(u32x2*)(outb + off) = w; }
        float sq = (v[0] * v[0] + v[1] * v[1]) + (v[2] * v[2] + v[3] * v[3]);
#pragma unroll
        for (int o = 1; o < 64; o <<= 1) sq += __uint_as_float((unsigned)__builtin_amdgcn_ds_bpermute((l ^ o) << 2, (int)__float_as_uint(sq)));
        if (l == 0) ssq[(size_t)(u.pm * BM + row) * 4 + u.pn] = sq; }
      __syncthreads();
    }
  }
};
struct EpiFinal {
  static constexpr bool AFTER_DRAIN = true;
  const bf16_t* base; float* out; const float* gain; float* ssq; unsigned* cnt;
  DI void operator()(const f32x4 (&)[2][2][4][2], const Unit&, int, int, int, int) const {}
  template <int SWEEP> DI void sweep(f32x4 (&acc)[2][2][4][2], const Unit& u, int wr, int wc, LAS unsigned char* lds, int wid, int l, const f32x4& g4) const {
    const int fr = l & 15, fq = l >> 4;
#pragma unroll
    for (int ps = 0; ps < 4; ++ps) {
      const int ai = ps >> 1, mh = ps & 1;
#pragma unroll
      for (int m1 = 0; m1 < 2; ++m1) { const int lr = wr * 32 + m1 * 16 + fr;
#pragma unroll
        for (int bj = 0; bj < 2; ++bj)
#pragma unroll
          for (int n = 0; n < 2; ++n) *(LAS f32x4*)(lds + lr * 1040 + (128 * bj + 32 * wc + 8 * fq + 4 * n) * 4) = acc[ai][bj][2 * mh + m1][n]; }
      __syncthreads();
      u32x2 xv[8]; f32x4 sqv[8];
#pragma unroll
      for (int i = 0; i < 8; ++i) { const int lr = 8 * wid + i; const int row = 128 * ai + 64 * (lr >> 5) + 16 * (2 * mh + ((lr >> 4) & 1)) + (lr & 15);
        xv[i] = *(const u32x2*)(base + (size_t)(u.pm * BM + row) * DM + u.pn * BM + 4 * l);
        if (SWEEP == 1) sqv[i] = *(const f32x4*)(ssq + (size_t)(u.pm * BM + row) * 4); else sqv[i] = (f32x4){0.f, 0.f, 0.f, 0.f}; }
#pragma unroll
      for (int i = 0; i < 8; ++i) { const int lr = 8 * wid + i; const int row = 128 * ai + 64 * (lr >> 5) + 16 * (2 * mh + ((lr >> 4) & 1)) + (lr & 15);
        const f32x4 a = *(const LAS f32x4*)(lds + lr * 1040 + l * 16);
        const f32x4 v = a + (f32x4){bf_lo(xv[i].x), bf_hi(xv[i].x), bf_lo(xv[i].y), bf_hi(xv[i].y)};
        if (SWEEP == 0) {
          float sq = (v[0] * v[0] + v[1] * v[1]) + (v[2] * v[2] + v[3] * v[3]);
#pragma unroll
          for (int o = 1; o < 64; o <<= 1) sq += __uint_as_float((unsigned)__builtin_amdgcn_ds_bpermute((l ^ o) << 2, (int)__float_as_uint(sq)));
          if (l == 0) ssq[(size_t)(u.pm * BM + row) * 4 + u.pn] = sq;
        } else {
          const float rstd = rsqrtf(((sqv[i][0] + sqv[i][1]) + (sqv[i][2] + sqv[i][3])) * (1.0f / DM) + RMS_EPS);
          *(f32x4*)(out + (size_t)(u.pm * BM + row) * DM + u.pn * BM + 4 * l) = v * rstd * g4; } }
      __syncthreads();
    }
  }
  DI void fused(f32x4 (&acc)[2][2][4][2], const Unit& u, int wr, int wc, int, int, LAS unsigned char* lds, int wid, int) const {
    const int l = lane_id();
    const f32x4 g4 = *(const f32x4*)(gain + u.pn * BM + 4 * l);
    sweep<0>(acc, u, wr, wc, lds, wid, l, g4);
    asm volatile("s_waitcnt vmcnt(0)" ::: "memory");
    __syncthreads();
    if (wid == 0 && l == 0) {
      __builtin_amdgcn_fence(__ATOMIC_RELEASE, "agent"); asm volatile("s_waitcnt vmcnt(0)" ::: "memory");
      (void)__hip_atomic_fetch_add(cnt + 64 * u.pm, 1u, __ATOMIC_RELAXED, __HIP_MEMORY_SCOPE_AGENT);
      unsigned sp = 0;
      while (__hip_atomic_load(cnt + 64 * u.pm, __ATOMIC_RELAXED, __HIP_MEMORY_SCOPE_AGENT) < 4u) { __builtin_amdgcn_s_sleep(2); if (++sp > (1u << 22)) break; }
      __builtin_amdgcn_fence(__ATOMIC_ACQUIRE, "agent"); asm volatile("s_waitcnt vmcnt(0)" ::: "memory");
    }
    __syncthreads();
    sweep<1>(acc, u, wr, wc, lds, wid, l, g4);
  }
};
}


#define XB_TMO      128
#define XB_XCNT(j)  (256  + 64 * (j))
#define XB_XSUB(j)  (1280 + 64 * (j))
#define XB_XGEN(j)  (2304 + 64 * (j))
#define XB_TOP      3328
#define XB_TOPGEN   3392
#define XCD_BAR_WORDS 3456
#define XB_SPIN_CAP (1u << 18)
DI unsigned xb_ld(unsigned* p)              { return __hip_atomic_load(p, __ATOMIC_RELAXED, __HIP_MEMORY_SCOPE_AGENT); }
DI unsigned xb_add(unsigned* p, unsigned v) { return __hip_atomic_fetch_add(p, v, __ATOMIC_RELAXED, __HIP_MEMORY_SCOPE_AGENT); }
DI unsigned xb_xcc_id() { return (unsigned)__builtin_amdgcn_s_getreg((3 << 11) | 20) & 0xFu; }
#define XB_SPIN(cond, bar) do { unsigned _sp = 0; while (cond) { __builtin_amdgcn_s_sleep(1); \
    if ((++_sp & 255u) == 0u) { if (xb_ld(&(bar)[XB_TMO])) break; if (_sp > XB_SPIN_CAP) { atomicAdd(&(bar)[XB_TMO], 1u); break; } } } } while (0)
struct XcdBarrier { unsigned* bar; unsigned x; volatile LAS unsigned* st; };
DI XcdBarrier xcd_barrier_post(unsigned* bar, volatile LAS unsigned* st) {
  XcdBarrier b; b.bar = bar; b.x = xb_xcc_id(); b.st = st;
  if (threadIdx.x == 0) (void)xb_add(&bar[XB_XCNT(b.x)], 1u);
  return b;
}
DI void xcd_barrier_complete(unsigned* bar, unsigned x, unsigned& nloc, unsigned& nx) {
  const unsigned G = gridDim.x * gridDim.y * gridDim.z;
  unsigned sum, cnt, mine, sp = 0u;
  for (;;) {
    sum = 0u; cnt = 0u; mine = 0u;
#pragma unroll
    for (unsigned j = 0; j < 16; ++j) { const unsigned c = xb_ld(&bar[XB_XCNT(j)]); sum += c; cnt += (c > 0u) ? 1u : 0u; mine = (j == x) ? c : mine; }
    if (sum == G) break;
    __builtin_amdgcn_s_sleep(1);
    if ((++sp & 255u) == 0u) { if (xb_ld(&bar[XB_TMO])) break; if (sp > XB_SPIN_CAP) { atomicAdd(&bar[XB_TMO], 1u); break; } }
  }
  nloc = mine > 0u ? mine : 1u; nx = cnt > 0u ? cnt : 1u;
}
DI void xcd_barrier(const XcdBarrier& b, bool is_t0) {
  asm volatile("s_waitcnt vmcnt(0)" ::: "memory");
  __syncthreads();
  if (is_t0) {
    unsigned* bar = b.bar;
    __builtin_amdgcn_s_waitcnt(0);
    unsigned nloc = b.st[0], nx = b.st[1];
    if (nloc == 0u) { xcd_barrier_complete(bar, b.x, nloc, nx); b.st[0] = nloc; b.st[1] = nx; }
    const unsigned old = xb_add(&bar[XB_XSUB(b.x)], 1u);
    const unsigned gen = old / nloc;
    if (old + 1u == (gen + 1u) * nloc) {
      __builtin_amdgcn_fence(__ATOMIC_RELEASE, "agent");
      asm volatile("s_waitcnt vmcnt(0)" ::: "memory");
      const unsigned og = xb_add(&bar[XB_TOP], 1u);
      const unsigned tg = og / nx;
      if (og + 1u == (tg + 1u) * nx) xb_add(&bar[XB_TOPGEN], 1u);
      else XB_SPIN(xb_ld(&bar[XB_TOPGEN]) == tg, bar);
      __builtin_amdgcn_fence(__ATOMIC_ACQUIRE, "agent");
      xb_add(&bar[XB_XGEN(b.x)], 1u);
      asm volatile("s_waitcnt vmcnt(0)" ::: "memory");
    } else {
      XB_SPIN(xb_ld(&bar[XB_XGEN(b.x)]) == gen, bar);
      __builtin_amdgcn_fence(__ATOMIC_ACQUIRE, "agent");
      asm volatile("s_waitcnt vmcnt(0)" ::: "memory");
    }
  }
  __syncthreads();
}

struct Params { const float* in[13]; float* out; unsigned char* ws; int ph_lo, ph_hi; };
enum { I_X = 0, I_ANORM, I_AWIN, I_AWGU, I_ABG, I_AGOUT, I_AWOUT, I_KVNORM, I_WKV, I_BNORM, I_BWIN, I_BWOUT, I_FNORM };
constexpr int NPHASE = 16;
constexpr int LDS_BYTES = 147456;

DI void transpose_item(const float* W, int ldw, int c0, const float* gk, float sc, bf16_t* WT, int K, int r0, LAS float* scr, int kb, int nb, int lane) {
  const int k0 = 64 * kb, n0 = 32 * nb;
  float wv[32];
  { const float* wp = W + (size_t)(k0 + (lane >> 5)) * ldw + c0 + n0 + (lane & 31);
#pragma unroll
    for (int i = 0; i < 32; ++i) wv[i] = wp[(size_t)(2 * i) * ldw]; }
#pragma unroll
  for (int i = 0; i < 32; ++i) { const int kk = 2 * i + (lane >> 5); const float g = gk ? gk[k0 + kk] * sc : sc; scr[kk * 33 + (lane & 31)] = wv[i] * g; }
  LDS_WAIT(); asm volatile("" ::: "memory");
  const int c = lane & 7;
#pragma unroll
  for (int j = 0; j < 4; ++j) { const int n = (lane >> 3) + 8 * j; const LAS float* s = scr + (8 * c) * 33 + n;
    u32x4 o; o.x = pk2(s[0 * 33], s[1 * 33]); o.y = pk2(s[2 * 33], s[3 * 33]); o.z = pk2(s[4 * 33], s[5 * 33]); o.w = pk2(s[6 * 33], s[7 * 33]);
    *(u32x4*)(WT + (size_t)(r0 + n0 + n) * K + k0 + 8 * c) = o; }
  LDS_WAIT(); asm volatile("" ::: "memory");
}
DI void convert_chunk_weights(const float* bwin, const float* wkv, const float* bnorm, const float* kvnorm, bf16_t* WC, int g, int hbase, int cw, LAS float* scr, int gw, int NGW, int lane) {
  const float qscale = 0.08838834764831845f * LOG2E;
  const int nseg = (g == 2) ? 4 : 3, nbs = cw >> 5, ips = 16 * nbs;
  for (int it = gw; it < nseg * ips; it += NGW) {
    const int seg = it / ips, r = it - seg * ips, kb = r / nbs, nb = r - kb * nbs;
    const int c0 = g * 2048 + hbase * 128;
    if (seg == 0) transpose_item(bwin, B_IN, c0, bnorm, qscale, WC, DM, 0, scr, kb, nb, lane);
    else if (seg == 1) transpose_item(wkv, KV_OUT, c0, kvnorm, 1.f, WC, DM, cw, scr, kb, nb, lane);
    else if (seg == nseg - 1) transpose_item(wkv, KV_OUT, 6144 + c0, kvnorm, 1.f, WC, DM, (nseg - 1) * cw, scr, kb, nb, lane);
    else transpose_item(bwin, B_IN, 6144 + hbase * 128, bnorm, 1.f, WC, DM, 2 * cw, scr, kb, nb, lane);
  }
}

#define CAS __attribute__((address_space(4)))
#if defined(__HIP_DEVICE_COMPILE__)
DI const CAS Params& fresh_params() { const CAS Params* q = (const CAS Params*)__builtin_amdgcn_kernarg_segment_ptr(); asm volatile("" : "+s"(q)); return *q; }
#else
DI const Params& fresh_params() { return *(const Params*)nullptr; }
#endif
__global__ void __launch_bounds__(512, 2) yoco_fwd(Params p_unused) {
  extern __shared__ __attribute__((aligned(16))) unsigned char lds_raw[];
  LAS unsigned char* lds = (LAS unsigned char*)lds_raw;
  cg::grid_group grid = cg::this_grid();
  const int G = gridDim.x, bx = blockIdx.x, NGW = G * 8;
  const int att_ipc = __builtin_amdgcn_readfirstlane((512 + (int)gridDim.x - 1) / (int)gridDim.x);
  const int wave_s = __builtin_amdgcn_readfirstlane(threadIdx.x >> 6);
#define FRESH_IDS int tid = wave_s * 64 + lane_id(); asm volatile("" : "+v"(tid)); const int lane = tid & 63, wave = wave_s, gw = bx * 8 + wave; (void)lane; (void)gw;
  const int lo = fresh_params().ph_lo, hi = fresh_params().ph_hi;
  volatile LAS unsigned* bst = (volatile LAS unsigned*)(lds + LDS_BYTES - 64);
  if (threadIdx.x < 2) bst[threadIdx.x] = 0u;
  __syncthreads();
  const XcdBarrier xbar = xcd_barrier_post((unsigned*)(fresh_params().ws + WS_CTL), bst);
#ifndef PHASE_MASK
#define PHASE_MASK 0xffffffffu
#endif
#define PH_EN(k) (((PHASE_MASK) >> ((k) > 8 && (k) < 15 ? 7 + (((k) - 7) & 1) : ((k) >= 15 ? (k) - 6 : (k)))) & 1u)
#define IN(k) (PH_EN(k) && lo <= (k) && (k) < hi)
#ifndef PROBE_REGION
#define PROBE_REGION 0
#endif
#if PROBE_REGION
#define RGN_BEGIN(id) unsigned long long rgn_t0_##id = 0; if (PROBE_REGION == (id)) { __syncthreads(); rgn_t0_##id = __builtin_amdgcn_s_memrealtime(); }
#define RGN_END(id) if (PROBE_REGION == (id)) { __syncthreads(); if (threadIdx.x == 0) { const unsigned long long n_ = __builtin_amdgcn_s_memrealtime(); const unsigned long long e_ = n_ + 2 * (n_ - rgn_t0_##id); while (__builtin_amdgcn_s_memrealtime() < e_) __builtin_amdgcn_s_sleep(8); } __syncthreads(); }
#else
#define RGN_BEGIN(id)
#define RGN_END(id)
#endif
#define GSYNC(k) do { if (lo < 0) grid.sync(); xcd_barrier(xbar, wave_s == 0 && lane_id() == 0); } while (0)
#ifndef PROBE_CLASS
#define PROBE_CLASS 0
#endif
#define PROBE_MULT 2
#define PH_CLASS(k) ((k) == 0 ? 1 : (k) == 1 ? 2 : (k) <= 5 ? 3 : (k) == 6 ? 4 : (k) >= 15 ? 7 : (((k) - 7) & 1) ? 6 : 5)
#if PROBE_CLASS
  unsigned long long t_prev = __builtin_amdgcn_s_memrealtime();
#define SEAM(k) do { if (IN(k) && IN((k) + 1)) { GSYNC(k); { if (threadIdx.x == 0) { unsigned long long t_now = __builtin_amdgcn_s_memrealtime(); \
      if (PH_CLASS(k) == PROBE_CLASS) { const unsigned long long t_end = t_now + PROBE_MULT * (t_now - t_prev); while (__builtin_amdgcn_s_memrealtime() < t_end) __builtin_amdgcn_s_sleep(8); t_now = __builtin_amdgcn_s_memrealtime(); } \
      t_prev = t_now; } __syncthreads(); } } } while (0)
#else
#define SEAM(k) do { if (IN(k) && IN((k) + 1)) GSYNC(k); } while (0)
#endif

  if (IN(0)) {
    const auto& p = fresh_params(); unsigned char* ws = p.ws; FRESH_IDS
    LAS float* wlrT = (LAS float*)lds;
    LAS float* scr = (LAS float*)(lds + 65536 + wave * 8448);
    const float* awin = p.in[I_AWIN];
    for (int k = tid; k < DM; k += 512) {
      const f32x4* src = (const f32x4*)(awin + (size_t)k * A_IN + 5120);
#pragma unroll
      for (int q = 0; q < 4; ++q) { const f32x4 v = src[q]; wlrT[(4 * q + 0) * DM + k] = v[0]; wlrT[(4 * q + 1) * DM + k] = v[1]; wlrT[(4 * q + 2) * DM + k] = v[2]; wlrT[(4 * q + 3) * DM + k] = v[3]; }
    }
    bf16_t* W1T = (bf16_t*)(ws + WS_W1T); bf16_t* WOT = (bf16_t*)(ws + WS_WOT); bf16_t* WO2T = (bf16_t*)(ws + WS_WO2T);
    for (int it = gw; it < 2560 + 1024 + 1024; it += NGW) {
      if (it < 2560) { const int kb = it / 160, nbb = it % 160; int c0, r0, nb;
        if (nbb < 16) { c0 = 0; r0 = 0; nb = nbb; } else if (nbb < 32) { c0 = 512; r0 = 512; nb = nbb - 16; } else if (nbb < 96) { c0 = 3072; r0 = 1024; nb = nbb - 32; } else { c0 = 1024; r0 = 3072; nb = nbb - 96; }
        transpose_item(awin, A_IN, c0, nullptr, 1.f, W1T, DM, r0, scr, kb, nb, lane); }
      else if (it < 3584) { const int r = it - 2560; transpose_item(p.in[I_AWOUT], DM, 0, nullptr, 1.f, WOT, DINNER, 0, scr, r >> 5, r & 31, lane); }
      else { const int r = it - 3584; transpose_item(p.in[I_BWOUT], DM, 0, nullptr, 1.f, WO2T, DINNER, 0, scr, r >> 5, r & 31, lane); }
    }
    __syncthreads();
    const float* x = p.in[I_X]; const float* gA = p.in[I_ANORM];
    bf16_t* H = (bf16_t*)(ws + WS_H); float* LR = (float*)(ws + WS_LR);
    f32x4 gv[4];
#pragma unroll
    for (int j = 0; j < 4; ++j) gv[j] = *(const f32x4*)(gA + 4 * lane + 256 * j);
    const int lid = lane_id();
    for (int m0 = gw; m0 < SEQ; m0 += 4 * NGW) {
      f32x4 xv[4][4];
#pragma unroll
      for (int i = 0; i < 4; ++i) { const int m = m0 + i * NGW; const f32x4* xr = (const f32x4*)(x + (size_t)(m < SEQ ? m : gw) * DM) + lane;
#pragma unroll
        for (int j = 0; j < 4; ++j) xv[i][j] = xr[64 * j]; }
#pragma unroll
      for (int i = 0; i < 4; ++i) { const int m = m0 + i * NGW;
        if (m < SEQ) {
          f32x4 v[4]; float s2 = 0.f;
#pragma unroll
          for (int j = 0; j < 4; ++j) { v[j] = xv[i][j]; s2 += (v[j][0] * v[j][0] + v[j][1] * v[j][1]) + (v[j][2] * v[j][2] + v[j][3] * v[j][3]); }
          const float rstd = rsqrtf(wave_sum(s2) * (1.f / DM) + RMS_EPS);
#pragma unroll
          for (int j = 0; j < 4; ++j) v[j] = v[j] * rstd * gv[j];
          u32x2* o8 = (u32x2*)(H + (size_t)m * DM) + lane;
#pragma unroll
          for (int j = 0; j < 4; ++j) { u32x2 w; w.x = pk2(v[j][0], v[j][1]); w.y = pk2(v[j][2], v[j][3]); o8[64 * j] = w; }
          float pa[16];
#pragma unroll
          for (int o = 0; o < 16; ++o) { float a = 0.f;
#pragma unroll
            for (int j = 0; j < 4; ++j) { const f32x4 w = *(const LAS f32x4*)(wlrT + o * DM + 4 * lane + 256 * j); a += (v[j][0] * w[0] + v[j][1] * w[1]) + (v[j][2] * w[2] + v[j][3] * w[3]); }
            pa[o] = a; __builtin_amdgcn_sched_barrier(0); }
          float c8v[8];
#pragma unroll
          for (int j = 0; j < 8; ++j) { const u32x2 rr2 = __builtin_amdgcn_permlane32_swap(__float_as_uint(pa[j]), __float_as_uint(pa[8 + j]), false, false); c8v[j] = __uint_as_float(rr2[0]) + __uint_as_float(rr2[1]); }
          float c4v[4], c2v[2], c1v;
          { const bool up = (lid & 16) != 0;
#pragma unroll
            for (int j = 0; j < 4; ++j) { const float snd = up ? c8v[j] : c8v[4 + j], kp = up ? c8v[4 + j] : c8v[j];
              c4v[j] = kp + __uint_as_float((unsigned)__builtin_amdgcn_ds_bpermute((lid ^ 16) << 2, (int)__float_as_uint(snd))); } }
          { const bool up = (lid & 8) != 0;
#pragma unroll
            for (int j = 0; j < 2; ++j) { const float snd = up ? c4v[j] : c4v[2 + j], kp = up ? c4v[2 + j] : c4v[j];
              c2v[j] = kp + __uint_as_float((unsigned)__builtin_amdgcn_ds_bpermute((lid ^ 8) << 2, (int)__float_as_uint(snd))); } }
          { const bool up = (lid & 4) != 0; const float snd = up ? c2v[0] : c2v[1], kp = up ? c2v[1] : c2v[0];
            c1v = kp + __uint_as_float((unsigned)__builtin_amdgcn_ds_bpermute((lid ^ 4) << 2, (int)__float_as_uint(snd))); }
          c1v += __uint_as_float((unsigned)__builtin_amdgcn_ds_bpermute((lid ^ 2) << 2, (int)__float_as_uint(c1v)));
          c1v += __uint_as_float((unsigned)__builtin_amdgcn_ds_bpermute((lid ^ 1) << 2, (int)__float_as_uint(c1v)));
          if ((lid & 3) == 0) LR[(size_t)m * 16 + (lid >> 2)] = c1v;
        }
      }
    }
  }
  SEAM(0);

  if (IN(1)) {
    const auto& p = fresh_params(); unsigned char* ws = p.ws; FRESH_IDS
    pg8::Order S; S.nsub = 2; S.G = G; S.c = bx; S.K = DM;
    S.s0 = pg8::Sub{(const char*)(ws + WS_H), (const char*)(ws + WS_W1T), 64, 12, 1, 8};
    S.s1 = pg8::Sub{(const char*)(ws + WS_W1T) + (size_t)3072 * DM * 2, (const char*)(ws + WS_H), 8, 64, 1, 8};
    pg8::EpiBf16Two E{(bf16_t*)(ws + WS_QKZ), 3072, (bf16_t*)p.out, DINNER};
    pg8::gemm_phase<pg8::EpiBf16Two, true, true>(lds, S, E, wave_s, 1);
  }
  SEAM(1);

  if (IN(2)) {
    const auto& p = fresh_params(); unsigned char* ws = p.ws; FRESH_IDS
    LAS float* lrs = (LAS float*)lds;
    LAS float* tot = (LAS float*)(lds + 16384);
    bf16_t* QKZ = (bf16_t*)(ws + WS_QKZ); bf16_t* KT = (bf16_t*)(ws + WS_KT); float* DCH = (float*)(ws + WS_DCH);
    const float* LR = (const float*)(ws + WS_LR);
    const int ch = tid & 127, seg = wave >> 1;
    for (int it = bx; it < NCH * GLA_H; it += G) {
      const int c = it >> 2, hd = it & 3, j = hd * 128 + ch;
      __syncthreads();
      { const f32x4* src = (const f32x4*)(LR + (size_t)c * GC * 16); LAS f32x4* dst = (LAS f32x4*)lrs; dst[tid] = src[tid]; dst[tid + 512] = src[tid + 512]; }
      float wg[16];
#pragma unroll
      for (int e = 0; e < 16; ++e) wg[e] = p.in[I_AWGU][e * GLA_DK + j];
      const float bias = p.in[I_ABG][j];
      __syncthreads();
      float cumv[64]; float cum = 0.f;
#pragma unroll
      for (int i = 0; i < 64; ++i) { const LAS f32x4* r4 = (const LAS f32x4*)(lrs + (seg * 64 + i) * 16); float pre = bias;
#pragma unroll
        for (int q = 0; q < 4; ++q) { const f32x4 v = r4[q]; pre += (v[0] * wg[4 * q] + v[1] * wg[4 * q + 1]) + (v[2] * wg[4 * q + 2] + v[3] * wg[4 * q + 3]); }
        const float ls = fminf(pre, 0.f) - 0.6931471805599453f * __builtin_amdgcn_logf(1.f + __builtin_amdgcn_exp2f(-LOG2E * fabsf(pre)));
        cum += ls * (1.f / 16.f); cumv[i] = cum; }
      tot[seg * 128 + ch] = cum;
      __syncthreads();
      float off = 0.f, total = 0.f;
#pragma unroll
      for (int s = 0; s < 4; ++s) { const float t = tot[s * 128 + ch]; total += t; if (s < seg) off += t; }
      const int t0 = c * GC + seg * 64;
      LAS unsigned char* til = lds + 18432;
      const int srow = tid >> 4, sslot = tid & 15;
#pragma unroll 1
      for (int qk = 0; qk < 2; ++qk) {
        bf16_t* gt = QKZ + (size_t)(c * GC + srow) * 3072 + qk * 512 + hd * 128 + sslot * 8;
        { u32x4 tv[8];
#pragma unroll
          for (int i = 0; i < 8; ++i) tv[i] = *(const u32x4*)(gt + (size_t)i * 32 * 3072);
          __syncthreads();
#pragma unroll
          for (int i = 0; i < 8; ++i) *(LAS u32x4*)(til + (srow + 32 * i) * 256 + sslot * 16) = tv[i]; }
        __syncthreads();
        if (qk == 0) {
#pragma unroll
          for (int i = 0; i < 64; ++i) { LAS bf16_t* e = (LAS bf16_t*)(til + (seg * 64 + i) * 256 + ch * 2); const float B = off + cumv[i];
            *e = f2bf(bf2f(*e) * (__builtin_amdgcn_exp2f(LOG2E * B) * 0.08838834764831845f)); }
        } else {
#pragma unroll
          for (int i8 = 0; i8 < 8; ++i8) { float kk[8];
#pragma unroll
            for (int e8 = 0; e8 < 8; ++e8) { const int i = i8 * 8 + e8; LAS bf16_t* e = (LAS bf16_t*)(til + (seg * 64 + i) * 256 + ch * 2); const float B = off + cumv[i];
              const float kv = bf2f(*e) * __builtin_amdgcn_exp2f(fminf(-LOG2E * B, 115.f)); *e = f2bf(kv); kk[e8] = kv; }
            u32x4 w; w.x = pk2(kk[0], kk[1]); w.y = pk2(kk[2], kk[3]); w.z = pk2(kk[4], kk[5]); w.w = pk2(kk[6], kk[7]);
            *(u32x4*)(KT + ((size_t)((t0 + i8 * 8) >> 6) * GLA_DK + j) * 64 + ((t0 + i8 * 8) & 63)) = w; }
        }
        __syncthreads();
#pragma unroll
        for (int i = 0; i < 8; ++i) *(u32x4*)(gt + (size_t)i * 32 * 3072) = *(const LAS u32x4*)(til + (srow + 32 * i) * 256 + sslot * 16);
      }
      if (seg == 0) DCH[c * GLA_DK + j] = __builtin_amdgcn_exp2f(LOG2E * total);
    }
  }
  if (IN(2) && IN(3)) { if (G == NCH * GLA_H) { asm volatile("s_waitcnt vmcnt(0)" ::: "memory"); __syncthreads(); } else { GSYNC(2); } }

  if (IN(3)) {
    const auto& p = fresh_params(); unsigned char* ws = p.ws; FRESH_IDS
    const bf16_t* KT = (const bf16_t*)(ws + WS_KT); const bf16_t* VT = (const bf16_t*)p.out; bf16_t* P = (bf16_t*)(ws + WS_P);
    const int r = lane & 31, h = lane >> 5, mt = wave & 3, nh = wave >> 2;
    const int prow = tid >> 3, pslot = tid & 7;
    const int pl0 = prow * 128 + ((pslot ^ ((prow >> 1) & 7)) << 4);
    const int vrow = tid >> 2, vs4 = tid & 3;
    const int vl0 = vrow * 128 + ((vs4 ^ ((vrow >> 1) & 7)) << 4), vl1 = vrow * 128 + (((4 + vs4) ^ ((vrow >> 1) & 7)) << 4);
    u32x4 pre[16];
#define P3_FETCH(IT) do { const int c_ = (IT) >> 4, hd_ = ((IT) >> 2) & 3, ns_ = (IT) & 3; \
      const bf16_t* ga_ = KT + ((size_t)(c_ * 4) * GLA_DK + hd_ * 128 + prow) * 64 + pslot * 8; const bf16_t* gb_ = VT + ((size_t)(c_ * 8) * DINNER + hd_ * 512 + ns_ * 128 + vrow) * 32 + vs4 * 8; \
      _Pragma("unroll") for (int tb_ = 0; tb_ < 4; ++tb_) { pre[4 * tb_] = *(const u32x4*)(ga_ + (size_t)tb_ * GLA_DK * 64); pre[4 * tb_ + 1] = *(const u32x4*)(ga_ + (size_t)tb_ * GLA_DK * 64 + 64 * 64); \
        pre[4 * tb_ + 2] = *(const u32x4*)(gb_ + (size_t)(2 * tb_) * DINNER * 32); pre[4 * tb_ + 3] = *(const u32x4*)(gb_ + (size_t)(2 * tb_ + 1) * DINNER * 32); } } while (0)
    const int ipw = (NCH * 16 + G - 1) / G, it0 = bx * ipw, it1 = (it0 + ipw < NCH * 16) ? it0 + ipw : NCH * 16;
    if (it0 < it1) P3_FETCH(it0);
    for (int it = it0; it < it1; ++it) {
      const int c = it >> 4, hd = (it >> 2) & 3, ns = it & 3;
      __syncthreads();
#pragma unroll
      for (int tb = 0; tb < 4; ++tb) { *(LAS u32x4*)(lds + tb * 16384 + pl0) = pre[4 * tb]; *(LAS u32x4*)(lds + tb * 16384 + pl0 + 8192) = pre[4 * tb + 1];
        *(LAS u32x4*)(lds + 65536 + tb * 16384 + vl0) = pre[4 * tb + 2]; *(LAS u32x4*)(lds + 65536 + tb * 16384 + vl1) = pre[4 * tb + 3]; }
      __syncthreads();
      if (it + 1 < it1) P3_FETCH(it + 1);
      __builtin_amdgcn_sched_barrier(0);
      f32x16 a0, a1;
#pragma unroll
      for (int i = 0; i < 16; ++i) { a0[i] = 0.f; a1[i] = 0.f; }
      const int ra = 32 * mt + r, rb = 64 * nh + r;
      const int xa = (ra >> 1) & 7, xb = (rb >> 1) & 7;
#pragma unroll
      for (int tb = 0; tb < 4; ++tb)
#pragma unroll
        for (int j = 0; j < 4; ++j) {
          const bf16x8 fa = *(const LAS bf16x8*)(lds + tb * 16384 + ra * 128 + (((4 * h + j) ^ xa) << 4));
          const bf16x8 fb0 = *(const LAS bf16x8*)(lds + 65536 + tb * 16384 + rb * 128 + (((4 * h + j) ^ xb) << 4));
          const bf16x8 fb1 = *(const LAS bf16x8*)(lds + 65536 + tb * 16384 + (rb + 32) * 128 + (((4 * h + j) ^ xb) << 4));
          a0 = MFMA32(fa, fb0, a0); a1 = MFMA32(fa, fb1, a1); }
      bf16_t* o0 = P + ((size_t)(c * 4 + hd) * 512 + ns * 128 + nh * 64 + r) * 128 + 32 * mt + 4 * h; bf16_t* o1 = o0 + 32 * 128;
#pragma unroll
      for (int i4 = 0; i4 < 4; ++i4) { u32x2 w0, w1; w0.x = pk2(a0[4 * i4], a0[4 * i4 + 1]); w0.y = pk2(a0[4 * i4 + 2], a0[4 * i4 + 3]); w1.x = pk2(a1[4 * i4], a1[4 * i4 + 1]); w1.y = pk2(a1[4 * i4 + 2], a1[4 * i4 + 3]);
        *(u32x2*)(o0 + 8 * i4) = w0; *(u32x2*)(o1 + 8 * i4) = w1; }
    }
#undef P3_FETCH
  }
  SEAM(3);

  if (IN(4)) {
    const auto& p = fresh_params(); unsigned char* ws = p.ws; FRESH_IDS
    const unsigned* P = (const unsigned*)(ws + WS_P); const float* DCH = (const float*)(ws + WS_DCH); unsigned* SB = (unsigned*)(ws + WS_H);
    for (int idx = bx * 512 + tid; idx < 131072; idx += G * 512) {
      const int e = idx * 2, k = e & 127, hd = e >> 16;
      float s0 = 0.f, s1 = 0.f;
#pragma unroll 8
      for (int c = 0; c < NCH; ++c) { const unsigned pw = P[(size_t)c * 131072 + idx]; const f32x2 pv = {bf_lo(pw), bf_hi(pw)}; const f32x2 dv = *(const f32x2*)(DCH + c * GLA_DK + hd * 128 + k);
        SB[(size_t)c * 131072 + idx] = pk2(s0, s1); s0 = dv[0] * (s0 + pv[0]); s1 = dv[1] * (s1 + pv[1]); }
    }
  }
  SEAM(4);

  if (IN(5)) {
    const auto& p = fresh_params(); unsigned char* ws = p.ws; FRESH_IDS
    const bf16_t* QKZ = (const bf16_t*)(ws + WS_QKZ); const bf16_t* VT = (const bf16_t*)p.out; const bf16_t* SB = (const bf16_t*)(ws + WS_H);
    bf16_t* OG = (bf16_t*)(ws + WS_P); const float* gout = p.in[I_AGOUT];
    LAS unsigned char* qs = lds;
    LAS unsigned char* ksl = lds + 16384;
    LAS unsigned char* ablk = lds + 81920;
    LAS float* red = (LAS float*)(lds + 133120);
    const int r = lane & 31, h = lane >> 5;
    const int wrow = lane >> 3, wslot = lane & 7;
    const int wl0 = wrow * 128 + ((wslot ^ (wrow >> 1)) << 4), wl1 = wrow * 128 + ((wslot ^ (wrow >> 1) ^ 4) << 4);
    const int srow = tid >> 4, sslot = tid & 15, sl0 = srow * 256 + ((sslot ^ (srow & 15)) << 4);
    const int ipw5 = (NCH * 16 + G - 1) / G, it5a = bx * ipw5, it5b = (it5a + ipw5 < NCH * 16) ? it5a + ipw5 : NCH * 16;
    u32x4 tq2[2], tk[8];
#define P5_STAGE_LOAD(IT) do { const int c_ = (IT) >> 4, hd_ = ((IT) >> 2) & 3, ts_ = (IT) & 3; \
      const bf16_t* qg_ = QKZ + (size_t)(c_ * GC + ts_ * 64 + srow) * 3072 + hd_ * 128 + sslot * 8; const bf16_t* kg_ = QKZ + (size_t)(c_ * GC + srow) * 3072 + 512 + hd_ * 128 + sslot * 8; \
      _Pragma("unroll") for (int i_ = 0; i_ < 2; ++i_) tq2[i_] = *(const u32x4*)(qg_ + (size_t)i_ * 32 * 3072); \
      _Pragma("unroll") for (int i_ = 0; i_ < 8; ++i_) { if (i_ < 2 * (ts_ + 1)) tk[i_] = *(const u32x4*)(kg_ + (size_t)i_ * 32 * 3072); else tk[i_] = (u32x4){0u, 0u, 0u, 0u}; } } while (0)
    if (it5a < it5b) P5_STAGE_LOAD(it5a);
    else {
#pragma unroll
      for (int i = 0; i < 8; ++i) { tk[i] = (u32x4){0u, 0u, 0u, 0u}; if (i < 2) tq2[i] = (u32x4){0u, 0u, 0u, 0u}; } }
    for (int it = it5a; it < it5b; ++it) {
      const int c = it >> 4, hd = (it >> 2) & 3, ts = it & 3;
      const int t0 = c * GC + ts * 64, ns = (ts + 1) * 64, ntiles = 4 * (ts + 1);
      __syncthreads();
#pragma unroll
      for (int i = 0; i < 2; ++i) *(LAS u32x4*)(qs + sl0 + i * 8192) = tq2[i];
#pragma unroll
      for (int i = 0; i < 8; ++i) if (32 * i < ns) *(LAS u32x4*)(ksl + sl0 + i * 8192) = tk[i];
      const bf16_t* sp0 = SB + ((size_t)(c * 4 + hd) * 512 + 64 * wave + wrow) * 128 + wslot * 8;
      u32x4 pre[8];
#pragma unroll
      for (int i = 0; i < 8; ++i) pre[i] = *(const u32x4*)(sp0 + (size_t)i * 8 * 128);
      __syncthreads();
#pragma unroll
      for (int rep = 0; rep < 2; ++rep) { const int ti = wave + 8 * rep;
        if (ti < ntiles) { const int st = ti >> 1, tt = ti & 1;
          const LAS unsigned char* ar = ksl + (32 * st + r) * 256; const LAS unsigned char* br = qs + (32 * tt + r) * 256;
          f32x16 acc;
#pragma unroll
          for (int i = 0; i < 16; ++i) acc[i] = 0.f;
#pragma unroll
          for (int ks = 0; ks < 8; ++ks) { const int so = (((2 * ks + h) ^ (r & 15)) << 4); acc = MFMA32(*(const LAS bf16x8*)(ar + so), *(const LAS bf16x8*)(br + so), acc); }
          const int tl = ts * 64 + 32 * tt + r;
#pragma unroll
          for (int i4 = 0; i4 < 4; ++i4) { float v[4];
#pragma unroll
            for (int e = 0; e < 4; ++e) { const int sl = 32 * st + 8 * i4 + 4 * h + e; v[e] = (sl <= tl) ? acc[4 * i4 + e] : 0.f; }
            u32x2 w; w.x = pk2(v[0], v[1]); w.y = pk2(v[2], v[3]);
            *(LAS u32x2*)(ablk + (32 * tt + r) * 528 + (32 * st + 8 * i4 + 4 * h) * 2) = w; } } }
      __syncthreads();
      f32x16 acc[2][2];
#pragma unroll
      for (int a = 0; a < 2; ++a)
#pragma unroll
        for (int b = 0; b < 2; ++b)
#pragma unroll
          for (int i = 0; i < 16; ++i) acc[a][b][i] = 0.f;
      const bf16_t* vp0 = VT + ((size_t)(c * 8) * DINNER + hd * 512 + 64 * wave + (lane >> 2)) * 32 + (lane & 3) * 8;
      LAS unsigned char* wl = lds + 16384 + wave * 8192;
      const int nbat = 2 + ns / 64;
#define P5_FETCH(b) do { if ((b) < 2) { _Pragma("unroll") for (int i_ = 0; i_ < 8; ++i_) pre[i_] = *(const u32x4*)(sp0 + (size_t)i_ * 8 * 128 + 64 * (b)); } \
        else { _Pragma("unroll") for (int i_ = 0; i_ < 8; ++i_) pre[i_] = *(const u32x4*)(vp0 + (size_t)(2 * ((b) - 2) + (i_ >> 2)) * DINNER * 32 + (i_ & 3) * 16 * 32); } } while (0)
#pragma unroll
      for (int b = 0; b < 6; ++b) {
        if (b < nbat) {
          if (b < 2) { _Pragma("unroll") for (int i = 0; i < 8; ++i) *(LAS u32x4*)(wl + ((i & 1) ? wl1 : wl0) + i * 1024) = pre[i]; }
          else { _Pragma("unroll") for (int i = 0; i < 8; ++i) { const int rw = 16 * (i & 3) + (lane >> 2), sl = 4 * (i >> 2) + (lane & 3); *(LAS u32x4*)(wl + rw * 128 + ((sl ^ ((rw >> 1) & 7)) << 4)) = pre[i]; } }
          __builtin_amdgcn_sched_barrier(0);
          if (b + 1 < nbat) P5_FETCH(b + 1);
          __builtin_amdgcn_sched_barrier(0);
#pragma unroll
          for (int j = 0; j < 4; ++j) {
            const bf16x8 a0 = *(const LAS bf16x8*)(wl + r * 128 + (((4 * h + j) ^ ((r >> 1) & 7)) << 4)), a1 = *(const LAS bf16x8*)(wl + (32 + r) * 128 + (((4 * h + j) ^ ((r >> 1) & 7)) << 4));
            bf16x8 b0, b1;
            if (b < 2) { const int so = (((8 * b + 4 * h + j) ^ (r & 15)) << 4); b0 = *(const LAS bf16x8*)(qs + r * 256 + so); b1 = *(const LAS bf16x8*)(qs + (32 + r) * 256 + so); }
            else { const int so = (64 * (b - 2) + 32 * h + 8 * j) * 2; b0 = *(const LAS bf16x8*)(ablk + r * 528 + so); b1 = *(const LAS bf16x8*)(ablk + (32 + r) * 528 + so); }
            acc[0][0] = MFMA32(a0, b0, acc[0][0]); acc[0][1] = MFMA32(a0, b1, acc[0][1]); acc[1][0] = MFMA32(a1, b0, acc[1][0]); acc[1][1] = MFMA32(a1, b1, acc[1][1]); }
          __builtin_amdgcn_sched_barrier(0);
        }
      }
#undef P5_FETCH
#pragma unroll
      for (int tt = 0; tt < 2; ++tt) { float sq = 0.f;
#pragma unroll
        for (int mi = 0; mi < 2; ++mi)
#pragma unroll
          for (int i = 0; i < 16; ++i) sq += acc[mi][tt][i] * acc[mi][tt][i];
        sq = xh_sum(sq);
        if (h == 0) red[wave * 64 + 32 * tt + r] = sq; }
      __syncthreads();
#pragma unroll
      for (int tt = 0; tt < 2; ++tt)
#pragma unroll
        for (int mi = 0; mi < 2; ++mi)
#pragma unroll
          for (int i4 = 0; i4 < 4; ++i4)
            *(LAS f32x4*)(lds + (32 * tt + r) * 2064 + (64 * wave + 32 * mi + 8 * i4 + 4 * h) * 4) = (f32x4){acc[mi][tt][4 * i4], acc[mi][tt][4 * i4 + 1], acc[mi][tt][4 * i4 + 2], acc[mi][tt][4 * i4 + 3]};
      __syncthreads();
      u32x4 zzv[8];
#pragma unroll
      for (int i = 0; i < 8; ++i) zzv[i] = *(const u32x4*)(QKZ + (size_t)(t0 + 8 * wave + i) * 3072 + 1024 + hd * 512 + lane * 8);
      if (it + 1 < it5b) P5_STAGE_LOAD(it + 1);
      __builtin_amdgcn_sched_barrier(0);
      const f32x4 ga4 = *(const f32x4*)(gout + lane * 8), gb4 = *(const f32x4*)(gout + lane * 8 + 4);
#pragma unroll
      for (int i = 0; i < 8; ++i) { const int tl = 8 * wave + i, t = t0 + tl;
        float sq = 0.f;
#pragma unroll
        for (int w = 0; w < 8; ++w) sq += red[w * 64 + tl];
        const float rstd = rsqrtf(sq * (1.f / GLA_DVH) + RMS_EPS);
        const f32x4 oa = *(const LAS f32x4*)(lds + tl * 2064 + lane * 32), ob = *(const LAS f32x4*)(lds + tl * 2064 + lane * 32 + 16);
        const u32x4 zz = zzv[i];
        const float z[8] = {bf_lo(zz.x), bf_hi(zz.x), bf_lo(zz.y), bf_hi(zz.y), bf_lo(zz.z), bf_hi(zz.z), bf_lo(zz.w), bf_hi(zz.w)};
        const float ov[8] = {oa[0], oa[1], oa[2], oa[3], ob[0], ob[1], ob[2], ob[3]}; float o[8];
#pragma unroll
        for (int e = 0; e < 8; ++e) o[e] = ov[e] * rstd * (e < 4 ? ga4[e] : gb4[e - 4]) * z[e] * __builtin_amdgcn_rcpf(1.f + __builtin_amdgcn_exp2f(-LOG2E * z[e]));
        u32x4 w4; w4.x = pk2(o[0], o[1]); w4.y = pk2(o[2], o[3]); w4.z = pk2(o[4], o[5]); w4.w = pk2(o[6], o[7]);
        *(u32x4*)(OG + (size_t)t * DINNER + hd * 512 + lane * 8) = w4;
        __builtin_amdgcn_sched_barrier(0); }
    }
#undef P5_STAGE_LOAD
  }
  SEAM(5);

  if (IN(6)) {
    const auto& p = fresh_params(); unsigned char* ws = p.ws; FRESH_IDS
    convert_chunk_weights(p.in[I_BWIN], p.in[I_WKV], p.in[I_BNORM], p.in[I_KVNORM], (bf16_t*)(ws + WS_WC), 0, 0, 2048, (LAS float*)(lds + wave * 8448), gw, NGW, lane);
    __syncthreads();
    pg8::Order S; S.nsub = 1; S.G = G; S.c = bx; S.K = DINNER;
    S.s0 = pg8::Sub{(const char*)(ws + WS_P), (const char*)(ws + WS_WOT), 64, 4, 1, 8}; S.s1 = S.s0;
    pg8::EpiResidual<false> E{(const void*)p.in[I_X], (bf16_t*)(ws + WS_H), (float*)(ws + WS_SSQ)};
    pg8::gemm_phase<pg8::EpiResidual<false>, false, true>(lds, S, E, wave_s, 1);
  }
  SEAM(6);

#pragma unroll 1
  for (int ci = 0; ci < 4; ++ci) {
    const int phG = 7 + 2 * ci, phA = 8 + 2 * ci;
#define CHUNK_IDS int ci_l = ci; asm volatile("" : "+s"(ci_l)); const int g = ci_l < 2 ? ci_l : 2, hbase = ci_l == 3 ? 8 : 0, cwsh = ci_l < 2 ? 11 : 10, cw = 1 << cwsh, dil = 1 << (2 * g), L = SEQ >> (2 * g); \
      const size_t qkstride = ci_l < 2 ? ((size_t)32 << 20) : ((size_t)16 << 20); (void)hbase; (void)L; (void)cw; (void)qkstride;
    if (IN(phG)) {
      const auto& p = fresh_params(); unsigned char* ws = p.ws; FRESH_IDS CHUNK_IDS
      { pg8::Order S; S.nsub = 2; S.G = G; S.c = bx; S.K = DM;
        const int tpb = cw >> 8, nN = (g == 2) ? 3 * tpb : 2 * tpb;
        S.s0 = pg8::Sub{(const char*)(ws + WS_H), (const char*)(ws + WS_WC), 64, nN, 1, 8};
        S.s1 = pg8::Sub{(const char*)(ws + WS_WC) + (size_t)nN * 256 * DM * 2, (const char*)(ws + WS_H), tpb, 64, dil, 6 - 2 * g};
        pg8::EpiChunk E{pg8::EpiRowScale3{(bf16_t*)(ws + WS_QC), (const float*)(ws + WS_SSQ), cw, cwsh - 8, qkstride}, pg8::EpiColScale{(bf16_t*)(ws + WS_VTC), (const float*)(ws + WS_SSQ), dil, 6 - 2 * g, cw}};
        pg8::gemm_phase<pg8::EpiChunk, true, true>(lds, S, E, wave_s, 1, 0, dil, 1); }
    }
    SEAM(phG);
    if (IN(phA)) {
      const auto& p = fresh_params(); unsigned char* ws = p.ws; FRESH_IDS CHUNK_IDS
      const bf16_t* QC = (const bf16_t*)(ws + WS_QC); const bf16_t* KC = QC + qkstride; const bf16_t* ZC = QC + 2 * qkstride; const bf16_t* VTC = (const bf16_t*)(ws + WS_VTC);
      bf16_t* ORUN = (bf16_t*)p.out; float* LSE = (float*)(ws + WS_LSE);
      int tid_a = tid; asm volatile("" : "+v"(tid_a));
      const int lane_a = tid_a & 63, q = lane_a & 31, h = lane_a >> 5;
      const int bprsh = 6 - 2 * g;
      const int nitems = cw >> 1, ipc = att_ipc << (cwsh - 10);
      const int i0 = bx * ipc, i1 = (i0 + ipc < nitems) ? i0 + ipc : nitems;
      u32x4 stg[12];
      const int krow0 = tid_a >> 4, kslot = tid_a & 15;
      const int klds0 = krow0 * 256 + ((kslot ^ (krow0 & 15)) << 4);
      const int vrow0 = tid_a >> 2, vslot = tid_a & 3, vlds0 = vrow0 * 784 + vslot * 16;
#define ATT_LOADK(IT) do { const int hl_ = (IT) >> 6, rem_ = (IT) & 63, rr_ = rem_ >> bprsh, jb_ = rem_ & ((1 << bprsh) - 1), kb0_ = 256 * jb_ - 128; \
        const bf16_t* kp_ = KC + (((long)rr_ + (long)dil * (kb0_ + krow0)) << cwsh) + hl_ * 128 + kslot * 8; const long kst_ = ((long)dil * 32) << cwsh; \
        _Pragma("unroll") for (int i_ = 0; i_ < 12; ++i_) { if (kb0_ + 32 * i_ >= 0) stg[i_] = *(const u32x4*)(kp_ + i_ * kst_); else stg[i_] = (u32x4){0u, 0u, 0u, 0u}; } } while (0)
#define ATT_STOREK() do { _Pragma("unroll") for (int i_ = 0; i_ < 12; ++i_) *(LAS u32x4*)(lds + klds0 + i_ * 8192) = stg[i_]; } while (0)
#define ATT_LOADV(IT) do { const int hl_ = (IT) >> 6, rem_ = (IT) & 63, rr_ = rem_ >> bprsh, jb_ = rem_ & ((1 << bprsh) - 1), kb0_ = 256 * jb_ - 128; \
        const bf16_t* vp_ = VTC + (((long)(((long)rr_ * L + kb0_) >> 5) << cwsh) + hl_ * 128 + vrow0) * 32 + vslot * 8;     \
        _Pragma("unroll") for (int i_ = 0; i_ < 12; ++i_) { if (kb0_ + 32 * i_ >= 0) stg[i_] = *(const u32x4*)(vp_ + (((long)i_ * 32) << cwsh)); else stg[i_] = (u32x4){0u, 0u, 0u, 0u}; } } while (0)
#define ATT_STOREV() do { _Pragma("unroll") for (int i_ = 0; i_ < 12; ++i_) *(LAS u32x4*)(lds + vlds0 + i_ * 64) = stg[i_]; } while (0)
      if (i0 < i1) { __syncthreads(); ATT_LOADK(i0); ATT_STOREK(); }
#pragma unroll 1
      for (int it = i0; it < i1; ++it) {
        const int hl = it >> 6, rem = it & 63, rr = rem >> bprsh, jblk = rem & ((1 << bprsh) - 1);
        const int hd = hbase + hl;
        const float slope2 = __builtin_amdgcn_exp2f((float)(g * 16 + hd + 1) * (-8.f / 48.f)) * (float)dil * LOG2E;
        const int jq = 256 * jblk + 32 * wave + q, tq = rr + dil * jq;
        const int kbw = 256 * jblk + 32 * wave - 128;
        int dbase = q + 128 - 4 * h; asm volatile("" : "+v"(dbase));
        bf16x8 qf[8];
        { const bf16_t* qp = QC + ((size_t)tq << cwsh) + hl * 128 + 8 * h;
#pragma unroll
          for (int s = 0; s < 8; ++s) qf[s] = *(const bf16x8*)(qp + 16 * s); }
        __syncthreads();
        f32x16 S5[5];
        float mx = -1e30f;
#pragma unroll
        for (int kt = 0; kt < 5; ++kt) {
          const int kb = kbw + 32 * kt;
#pragma unroll
          for (int i = 0; i < 16; ++i) S5[kt][i] = 0.f;
          if (kb >= 0) {
            const LAS unsigned char* kr = lds + (32 * wave + 32 * kt + q) * 256;
#pragma unroll
            for (int s = 0; s < 8; ++s) { const bf16x8 kf = *(const LAS bf16x8*)(kr + (((2 * s + h) ^ (q & 15)) << 4)); S5[kt] = MFMA32(kf, qf[s], S5[kt]); }
#pragma unroll
            for (int i = 0; i < 16; ++i) { const int cki = 32 * kt + (i & 3) + 8 * (i >> 2); const int delta = dbase - cki;
              const bool valid = (kt == 0) ? (delta <= 128) : ((kt == 4) ? (delta >= 0) : true);
              const float v = valid ? fmaf(slope2, (float)cki, S5[kt][i]) : -1e30f; S5[kt][i] = v; mx = fmaxf(mx, v); }
          } else {
#pragma unroll
            for (int i = 0; i < 16; ++i) S5[kt][i] = -1e30f;
          }
          __builtin_amdgcn_sched_barrier(0);
        }
        const float hb = slope2 * (float)(4 * h);
        mx += hb; mx = xh_max(mx);
        const float mxa = mx - hb;
        __builtin_amdgcn_sched_barrier(0);
        ATT_LOADV(it);
        __builtin_amdgcn_sched_barrier(0);
        float lsum = 0.f;
        bf16x8 pf[5][2];
#pragma unroll
        for (int kt = 0; kt < 5; ++kt) {
#pragma unroll
          for (int i = 0; i < 16; ++i) { const float pv = __builtin_amdgcn_exp2f(S5[kt][i] - mxa); S5[kt][i] = pv; lsum += pv; }
#pragma unroll
          for (int s2 = 0; s2 < 2; ++s2) { u32x4 w; w.x = pk2(S5[kt][8 * s2], S5[kt][8 * s2 + 1]); w.y = pk2(S5[kt][8 * s2 + 2], S5[kt][8 * s2 + 3]); w.z = pk2(S5[kt][8 * s2 + 4], S5[kt][8 * s2 + 5]); w.w = pk2(S5[kt][8 * s2 + 6], S5[kt][8 * s2 + 7]);
            pf[kt][s2] = __builtin_bit_cast(bf16x8, w); }
          __builtin_amdgcn_sched_barrier(0);
        }
        const float ltot = xh_sum(lsum);
        __syncthreads();
        ATT_STOREV();
        __syncthreads();
        f32x16 O[4];
#pragma unroll
        for (int ct = 0; ct < 4; ++ct)
#pragma unroll
          for (int i = 0; i < 16; ++i) O[ct][i] = 0.f;
#pragma unroll
        for (int kt = 0; kt < 5; ++kt) {
          if (kbw + 32 * kt >= 0) {
#pragma unroll
            for (int s2 = 0; s2 < 2; ++s2) { const int ks = 2 * wave + 2 * kt + s2;
#pragma unroll
              for (int ct = 0; ct < 4; ++ct) { const bf16x8 vf = *(const LAS bf16x8*)(lds + (32 * ct + q) * 784 + (16 * ks + 8 * h) * 2); O[ct] = MFMA32(vf, pf[kt][s2], O[ct]); }
              __builtin_amdgcn_sched_barrier(0); }
          }
        }
        const float inv = __builtin_amdgcn_rcpf(ltot); float lse2 = (mx - slope2 * (float)(dbase + 4 * h)) + __builtin_amdgcn_logf(ltot);
        float wo = 0.f, wn = inv;
        float* lsep = LSE + (size_t)tq * 16 + hd;
        if (g > 0) { const float lold = *lsep; const float mm = fmaxf(lold, lse2); const float eo = __builtin_amdgcn_exp2f(lold - mm), en = __builtin_amdgcn_exp2f(lse2 - mm), den = eo + en, rden = __builtin_amdgcn_rcpf(den);
          wo = eo * rden; wn = en * rden * inv; lse2 = mm + __builtin_amdgcn_logf(den); }
        if (g < 2 && h == 0) *lsep = lse2;
        int le = lane_a; asm volatile("" : "+v"(le));
        const int c8 = le & 15, r4 = le >> 4;
        u32x4 ovv[8], zzv[8];
#pragma unroll
        for (int k = 0; k < 8; ++k) { ovv[k] = (u32x4){0u, 0u, 0u, 0u}; zzv[k] = (u32x4){0u, 0u, 0u, 0u}; }
        const int tok0 = rr + dil * (256 * jblk + 32 * wave + r4);
        bf16_t* op0 = ORUN + (size_t)tok0 * DINNER + hd * 128 + c8 * 8; const bf16_t* zp0 = ZC + (size_t)tok0 * 1024 + hl * 128 + c8 * 8;
        const long ostep = (long)dil * 4 * DINNER, zstep = (long)dil * 4 * 1024;
#pragma unroll
        for (int k = 0; k < 8; ++k) { if (g > 0) ovv[k] = *(const u32x4*)(op0 + k * ostep); if (g == 2) zzv[k] = *(const u32x4*)(zp0 + k * zstep); }
        __builtin_amdgcn_sched_barrier(0);
        __syncthreads();
        { LAS unsigned char* ow = lds + wave * 16896;
          LAS float* wov = (LAS float*)(lds + 135168 + wave * 128);
#pragma unroll
          for (int ct = 0; ct < 4; ++ct)
#pragma unroll
            for (int i4 = 0; i4 < 4; ++i4) *(LAS f32x4*)(ow + q * 528 + (32 * ct + 8 * i4 + 4 * h) * 4) = (f32x4){O[ct][4 * i4] * wn, O[ct][4 * i4 + 1] * wn, O[ct][4 * i4 + 2] * wn, O[ct][4 * i4 + 3] * wn};
          if (h == 0) wov[q] = wo;
          LDS_WAIT();
          __builtin_amdgcn_sched_barrier(0);
          if (it + 1 < i1) ATT_LOADK(it + 1);
          __builtin_amdgcn_sched_barrier(0);
#pragma unroll
          for (int k = 0; k < 8; ++k) { const int row = 4 * k + r4;
            const f32x4 a = *(const LAS f32x4*)(ow + row * 528 + c8 * 32), b = *(const LAS f32x4*)(ow + row * 528 + c8 * 32 + 16);
            float o[8] = {a[0], a[1], a[2], a[3], b[0], b[1], b[2], b[3]};
            if (g > 0) { const float w = wov[row]; const u32x4 ov = ovv[k];
              o[0] += w * bf_lo(ov.x); o[1] += w * bf_hi(ov.x); o[2] += w * bf_lo(ov.y); o[3] += w * bf_hi(ov.y); o[4] += w * bf_lo(ov.z); o[5] += w * bf_hi(ov.z); o[6] += w * bf_lo(ov.w); o[7] += w * bf_hi(ov.w); }
            if (g == 2) { const u32x4 zz = zzv[k];
              const float z[8] = {bf_lo(zz.x), bf_hi(zz.x), bf_lo(zz.y), bf_hi(zz.y), bf_lo(zz.z), bf_hi(zz.z), bf_lo(zz.w), bf_hi(zz.w)};
#pragma unroll
              for (int e = 0; e < 8; ++e) o[e] *= z[e] * __builtin_amdgcn_rcpf(1.f + __builtin_amdgcn_exp2f(-LOG2E * z[e])); }
            u32x4 w4; w4.x = pk2(o[0], o[1]); w4.y = pk2(o[2], o[3]); w4.z = pk2(o[4], o[5]); w4.w = pk2(o[6], o[7]);
            *(u32x4*)(op0 + k * ostep) = w4; } }
        __syncthreads();
        if (it + 1 < i1) ATT_STOREK();
      }
      __syncthreads();
#undef ATT_LOADK
#undef ATT_STOREK
#undef ATT_LOADV
#undef ATT_STOREV
      if (ci_l < 3) { const int n_ = ci_l + 1; convert_chunk_weights(p.in[I_BWIN], p.in[I_WKV], p.in[I_BNORM], p.in[I_KVNORM], (bf16_t*)(ws + WS_WC), n_ < 2 ? n_ : 2, n_ == 3 ? 8 : 0, n_ < 2 ? 2048 : 1024, (LAS float*)(lds + wave * 8448), gw, NGW, lane); }
    }
    SEAM(phA);
  }

  if (IN(15)) {
    const auto& p = fresh_params(); unsigned char* ws = p.ws; FRESH_IDS
    pg8::Order S; S.nsub = 1; S.G = G; S.c = bx; S.K = DINNER;
    S.s0 = pg8::Sub{(const char*)p.out, (const char*)(ws + WS_WO2T), 64, 4, 1, 8}; S.s1 = S.s0;
    pg8::EpiFinal E{(const bf16_t*)(ws + WS_H), p.out, p.in[I_FNORM], (float*)(ws + WS_SSQ), (unsigned*)(ws + WS_CTL + 16384)};
    pg8::gemm_phase<pg8::EpiFinal, false, true>(lds, S, E, wave_s, 1);
  }
#undef IN
#undef SEAM
}

extern "C" void kernel_launch(void* const* d_in, const int* in_sizes, int n_in, void* d_out, int out_size, void* d_ws, size_t ws_size, hipStream_t stream) {
  static int grid = 0;
  if (grid == 0) {
    int dev = 0, cus = 0, per_cu = 0;
    if (n_in != 13 || out_size != SEQ * DM || ws_size < 256 * MiB) { fprintf(stderr, "kernel_launch: unexpected problem (n_in %d out %d ws %zu)\n", n_in, out_size, ws_size); grid = -1; return; }
    (void)hipGetDevice(&dev); (void)hipDeviceGetAttribute(&cus, hipDeviceAttributeMultiprocessorCount, dev);
    if (hipFuncSetAttribute((const void*)yoco_fwd, hipFuncAttributeMaxDynamicSharedMemorySize, LDS_BYTES) != hipSuccess) { fprintf(stderr, "kernel_launch: hipFuncSetAttribute failed\n"); grid = -1; return; }
    if (hipOccupancyMaxActiveBlocksPerMultiprocessor(&per_cu, (const void*)yoco_fwd, 512, LDS_BYTES) != hipSuccess || per_cu < 1) { fprintf(stderr, "kernel_launch: occupancy query says %d\n", per_cu); (void)hipGetLastError(); }
    grid = cus;
    if (grid != 256) fprintf(stderr, "kernel_launch: %d CUs; the residual GEMM epilogues assume 256\n", grid);
  }
  if (grid < 0) return;
  if (hipMemsetAsync((char*)d_ws + WS_CTL, 0, 32768, stream) != hipSuccess) { fprintf(stderr, "kernel_launch: memset of barrier words failed\n"); return; }
  Params p{};
  for (int i = 0; i < 13; ++i) p.in[i] = (const float*)d_in[i];
  p.out = (float*)d_out; p.ws = (unsigned char*)d_ws; p.ph_lo = 0; p.ph_hi = NPHASE;
  void* args[] = {&p};
  hipError_t e = hipLaunchCooperativeKernel((void*)yoco_fwd, dim3(grid), dim3(512), args, LDS_BYTES, stream);
  if (e != hipSuccess) fprintf(stderr, "cooperative launch failed: %s (grid %d)\n", hipGetErrorString(e), grid);
}
```

```cpp
#include <hip/hip_runtime.h>
#include <hip/hip_cooperative_groups.h>
#include <cstdio>
#include <cstdint>
namespace cg = cooperative_groups;

#define LAS __attribute__((address_space(3)))
#define DI __device__ __forceinline__
typedef unsigned short bf16_t;
typedef short bf16x8 __attribute__((ext_vector_type(8)));
typedef short bf16x4 __attribute__((ext_vector_type(4)));
typedef float f32x2 __attribute__((ext_vector_type(2)));
typedef float f32x4 __attribute__((ext_vector_type(4)));
typedef float f32x16 __attribute__((ext_vector_type(16)));
typedef unsigned u32x2 __attribute__((ext_vector_type(2)));
typedef unsigned u32x4 __attribute__((ext_vector_type(4)));
typedef __bf16 bf16v2 __attribute__((ext_vector_type(2)));

constexpr int SEQ = 16384, DM = 1024, DINNER = 2048;
constexpr int A_IN = 5136, GLA_DK = 512, GLA_H = 4, GLA_DVH = 512;
constexpr int GC = 256, NCH = SEQ / GC;
constexpr int KV_OUT = 12288, B_IN = 8192;
constexpr float RMS_EPS = 1e-6f;
constexpr float LOG2E = 1.4426950408889634f;
constexpr size_t MiB = 1u << 20;
constexpr size_t WS_W1T = 0;
constexpr size_t WS_WOT = 22 * MiB;
constexpr size_t WS_LR = 14 * MiB;
constexpr size_t WS_DCH = 15 * MiB;
constexpr size_t WS_SSQ = 16 * MiB;
constexpr size_t WS_LSE = 17 * MiB;
constexpr size_t WS_WO2T = 18 * MiB;
constexpr size_t WS_CTL = 30 * MiB;
constexpr size_t WS_WC = 0;
constexpr size_t WS_H = 32 * MiB;
constexpr size_t WS_QKZ = 64 * MiB;
constexpr size_t WS_KT = 160 * MiB;
constexpr size_t WS_P = 176 * MiB;
constexpr size_t WS_QC = 64 * MiB, WS_VTC = 192 * MiB;

DI unsigned pk2(float lo, float hi) { f32x2 v = {lo, hi}; return __builtin_bit_cast(unsigned, __builtin_convertvector(v, bf16v2)); }
DI float bf_lo(unsigned w) { return __uint_as_float(w << 16); }
DI float bf_hi(unsigned w) { return __uint_as_float(w & 0xffff0000u); }
DI float bf2f(bf16_t b) { return __uint_as_float(((unsigned)b) << 16); }
DI bf16_t f2bf(float f) { return (bf16_t)(pk2(f, 0.f) & 0xffffu); }
#define MFMA32(a, b, c) __builtin_amdgcn_mfma_f32_32x32x16_bf16((a), (b), (c), 0, 0, 0)
DI int lane_id() { int l; asm volatile("v_mbcnt_lo_u32_b32 %0, -1, 0\n\tv_mbcnt_hi_u32_b32 %0, -1, %0" : "=v"(l)); return l; }
DI int crow(int reg, int h) { return (reg & 3) + 8 * (reg >> 2) + 4 * h; }
DI float wave_sum(float v) {
#pragma unroll
  for (int o = 1; o < 64; o <<= 1) v += __shfl_xor(v, o);
  return v;
}
#define LDS_WAIT() asm volatile("s_waitcnt lgkmcnt(0)" ::: "memory")
DI float xh_sum(float x) { const unsigned u = __float_as_uint(x); const u32x2 r = __builtin_amdgcn_permlane32_swap(u, u, false, false); return __uint_as_float(r[0]) + __uint_as_float(r[1]); }
DI float xh_max(float x) { const unsigned u = __float_as_uint(x); const u32x2 r = __builtin_amdgcn_permlane32_swap(u, u, false, false); return fmaxf(__uint_as_float(r[0]), __uint_as_float(r[1])); }

namespace pg8 {
constexpr int BM = 256, BK = 64, HALF = 128, HTB = HALF * BK * 2, STAGE_BYTES = 8 * HTB, NXCD = 8, WGM = 8;
__host__ __device__ __forceinline__ int lds_byte(int r, int c) { const int st = (r >> 4) * 2 + (c >> 5), rr = r & 15, cc = c & 31, ob = rr * 64 + cc * 2; return st * 1024 + (ob ^ (((ob >> 9) & 1) << 5)); }
__host__ __device__ __forceinline__ void stage_rc(int b, int& R, int& C) { const int st = b / 1024, sb = b % 1024, swz = sb ^ (((sb >> 9) & 1) << 5); R = (st >> 1) * 16 + swz / 64; C = (st & 1) * 32 + (swz % 64) / 2; }
__host__ __device__ __forceinline__ int p16(int x) { return x < 4 ? x : (x < 8 ? x + 4 : (x < 12 ? x - 4 : x)); }
__host__ __device__ __forceinline__ int perm32(int rho) { const int n = rho >> 4, i = rho & 15; return 8 * (i >> 2) + 4 * n + (i & 3); }

struct Unit { int pm, pn, sub; const char* a; const char* b; };
struct Sub { const char* A; const char* Bt; int nM, nN, dil, tprsh; };
struct Order {
  Sub s0, s1; int nsub, G, c, K;
  DI bool next(int i, Unit& u) const {
    long L = (long)i * G + c; const int n0 = s0.nM * s0.nN;
    int si = 0;
    if (L >= n0) { if (nsub < 2) return false; L -= n0; si = 1; if (L >= (long)s1.nM * s1.nN) return false; }
    const int nM = si ? s1.nM : s0.nM, nN = si ? s1.nN : s0.nN, dil = si ? s1.dil : s0.dil, tprsh = si ? s1.tprsh : s0.tprsh;
    const char* A = si ? s1.A : s0.A; const char* Bt = si ? s1.Bt : s0.Bt;
    const int nwg = nM * nN;
    int wgid = (int)L; { const int q = nwg / NXCD, r = nwg % NXCD, xcd = wgid % NXCD, off = wgid / NXCD; wgid = (xcd < r ? xcd * (q + 1) : r * (q + 1) + (xcd - r) * q) + off; }
    const int nig = WGM * nN, gid = wgid / nig, fm = gid * WGM, gsz = (nM - fm) < WGM ? (nM - fm) : WGM;
    u.pm = fm + ((wgid % nig) % gsz); u.pn = (wgid % nig) / gsz; u.sub = si;
    u.a = A + (size_t)u.pm * BM * K * 2;
    u.b = Bt + ((size_t)(u.pn >> tprsh) + (size_t)dil * BM * (u.pn & ((1 << tprsh) - 1))) * K * 2;
    return true;
  }
};

template <class Epi, bool ALIGN_EPI, bool SP2>
DI void gemm_phase(LAS unsigned char* lds, const Order& S, const Epi& E, int wave_s, int ldb_mult, int bperm16 = 0, int ldb_mult1 = 1, int bperm16_1 = 0) {
  int tid = wave_s * 64 + lane_id(); asm volatile("" : "+v"(tid));
  const int wid = __builtin_amdgcn_readfirstlane(tid >> 6), lane = tid & 63, wr = wid >> 2, wc = wid & 3, fr = lane & 15, fq = lane >> 4;
  const int K = S.K, nt = K / BK;
  unsigned voffA[2], voffB0[2], voffB1[2];
#pragma unroll
  for (int i = 0; i < 2; ++i) { int R, C; stage_rc(tid * 16 + i * 8192, R, C); const int Rp = (R & ~31) + perm32(R & 31); const int Rb0 = bperm16 ? ((Rp & ~15) | p16(Rp & 15)) : Rp, Rb1 = bperm16_1 ? ((Rp & ~15) | p16(Rp & 15)) : Rp;
    voffA[i] = (unsigned)(R * K + C) * 2u; voffB0[i] = (unsigned)(Rb0 * K * ldb_mult + C) * 2u; voffB1[i] = (unsigned)(Rb1 * K * ldb_mult1 + C) * 2u; }
  const size_t kstep = (size_t)(BK * 2);
  const size_t hstepA = (size_t)HALF * K * 2, hstepB0 = (size_t)HALF * K * 2 * ldb_mult, hstepB1 = (size_t)HALF * K * 2 * ldb_mult1;
  const unsigned ldsw = (unsigned)wid * 1024u;
  const int aoff = lds_byte(wr * 64 + fr, fq * 8), boff = lds_byte(wc * 32 + fr, fq * 8);
#define PG8_SA(b, h) (((b) * 2 + (h)) * HTB)
#define PG8_SB(b, h) ((4 + (b) * 2 + (h)) * HTB)
#define PG8_STAGE(bufoff, gbase, voff) do { _Pragma("unroll") for (int _i = 0; _i < 2; ++_i) \
        __builtin_amdgcn_global_load_lds((const unsigned*)((const char*)(gbase) + (voff)[_i]), (LAS unsigned*)(lds + (bufoff) + ldsw + _i * 8192), 16, 0, 0); } while (0)
#define PG8_LDA(dst, b, h) do { _Pragma("unroll") for (int m = 0; m < 4; ++m) _Pragma("unroll") for (int k = 0; k < 2; ++k) dst[m][k] = *(const LAS bf16x8*)(lds + PG8_SA(b, h) + aoff + m * 2048 + k * 1024); } while (0)
#define PG8_LDB(dst, b, h) do { _Pragma("unroll") for (int n = 0; n < 2; ++n) _Pragma("unroll") for (int k = 0; k < 2; ++k) dst[n][k] = *(const LAS bf16x8*)(lds + PG8_SB(b, h) + boff + n * 2048 + k * 1024); } while (0)
#define PG8_MMA(ai, bj, At, Bt) do { __builtin_amdgcn_s_setprio(1); _Pragma("unroll") for (int m = 0; m < 4; ++m) _Pragma("unroll") for (int n = 0; n < 2; ++n) _Pragma("unroll") for (int k = 0; k < 2; ++k) \
        acc[ai][bj][m][n] = __builtin_amdgcn_mfma_f32_16x16x32_bf16(Bt[n][k], At[m][k], acc[ai][bj][m][n], 0, 0, 0); __builtin_amdgcn_s_setprio(0); } while (0)
#define PG8_WAIT_V(n) asm volatile("s_waitcnt vmcnt(" #n ")" ::: "memory")
#define PG8_WAIT_L(n) asm volatile("s_waitcnt lgkmcnt(" #n ")" ::: "memory")
#define PG8_BAR __builtin_amdgcn_s_barrier()
#define PG8_SCHED __builtin_amdgcn_sched_barrier(0)
  Unit cur, nxt; int ui = 0;
  if (!S.next(0, cur)) return;
  f32x4 acc[2][2][4][2];
#pragma unroll
  for (int a = 0; a < 2; ++a)
#pragma unroll
    for (int b = 0; b < 2; ++b)
#pragma unroll
      for (int m = 0; m < 4; ++m)
#pragma unroll
        for (int n = 0; n < 2; ++n) acc[a][b][m][n] = (f32x4){0.f, 0.f, 0.f, 0.f};
  bf16x8 At[4][2], B0[2][2], B1[2][2];
  const char* cA = cur.a; const char* cB = cur.b;
  unsigned voffB[2] = {cur.sub ? voffB1[0] : voffB0[0], cur.sub ? voffB1[1] : voffB0[1]}; size_t hstepB = cur.sub ? hstepB1 : hstepB0;
  if constexpr (SP2) {
    PG8_STAGE(PG8_SB(0, 0), cB, voffB); PG8_STAGE(PG8_SB(0, 1), cB + hstepB, voffB); PG8_STAGE(PG8_SA(0, 0), cA, voffA); PG8_STAGE(PG8_SA(0, 1), cA + hstepA, voffA);
    if (wr == 1) PG8_BAR;
    PG8_WAIT_V(2); PG8_BAR;
    PG8_STAGE(PG8_SB(1, 0), cB + kstep, voffB); PG8_STAGE(PG8_SA(1, 0), cA + kstep, voffA); PG8_STAGE(PG8_SB(1, 1), cB + hstepB + kstep, voffB);
    PG8_WAIT_V(6); PG8_BAR;
  } else {
    PG8_STAGE(PG8_SB(0, 0), cB, voffB); PG8_STAGE(PG8_SA(0, 0), cA, voffA); PG8_STAGE(PG8_SB(0, 1), cB + hstepB, voffB); PG8_STAGE(PG8_SA(0, 1), cA + hstepA, voffA);
    if (wr == 1) PG8_BAR;
    PG8_WAIT_V(4); PG8_BAR;
    PG8_STAGE(PG8_SB(1, 0), cB + kstep, voffB); PG8_STAGE(PG8_SA(1, 0), cA + kstep, voffA); PG8_STAGE(PG8_SB(1, 1), cB + hstepB + kstep, voffB);
    PG8_WAIT_V(6); PG8_BAR;
  }
  for (;;) {
    const bool has_next = S.next(ui + 1, nxt);
    const char* nA = has_next ? nxt.a : cA; const char* nB = has_next ? nxt.b : cB;
    for (int t = 0; t < nt; t += 2) {
      const bool last = (t == nt - 2);
      if (last && has_next) { voffB[0] = nxt.sub ? voffB1[0] : voffB0[0]; voffB[1] = nxt.sub ? voffB1[1] : voffB0[1]; hstepB = nxt.sub ? hstepB1 : hstepB0; }
      const char* a1 = cA + (size_t)(t + 1) * kstep;
      const char* a2 = last ? nA : cA + (size_t)(t + 2) * kstep; const char* b2 = last ? nB : cB + (size_t)(t + 2) * kstep;
      const char* a3 = a2 + kstep; const char* b3 = b2 + kstep;
      if constexpr (SP2) {
        PG8_LDB(B0, 0, 0); PG8_LDB(B1, 0, 1); PG8_SCHED; PG8_LDA(At, 0, 0); PG8_STAGE(PG8_SA(1, 1), a1 + hstepA, voffA);
        PG8_WAIT_V(8); PG8_WAIT_L(0); PG8_BAR; PG8_MMA(0, 0, At, B0); PG8_MMA(0, 1, At, B1); PG8_BAR; PG8_SCHED;
        PG8_LDA(At, 0, 1); PG8_STAGE(PG8_SB(0, 0), b2, voffB); PG8_STAGE(PG8_SB(0, 1), b2 + hstepB, voffB); PG8_STAGE(PG8_SA(0, 0), a2, voffA);
        PG8_WAIT_V(8); PG8_WAIT_L(0); PG8_BAR; PG8_MMA(1, 0, At, B0); PG8_MMA(1, 1, At, B1); PG8_BAR; PG8_SCHED;
        PG8_LDB(B0, 1, 0); PG8_LDB(B1, 1, 1); PG8_SCHED; PG8_LDA(At, 1, 0); PG8_STAGE(PG8_SA(0, 1), a2 + hstepA, voffA);
        PG8_WAIT_V(8); PG8_WAIT_L(0); PG8_BAR; PG8_MMA(0, 0, At, B0); PG8_MMA(0, 1, At, B1); PG8_BAR; PG8_SCHED;
        PG8_LDA(At, 1, 1); PG8_STAGE(PG8_SB(1, 0), b3, voffB); PG8_STAGE(PG8_SB(1, 1), b3 + hstepB, voffB); PG8_STAGE(PG8_SA(1, 0), a3, voffA);
        PG8_WAIT_V(8); PG8_WAIT_L(0); PG8_BAR; PG8_MMA(1, 0, At, B0); PG8_MMA(1, 1, At, B1); PG8_BAR; PG8_SCHED;
      } else {
        PG8_LDB(B0, 0, 0); PG8_SCHED; PG8_LDA(At, 0, 0); PG8_STAGE(PG8_SA(1, 1), a1 + hstepA, voffA);
        PG8_WAIT_L(8); PG8_BAR; PG8_WAIT_L(0); PG8_MMA(0, 0, At, B0); PG8_BAR; PG8_SCHED;
        PG8_LDB(B1, 0, 1); PG8_STAGE(PG8_SB(0, 0), b2, voffB);
        PG8_BAR; PG8_WAIT_L(0); PG8_MMA(0, 1, At, B1); PG8_BAR;
        PG8_LDA(At, 0, 1); PG8_STAGE(PG8_SA(0, 0), a2, voffA);
        PG8_BAR; PG8_WAIT_L(0); PG8_MMA(1, 0, At, B0); PG8_BAR; PG8_SCHED;
        PG8_STAGE(PG8_SB(0, 1), b2 + hstepB, voffB);
        PG8_WAIT_V(6); PG8_BAR; PG8_MMA(1, 1, At, B1); PG8_BAR;
        PG8_LDB(B0, 1, 0); PG8_SCHED; PG8_LDA(At, 1, 0); PG8_STAGE(PG8_SA(0, 1), a2 + hstepA, voffA);
        PG8_WAIT_L(8); PG8_BAR; PG8_WAIT_L(0); PG8_MMA(0, 0, At, B0); PG8_BAR; PG8_SCHED;
        PG8_LDB(B1, 1, 1); PG8_STAGE(PG8_SB(1, 0), b3, voffB);
        PG8_BAR; PG8_WAIT_L(0); PG8_MMA(0, 1, At, B1); PG8_BAR;
        PG8_LDA(At, 1, 1); PG8_STAGE(PG8_SA(1, 0), a3, voffA);
        PG8_BAR; PG8_WAIT_L(0); PG8_MMA(1, 0, At, B0); PG8_BAR; PG8_SCHED;
        PG8_STAGE(PG8_SB(1, 1), b3 + hstepB, voffB);
        PG8_WAIT_V(6); PG8_BAR; PG8_MMA(1, 1, At, B1); PG8_BAR;
      }
    }
    if constexpr (ALIGN_EPI) { if (wr == 0) PG8_BAR; }
    if constexpr (!Epi::AFTER_DRAIN) { E(acc, cur, wr, wc, fr, fq); }
    if (!has_next) break;
#pragma unroll
    for (int a = 0; a < 2; ++a)
#pragma unroll
      for (int b = 0; b < 2; ++b)
#pragma unroll
        for (int m = 0; m < 4; ++m)
#pragma unroll
          for (int n = 0; n < 2; ++n) acc[a][b][m][n] = (f32x4){0.f, 0.f, 0.f, 0.f};
    cur = nxt; cA = nA; cB = nB; ++ui;
    if constexpr (ALIGN_EPI) { if (wr == 1) PG8_BAR; }
  }
  PG8_WAIT_V(0);
  if constexpr (!ALIGN_EPI) { if (wr == 0) PG8_BAR; }
  PG8_BAR;
  if constexpr (Epi::AFTER_DRAIN) { E.fused(acc, cur, wr, wc, fr, fq, lds, wid, lane); }
#undef PG8_SA
#undef PG8_SB
#undef PG8_STAGE
#undef PG8_LDA
#undef PG8_LDB
#undef PG8_MMA
#undef PG8_WAIT_V
#undef PG8_WAIT_L
#undef PG8_BAR
#undef PG8_SCHED
}

struct EpiBf16Two {
  static constexpr bool AFTER_DRAIN = false;
  bf16_t* O0; int ldc0; bf16_t* O1; int ldc1;
  DI void operator()(const f32x4 (&acc)[2][2][4][2], const Unit& u, int wr, int wc, int fr_, int fq_) const {
    (void)fr_; (void)fq_; const int l_ = lane_id(); const int fr = l_ & 15, fq = l_ >> 4;
    const int row0 = u.pm * BM + wr * 64 + fr, col0 = u.pn * BM + wc * 32 + 8 * fq;
#pragma unroll
    for (int ai = 0; ai < 2; ++ai)
#pragma unroll
      for (int m = 0; m < 4; ++m) { const int row = row0 + ai * HALF + m * 16;
#pragma unroll
        for (int bj = 0; bj < 2; ++bj) { const f32x4 v0 = acc[ai][bj][m][0], v1 = acc[ai][bj][m][1]; const int col = col0 + bj * HALF;
          u32x4 w; w.x = pk2(v0[0], v0[1]); w.y = pk2(v0[2], v0[3]); w.z = pk2(v1[0], v1[1]); w.w = pk2(v1[2], v1[3]);
          bf16_t* dst = u.sub ? O1 + ((size_t)(col >> 5) * ldc1 + row) * 32 + (col & 31)
                              : O0 + (size_t)row * ldc0 + col;
          *(u32x4*)dst = w; } }
  }
};
struct EpiRowScale3 {
  static constexpr bool AFTER_DRAIN = false;
  bf16_t* O0; const float* ssq; int cw, tpbsh; size_t bstride;
  DI void operator()(const f32x4 (&acc)[2][2][4][2], const Unit& u, int wr, int wc, int fr_, int fq_) const {
    (void)fr_; (void)fq_; const int l_ = lane_id(); const int fr = l_ & 15, fq = l_ >> 4;
    const int t = u.pn >> tpbsh; bf16_t* base = O0 + (size_t)t * bstride;
    const int row0 = u.pm * BM + wr * 64 + fr, col0 = (u.pn & ((1 << tpbsh) - 1)) * BM + wc * 32 + 8 * fq;
#pragma unroll
    for (int ai = 0; ai < 2; ++ai)
#pragma unroll
      for (int m = 0; m < 4; ++m) { const int row = row0 + ai * HALF + m * 16;
        const f32x4 sq = *(const f32x4*)(ssq + (size_t)row * 4); const float rs = rsqrtf(((sq[0] + sq[1]) + (sq[2] + sq[3])) * (1.0f / DM) + RMS_EPS);
        bf16_t* rowp = base + (size_t)row * cw + col0;
#pragma unroll
        for (int bj = 0; bj < 2; ++bj) { const f32x4 v0 = acc[ai][bj][m][0] * rs, v1 = acc[ai][bj][m][1] * rs;
          u32x4 w; w.x = pk2(v0[0], v0[1]); w.y = pk2(v0[2], v0[3]); w.z = pk2(v1[0], v1[1]); w.w = pk2(v1[2], v1[3]);
          *(u32x4*)(rowp + bj * HALF) = w; } }
  }
};
struct EpiColScale {
  static constexpr bool AFTER_DRAIN = false;
  bf16_t* O; const float* ssq; int dil, tprsh, cw;
  DI void operator()(const f32x4 (&acc)[2][2][4][2], const Unit& u, int wr, int wc, int fr_, int fq_) const {
    (void)fr_; (void)fq_; const int l_ = lane_id(); const int fr = l_ & 15, fq = l_ >> 4;
    const int row0 = u.pm * BM + wr * 64 + fr, col0 = u.pn * BM + wc * 32 + 8 * fq;
    const int r = u.pn >> tprsh, j0 = (u.pn & ((1 << tprsh) - 1)) * BM + wc * 32 + 8 * fq;
#pragma unroll
    for (int bj = 0; bj < 2; ++bj) {
      float rs[8];
#pragma unroll
      for (int e = 0; e < 8; ++e) { const int cc = j0 + bj * HALF + e; const int tok = r + dil * ((cc & ~15) | p16(cc & 15)); const f32x4 sq = *(const f32x4*)(ssq + (size_t)tok * 4);
        rs[e] = rsqrtf(((sq[0] + sq[1]) + (sq[2] + sq[3])) * (1.0f / DM) + RMS_EPS); }
#pragma unroll
      for (int ai = 0; ai < 2; ++ai)
#pragma unroll
        for (int m = 0; m < 4; ++m) { bf16_t* dst = O + ((size_t)((col0 + bj * HALF) >> 5) * cw + row0 + ai * HALF + m * 16) * 32 + ((col0 + bj * HALF) & 31);
          const f32x4 v0 = acc[ai][bj][m][0], v1 = acc[ai][bj][m][1];
          u32x4 w; w.x = pk2(v0[0] * rs[0], v0[1] * rs[1]); w.y = pk2(v0[2] * rs[2], v0[3] * rs[3]);
          w.z = pk2(v1[0] * rs[4], v1[1] * rs[5]); w.w = pk2(v1[2] * rs[6], v1[3] * rs[7]);
          *(u32x4*)dst = w; }
      __builtin_amdgcn_sched_barrier(0);
    }
  }
};
struct EpiChunk {
  static constexpr bool AFTER_DRAIN = false;
  EpiRowScale3 e0; EpiColScale e1;
  DI void operator()(const f32x4 (&acc)[2][2][4][2], const Unit& u, int wr, int wc, int fr, int fq) const { if (u.sub) e1(acc, u, wr, wc, fr, fq); else e0(acc, u, wr, wc, fr, fq); }
};
template <bool BASE_BF16> struct EpiResidual {
  static constexpr bool AFTER_DRAIN = true;
  const void* base; bf16_t* outb; float* ssq;
  DI void operator()(const f32x4 (&)[2][2][4][2], const Unit&, int, int, int, int) const {}
  DI void fused(f32x4 (&acc)[2][2][4][2], const Unit& u, int wr, int wc, int fr_, int fq_, LAS unsigned char* lds, int wid, int lane_) const {
    (void)fr_; (void)fq_; (void)lane_;
    const int l = lane_id(), fr = l & 15, fq = l >> 4;
#pragma unroll
    for (int ps = 0; ps < 4; ++ps) {
      const int ai = ps >> 1, mh = ps & 1;
#pragma unroll
      for (int m1 = 0; m1 < 2; ++m1) { const int lr = wr * 32 + m1 * 16 + fr;
#pragma unroll
        for (int bj = 0; bj < 2; ++bj)
#pragma unroll
          for (int n = 0; n < 2; ++n) *(LAS f32x4*)(lds + lr * 1040 + (128 * bj + 32 * wc + 8 * fq + 4 * n) * 4) = acc[ai][bj][2 * mh + m1][n]; }
      __syncthreads();
      f32x4 xv[8];
#pragma unroll
      for (int i = 0; i < 8; ++i) { const int lr = 8 * wid + i; const int row = 128 * ai + 64 * (lr >> 5) + 16 * (2 * mh + ((lr >> 4) & 1)) + (lr & 15);
        const size_t off = (size_t)(u.pm * BM + row) * DM + u.pn * BM + 4 * l;
        if constexpr (BASE_BF16) { const u32x2 b2 = *(const u32x2*)((const bf16_t*)base + off); xv[i] = (f32x4){bf_lo(b2.x), bf_hi(b2.x), bf_lo(b2.y), bf_hi(b2.y)}; }
        else xv[i] = *(const f32x4*)((const float*)base + off); }
#pragma unroll
      for (int i = 0; i < 8; ++i) { const int lr = 8 * wid + i; const int row = 128 * ai + 64 * (lr >> 5) + 16 * (2 * mh + ((lr >> 4) & 1)) + (lr & 15);
        const size_t off = (size_t)(u.pm * BM + row) * DM + u.pn * BM + 4 * l;
        const f32x4 a = *(const LAS f32x4*)(lds + lr * 1040 + l * 16);
        const f32x4 v = a + xv[i];
        { u32x2 w; w.x = pk2(v[0], v[1]); w.y = pk2(v[2], v[3]); *(u32x2*)(outb + off) = w; }
        float sq = (v[0] * v[0] + v[1] * v[1]) + (v[2] * v[2] + v[3] * v[3]);
#pragma unroll
        for (int o = 1; o < 64; o <<= 1) sq += __uint_as_float((unsigned)__builtin_amdgcn_ds_bpermute((l ^ o) << 2, (int)__float_as_uint(sq)));
        if (l == 0) ssq[(size_t)(u.pm * BM + row) * 4 + u.pn] = sq; }
      __syncthreads();
    }
  }
};
struct EpiFinal {
  static constexpr bool AFTER_DRAIN = true;
  const bf16_t* base; float* out; const float* gain; float* ssq; unsigned* cnt;
  DI void operator()(const f32x4 (&)[2][2][4][2], const Unit&, int, int, int, int) const {}
  template <int SWEEP> DI void sweep(f32x4 (&acc)[2][2][4][2], const Unit& u, int wr, int wc, LAS unsigned char* lds, int wid, int l, const f32x4& g4) const {
    const int fr = l & 15, fq = l >> 4;
#pragma unroll
    for (int ps = 0; ps < 4; ++ps) {
      const int ai = ps >> 1, mh = ps & 1;
#pragma unroll
      for (int m1 = 0; m1 < 2; ++m1) { const int lr = wr * 32 + m1 * 16 + fr;
#pragma unroll
        for (int bj = 0; bj < 2; ++bj)
#pragma unroll
          for (int n = 0; n < 2; ++n) *(LAS f32x4*)(lds + lr * 1040 + (128 * bj + 32 * wc + 8 * fq + 4 * n) * 4) = acc[ai][bj][2 * mh + m1][n]; }
      __syncthreads();
      u32x2 xv[8]; f32x4 sqv[8];
#pragma unroll
      for (int i = 0; i < 8; ++i) { const int lr = 8 * wid + i; const int row = 128 * ai + 64 * (lr >> 5) + 16 * (2 * mh + ((lr >> 4) & 1)) + (lr & 15);
        xv[i] = *(const u32x2*)(base + (size_t)(u.pm * BM + row) * DM + u.pn * BM + 4 * l);
        if (SWEEP == 1) sqv[i] = *(const f32x4*)(ssq + (size_t)(u.pm * BM + row) * 4); else sqv[i] = (f32x4){0.f, 0.f, 0.f, 0.f}; }
#pragma unroll
      for (int i = 0; i < 8; ++i) { const int lr = 8 * wid + i; const int row = 128 * ai + 64 * (lr >> 5) + 16 * (2 * mh + ((lr >> 4) & 1)) + (lr & 15);
        const f32x4 a = *(const LAS f32x4*)(lds + lr * 1040 + l * 16);
        const f32x4 v = a + (f32x4){bf_lo(xv[i].x), bf_hi(xv[i].x), bf_lo(xv[i].y), bf_hi(xv[i].y)};
        if (SWEEP == 0) {
          float sq = (v[0] * v[0] + v[1] * v[1]) + (v[2] * v[2] + v[3] * v[3]);
#pragma unroll
          for (int o = 1; o < 64; o <<= 1) sq += __uint_as_float((unsigned)__builtin_amdgcn_ds_bpermute((l ^ o) << 2, (int)__float_as_uint(sq)));
          if (l == 0) ssq[(size_t)(u.pm * BM + row) * 4 + u.pn] = sq;
        } else {
          const float rstd = rsqrtf(((sqv[i][0] + sqv[i][1]) + (sqv[i][2] + sqv[i][3])) * (1.0f / DM) + RMS_EPS);
          *(f32x4*)(out + (size_t)(u.pm * BM + row) * DM + u.pn * BM + 4 * l) = v * rstd * g4; } }
      __syncthreads();
    }
  }
  DI void fused(f32x4 (&acc)[2][2][4][2], const Unit& u, int wr, int wc, int, int, LAS unsigned char* lds, int wid, int) const {
    const int l = lane_id();
    const f32x4 g4 = *(const f32x4*)(gain + u.pn * BM + 4 * l);
    sweep<0>(acc, u, wr, wc, lds, wid, l, g4);
    asm volatile("s_waitcnt vmcnt(0)" ::: "memory");
    __syncthreads();
    if (wid == 0 && l == 0) {
      __builtin_amdgcn_fence(__ATOMIC_RELEASE, "agent"); asm volatile("s_waitcnt vmcnt(0)" ::: "memory");
      (void)__hip_atomic_fetch_add(cnt + 64 * u.pm, 1u, __ATOMIC_RELAXED, __HIP_MEMORY_SCOPE_AGENT);
      unsigned sp = 0;
      while (__hip_atomic_load(cnt + 64 * u.pm, __ATOMIC_RELAXED, __HIP_MEMORY_SCOPE_AGENT) < 4u) { __builtin_amdgcn_s_sleep(2); if (++sp > (1u << 22)) break; }
      __builtin_amdgcn_fence(__ATOMIC_ACQUIRE, "agent"); asm volatile("s_waitcnt vmcnt(0)" ::: "memory");
    }
    __syncthreads();
    sweep<1>(acc, u, wr, wc, lds, wid, l, g4);
  }
};
}


#define XB_TMO      128
#define XB_XCNT(j)  (256  + 64 * (j))
#define XB_XSUB(j)  (1280 + 64 * (j))
#define XB_XGEN(j)  (2304 + 64 * (j))
#define XB_TOP      3328
#define XB_TOPGEN   3392
#define XCD_BAR_WORDS 3456
#define XB_SPIN_CAP (1u << 18)
DI unsigned xb_ld(unsigned* p)              { return __hip_atomic_load(p, __ATOMIC_RELAXED, __HIP_MEMORY_SCOPE_AGENT); }
DI unsigned xb_add(unsigned* p, unsigned v) { return __hip_atomic_fetch_add(p, v, __ATOMIC_RELAXED, __HIP_MEMORY_SCOPE_AGENT); }
DI unsigned xb_xcc_id() { return (unsigned)__builtin_amdgcn_s_getreg((3 << 11) | 20) & 0xFu; }
#define XB_SPIN(cond, bar) do { unsigned _sp = 0; while (cond) { __builtin_amdgcn_s_sleep(1); \
    if ((++_sp & 255u) == 0u) { if (xb_ld(&(bar)[XB_TMO])) break; if (_sp > XB_SPIN_CAP) { atomicAdd(&(bar)[XB_TMO], 1u); break; } } } } while (0)
struct XcdBarrier { unsigned* bar; unsigned x; volatile LAS unsigned* st; };
DI XcdBarrier xcd_barrier_post(unsigned* bar, volatile LAS unsigned* st) {
  XcdBarrier b; b.bar = bar; b.x = xb_xcc_id(); b.st = st;
  if (threadIdx.x == 0) (void)xb_add(&bar[XB_XCNT(b.x)], 1u);
  return b;
}
DI void xcd_barrier_complete(unsigned* bar, unsigned x, unsigned& nloc, unsigned& nx) {
  const unsigned G = gridDim.x * gridDim.y * gridDim.z;
  unsigned sum, cnt, mine, sp = 0u;
  for (;;) {
    sum = 0u; cnt = 0u; mine = 0u;
#pragma unroll
    for (unsigned j = 0; j < 16; ++j) { const unsigned c = xb_ld(&bar[XB_XCNT(j)]); sum += c; cnt += (c > 0u) ? 1u : 0u; mine = (j == x) ? c : mine; }
    if (sum == G) break;
    __builtin_amdgcn_s_sleep(1);
    if ((++sp & 255u) == 0u) { if (xb_ld(&bar[XB_TMO])) break; if (sp > XB_SPIN_CAP) { atomicAdd(&bar[XB_TMO], 1u); break; } }
  }
  nloc = mine > 0u ? mine : 1u; nx = cnt > 0u ? cnt : 1u;
}
DI void xcd_barrier(const XcdBarrier& b, bool is_t0) {
  asm volatile("s_waitcnt vmcnt(0)" ::: "memory");
  __syncthreads();
  if (is_t0) {
    unsigned* bar = b.bar;
    __builtin_amdgcn_s_waitcnt(0);
    unsigned nloc = b.st[0], nx = b.st[1];
    if (nloc == 0u) { xcd_barrier_complete(bar, b.x, nloc, nx); b.st[0] = nloc; b.st[1] = nx; }
    const unsigned old = xb_add(&bar[XB_XSUB(b.x)], 1u);
    const unsigned gen = old / nloc;
    if (old + 1u == (gen + 1u) * nloc) {
      __builtin_amdgcn_fence(__ATOMIC_RELEASE, "agent");
      asm volatile("s_waitcnt vmcnt(0)" ::: "memory");
      const unsigned og = xb_add(&bar[XB_TOP], 1u);
      const unsigned tg = og / nx;
      if (og + 1u == (tg + 1u) * nx) xb_add(&bar[XB_TOPGEN], 1u);
      else XB_SPIN(xb_ld(&bar[XB_TOPGEN]) == tg, bar);
      __builtin_amdgcn_fence(__ATOMIC_ACQUIRE, "agent");
      xb_add(&bar[XB_XGEN(b.x)], 1u);
      asm volatile("s_waitcnt vmcnt(0)" ::: "memory");
    } else {
      XB_SPIN(xb_ld(&bar[XB_XGEN(b.x)]) == gen, bar);
      __builtin_amdgcn_fence(__ATOMIC_ACQUIRE, "agent");
      asm volatile("s_waitcnt vmcnt(0)" ::: "memory");
    }
  }
  __syncthreads();
}

struct Params { const float* in[13]; float* out; unsigned char* ws; int ph_lo, ph_hi; };
enum { I_X = 0, I_ANORM, I_AWIN, I_AWGU, I_ABG, I_AGOUT, I_AWOUT, I_KVNORM, I_WKV, I_BNORM, I_BWIN, I_BWOUT, I_FNORM };
constexpr int NPHASE = 16;
constexpr int LDS_BYTES = 147456;

DI void transpose_item(const float* W, int ldw, int c0, const float* gk, float sc, bf16_t* WT, int K, int r0, LAS float* scr, int kb, int nb, int lane) {
  const int k0 = 64 * kb, n0 = 32 * nb;
  float wv[32];
  { const float* wp = W + (size_t)(k0 + (lane >> 5)) * ldw + c0 + n0 + (lane & 31);
#pragma unroll
    for (int i = 0; i < 32; ++i) wv[i] = wp[(size_t)(2 * i) * ldw]; }
#pragma unroll
  for (int i = 0; i < 32; ++i) { const int kk = 2 * i + (lane >> 5); const float g = gk ? gk[k0 + kk] * sc : sc; scr[kk * 33 + (lane & 31)] = wv[i] * g; }
  LDS_WAIT(); asm volatile("" ::: "memory");
  const int c = lane & 7;
#pragma unroll
  for (int j = 0; j < 4; ++j) { const int n = (lane >> 3) + 8 * j; const LAS float* s = scr + (8 * c) * 33 + n;
    u32x4 o; o.x = pk2(s[0 * 33], s[1 * 33]); o.y = pk2(s[2 * 33], s[3 * 33]); o.z = pk2(s[4 * 33], s[5 * 33]); o.w = pk2(s[6 * 33], s[7 * 33]);
    *(u32x4*)(WT + (size_t)(r0 + n0 + n) * K + k0 + 8 * c) = o; }
  LDS_WAIT(); asm volatile("" ::: "memory");
}
DI void convert_chunk_weights(const float* bwin, const float* wkv, const float* bnorm, const float* kvnorm, bf16_t* WC, int g, int hbase, int cw, LAS float* scr, int gw, int NGW, int lane) {
  const float qscale = 0.08838834764831845f * LOG2E;
  const int nseg = (g == 2) ? 4 : 3, nbs = cw >> 5, ips = 16 * nbs;
  for (int it = gw; it < nseg * ips; it += NGW) {
    const int seg = it / ips, r = it - seg * ips, kb = r / nbs, nb = r - kb * nbs;
    const int c0 = g * 2048 + hbase * 128;
    if (seg == 0) transpose_item(bwin, B_IN, c0, bnorm, qscale, WC, DM, 0, scr, kb, nb, lane);
    else if (seg == 1) transpose_item(wkv, KV_OUT, c0, kvnorm, 1.f, WC, DM, cw, scr, kb, nb, lane);
    else if (seg == nseg - 1) transpose_item(wkv, KV_OUT, 6144 + c0, kvnorm, 1.f, WC, DM, (nseg - 1) * cw, scr, kb, nb, lane);
    else transpose_item(bwin, B_IN, 6144 + hbase * 128, bnorm, 1.f, WC, DM, 2 * cw, scr, kb, nb, lane);
  }
}

#define CAS __attribute__((address_space(4)))
#if defined(__HIP_DEVICE_COMPILE__)
DI const CAS Params& fresh_params() { const CAS Params* q = (const CAS Params*)__builtin_amdgcn_kernarg_segment_ptr(); asm volatile("" : "+s"(q)); return *q; }
#else
DI const Params& fresh_params() { return *(const Params*)nullptr; }
#endif
__global__ void __launch_bounds__(512, 2) yoco_fwd(Params p_unused) {
  extern __shared__ __attribute__((aligned(16))) unsigned char lds_raw[];
  LAS unsigned char* lds = (LAS unsigned char*)lds_raw;
  cg::grid_group grid = cg::this_grid();
  const int G = gridDim.x, bx = blockIdx.x, NGW = G * 8;
  const int att_ipc = __builtin_amdgcn_readfirstlane((512 + (int)gridDim.x - 1) / (int)gridDim.x);
  const int wave_s = __builtin_amdgcn_readfirstlane(threadIdx.x >> 6);
#define FRESH_IDS int tid = wave_s * 64 + lane_id(); asm volatile("" : "+v"(tid)); const int lane = tid & 63, wave = wave_s, gw = bx * 8 + wave; (void)lane; (void)gw;
  const int lo = fresh_params().ph_lo, hi = fresh_params().ph_hi;
  volatile LAS unsigned* bst = (volatile LAS unsigned*)(lds + LDS_BYTES - 64);
  if (threadIdx.x < 2) bst[threadIdx.x] = 0u;
  __syncthreads();
  const XcdBarrier xbar = xcd_barrier_post((unsigned*)(fresh_params().ws + WS_CTL), bst);
#ifndef PHASE_MASK
#define PHASE_MASK 0xffffffffu
#endif
#define PH_EN(k) (((PHASE_MASK) >> ((k) > 8 && (k) < 15 ? 7 + (((k) - 7) & 1) : ((k) >= 15 ? (k) - 6 : (k)))) & 1u)
#define IN(k) (PH_EN(k) && lo <= (k) && (k) < hi)
#ifndef PROBE_REGION
#define PROBE_REGION 0
#endif
#if PROBE_REGION
#define RGN_BEGIN(id) unsigned long long rgn_t0_##id = 0; if (PROBE_REGION == (id)) { __syncthreads(); rgn_t0_##id = __builtin_amdgcn_s_memrealtime(); }
#define RGN_END(id) if (PROBE_REGION == (id)) { __syncthreads(); if (threadIdx.x == 0) { const unsigned long long n_ = __builtin_amdgcn_s_memrealtime(); const unsigned long long e_ = n_ + 2 * (n_ - rgn_t0_##id); while (__builtin_amdgcn_s_memrealtime() < e_) __builtin_amdgcn_s_sleep(8); } __syncthreads(); }
#else
#define RGN_BEGIN(id)
#define RGN_END(id)
#endif
#define GSYNC(k) do { if (lo < 0) grid.sync(); xcd_barrier(xbar, wave_s == 0 && lane_id() == 0); } while (0)
#ifndef PROBE_CLASS
#define PROBE_CLASS 0
#endif
#define PROBE_MULT 2
#define PH_CLASS(k) ((k) == 0 ? 1 : (k) == 1 ? 2 : (k) <= 5 ? 3 : (k) == 6 ? 4 : (k) >= 15 ? 7 : (((k) - 7) & 1) ? 6 : 5)
#if PROBE_CLASS
  unsigned long long t_prev = __builtin_amdgcn_s_memrealtime();
#define SEAM(k) do { if (IN(k) && IN((k) + 1)) { GSYNC(k); { if (threadIdx.x == 0) { unsigned long long t_now = __builtin_amdgcn_s_memrealtime(); \
      if (PH_CLASS(k) == PROBE_CLASS) { const unsigned long long t_end = t_now + PROBE_MULT * (t_now - t_prev); while (__builtin_amdgcn_s_memrealtime() < t_end) __builtin_amdgcn_s_sleep(8); t_now = __builtin_amdgcn_s_memrealtime(); } \
      t_prev = t_now; } __syncthreads(); } } } while (0)
#else
#define SEAM(k) do { if (IN(k) && IN((k) + 1)) GSYNC(k); } while (0)
#endif

  if (IN(0)) {
    const auto& p = fresh_params(); unsigned char* ws = p.ws; FRESH_IDS
    LAS float* wlrT = (LAS float*)lds;
    LAS float* scr = (LAS float*)(lds + 65536 + wave * 8448);
    const float* awin = p.in[I_AWIN];
    for (int k = tid; k < DM; k += 512) {
      const f32x4* src = (const f32x4*)(awin + (size_t)k * A_IN + 5120);
#pragma unroll
      for (int q = 0; q < 4; ++q) { const f32x4 v = src[q]; wlrT[(4 * q + 0) * DM + k] = v[0]; wlrT[(4 * q + 1) * DM + k] = v[1]; wlrT[(4 * q + 2) * DM + k] = v[2]; wlrT[(4 * q + 3) * DM + k] = v[3]; }
    }
    bf16_t* W1T = (bf16_t*)(ws + WS_W1T); bf16_t* WOT = (bf16_t*)(ws + WS_WOT); bf16_t* WO2T = (bf16_t*)(ws + WS_WO2T);
    for (int it = gw; it < 2560 + 1024 + 1024; it += NGW) {
      if (it < 2560) { const int kb = it / 160, nbb = it % 160; int c0, r0, nb;
        if (nbb < 16) { c0 = 0; r0 = 0; nb = nbb; } else if (nbb < 32) { c0 = 512; r0 = 512; nb = nbb - 16; } else if (nbb < 96) { c0 = 3072; r0 = 1024; nb = nbb - 32; } else { c0 = 1024; r0 = 3072; nb = nbb - 96; }
        transpose_item(awin, A_IN, c0, nullptr, 1.f, W1T, DM, r0, scr, kb, nb, lane); }
      else if (it < 3584) { const int r = it - 2560; transpose_item(p.in[I_AWOUT], DM, 0, nullptr, 1.f, WOT, DINNER, 0, scr, r >> 5, r & 31, lane); }
      else { const int r = it - 3584; transpose_item(p.in[I_BWOUT], DM, 0, nullptr, 1.f, WO2T, DINNER, 0, scr, r >> 5, r & 31, lane); }
    }
    __syncthreads();
    const float* x = p.in[I_X]; const float* gA = p.in[I_ANORM];
    bf16_t* H = (bf16_t*)(ws + WS_H); float* LR = (float*)(ws + WS_LR);
    f32x4 gv[4];
#pragma unroll
    for (int j = 0; j < 4; ++j) gv[j] = *(const f32x4*)(gA + 4 * lane + 256 * j);
    const int lid = lane_id();
    for (int m0 = gw; m0 < SEQ; m0 += 4 * NGW) {
      f32x4 xv[4][4];
#pragma unroll
      for (int i = 0; i < 4; ++i) { const int m = m0 + i * NGW; const f32x4* xr = (const f32x4*)(x + (size_t)(m < SEQ ? m : gw) * DM) + lane;
#pragma unroll
        for (int j = 0; j < 4; ++j) xv[i][j] = xr[64 * j]; }
#pragma unroll
      for (int i = 0; i < 4; ++i) { const int m = m0 + i * NGW;
        if (m < SEQ) {
          f32x4 v[4]; float s2 = 0.f;
#pragma unroll
          for (int j = 0; j < 4; ++j) { v[j] = xv[i][j]; s2 += (v[j][0] * v[j][0] + v[j][1] * v[j][1]) + (v[j][2] * v[j][2] + v[j][3] * v[j][3]); }
          const float rstd = rsqrtf(wave_sum(s2) * (1.f / DM) + RMS_EPS);
#pragma unroll
          for (int j = 0; j < 4; ++j) v[j] = v[j] * rstd * gv[j];
          u32x2* o8 = (u32x2*)(H + (size_t)m * DM) + lane;
#pragma unroll
          for (int j = 0; j < 4; ++j) { u32x2 w; w.x = pk2(v[j][0], v[j][1]); w.y = pk2(v[j][2], v[j][3]); o8[64 * j] = w; }
          float pa[16];
#pragma unroll
          for (int o = 0; o < 16; ++o) { float a = 0.f;
#pragma unroll
            for (int j = 0; j < 4; ++j) { const f32x4 w = *(const LAS f32x4*)(wlrT + o * DM + 4 * lane + 256 * j); a += (v[j][0] * w[0] + v[j][1] * w[1]) + (v[j][2] * w[2] + v[j][3] * w[3]); }
            pa[o] = a; __builtin_amdgcn_sched_barrier(0); }
          float c8v[8];
#pragma unroll
          for (int j = 0; j < 8; ++j) { const u32x2 rr2 = __builtin_amdgcn_permlane32_swap(__float_as_uint(pa[j]), __float_as_uint(pa[8 + j]), false, false); c8v[j] = __uint_as_float(rr2[0]) + __uint_as_float(rr2[1]); }
          float c4v[4], c2v[2], c1v;
          { const bool up = (lid & 16) != 0;
#pragma unroll
            for (int j = 0; j < 4; ++j) { const float snd = up ? c8v[j] : c8v[4 + j], kp = up ? c8v[4 + j] : c8v[j];
              c4v[j] = kp + __uint_as_float((unsigned)__builtin_amdgcn_ds_bpermute((lid ^ 16) << 2, (int)__float_as_uint(snd))); } }
          { const bool up = (lid & 8) != 0;
#pragma unroll
            for (int j = 0; j < 2; ++j) { const float snd = up ? c4v[j] : c4v[2 + j], kp = up ? c4v[2 + j] : c4v[j];
              c2v[j] = kp + __uint_as_float((unsigned)__builtin_amdgcn_ds_bpermute((lid ^ 8) << 2, (int)__float_as_uint(snd))); } }
          { const bool up = (lid & 4) != 0; const float snd = up ? c2v[0] : c2v[1], kp = up ? c2v[1] : c2v[0];
            c1v = kp + __uint_as_float((unsigned)__builtin_amdgcn_ds_bpermute((lid ^ 4) << 2, (int)__float_as_uint(snd))); }
          c1v += __uint_as_float((unsigned)__builtin_amdgcn_ds_bpermute((lid ^ 2) << 2, (int)__float_as_uint(c1v)));
          c1v += __uint_as_float((unsigned)__builtin_amdgcn_ds_bpermute((lid ^ 1) << 2, (int)__float_as_uint(c1v)));
          if ((lid & 3) == 0) LR[(size_t)m * 16 + (lid >> 2)] = c1v;
        }
      }
    }
  }
  SEAM(0);

  if (IN(1)) {
    const auto& p = fresh_params(); unsigned char* ws = p.ws; FRESH_IDS
    pg8::Order S; S.nsub = 2; S.G = G; S.c = bx; S.K = DM;
    S.s0 = pg8::Sub{(const char*)(ws + WS_H), (const char*)(ws + WS_W1T), 64, 12, 1, 8};
    S.s1 = pg8::Sub{(const char*)(ws + WS_W1T) + (size_t)3072 * DM * 2, (const char*)(ws + WS_H), 8, 64, 1, 8};
    pg8::EpiBf16Two E{(bf16_t*)(ws + WS_QKZ), 3072, (bf16_t*)p.out, DINNER};
    pg8::gemm_phase<pg8::EpiBf16Two, true, true>(lds, S, E, wave_s, 1);
  }
  SEAM(1);

  if (IN(2)) {
    const auto& p = fresh_params(); unsigned char* ws = p.ws; FRESH_IDS
    LAS float* lrs = (LAS float*)lds;
    LAS float* tot = (LAS float*)(lds + 16384);
    bf16_t* QKZ = (bf16_t*)(ws + WS_QKZ); bf16_t* KT = (bf16_t*)(ws + WS_KT); float* DCH = (float*)(ws + WS_DCH);
    const float* LR = (const float*)(ws + WS_LR);
    const int ch = tid & 127, seg = wave >> 1;
    for (int it = bx; it < NCH * GLA_H; it += G) {
      const int c = it >> 2, hd = it & 3, j = hd * 128 + ch;
      __syncthreads();
      { const f32x4* src = (const f32x4*)(LR + (size_t)c * GC * 16); LAS f32x4* dst = (LAS f32x4*)lrs; dst[tid] = src[tid]; dst[tid + 512] = src[tid + 512]; }
      float wg[16];
#pragma unroll
      for (int e = 0; e < 16; ++e) wg[e] = p.in[I_AWGU][e * GLA_DK + j];
      const float bias = p.in[I_ABG][j];
      __syncthreads();
      float cumv[64]; float cum = 0.f;
#pragma unroll
      for (int i = 0; i < 64; ++i) { const LAS f32x4* r4 = (const LAS f32x4*)(lrs + (seg * 64 + i) * 16); float pre = bias;
#pragma unroll
        for (int q = 0; q < 4; ++q) { const f32x4 v = r4[q]; pre += (v[0] * wg[4 * q] + v[1] * wg[4 * q + 1]) + (v[2] * wg[4 * q + 2] + v[3] * wg[4 * q + 3]); }
        const float ls = fminf(pre, 0.f) - 0.6931471805599453f * __builtin_amdgcn_logf(1.f + __builtin_amdgcn_exp2f(-LOG2E * fabsf(pre)));
        cum += ls * (1.f / 16.f); cumv[i] = cum; }
      tot[seg * 128 + ch] = cum;
      __syncthreads();
      float off = 0.f, total = 0.f;
#pragma unroll
      for (int s = 0; s < 4; ++s) { const float t = tot[s * 128 + ch]; total += t; if (s < seg) off += t; }
      const int t0 = c * GC + seg * 64;
      LAS unsigned char* til = lds + 18432;
      const int srow = tid >> 4, sslot = tid & 15;
#pragma unroll 1
      for (int qk = 0; qk < 2; ++qk) {
        bf16_t* gt = QKZ + (size_t)(c * GC + srow) * 3072 + qk * 512 + hd * 128 + sslot * 8;
        { u32x4 tv[8];
#pragma unroll
          for (int i = 0; i < 8; ++i) tv[i] = *(const u32x4*)(gt + (size_t)i * 32 * 3072);
          __syncthreads();
#pragma unroll
          for (int i = 0; i < 8; ++i) *(LAS u32x4*)(til + (srow + 32 * i) * 256 + sslot * 16) = tv[i]; }
        __syncthreads();
        if (qk == 0) {
#pragma unroll
          for (int i = 0; i < 64; ++i) { LAS bf16_t* e = (LAS bf16_t*)(til + (seg * 64 + i) * 256 + ch * 2); const float B = off + cumv[i];
            *e = f2bf(bf2f(*e) * (__builtin_amdgcn_exp2f(LOG2E * B) * 0.08838834764831845f)); }
        } else {
#pragma unroll
          for (int i8 = 0; i8 < 8; ++i8) { float kk[8];
#pragma unroll
            for (int e8 = 0; e8 < 8; ++e8) { const int i = i8 * 8 + e8; LAS bf16_t* e = (LAS bf16_t*)(til + (seg * 64 + i) * 256 + ch * 2); const float B = off + cumv[i];
              const float kv = bf2f(*e) * __builtin_amdgcn_exp2f(fminf(-LOG2E * B, 115.f)); *e = f2bf(kv); kk[e8] = kv; }
            u32x4 w; w.x = pk2(kk[0], kk[1]); w.y = pk2(kk[2], kk[3]); w.z = pk2(kk[4], kk[5]); w.w = pk2(kk[6], kk[7]);
            *(u32x4*)(KT + ((size_t)((t0 + i8 * 8) >> 6) * GLA_DK + j) * 64 + ((t0 + i8 * 8) & 63)) = w; }
        }
        __syncthreads();
#pragma unroll
        for (int i = 0; i < 8; ++i) *(u32x4*)(gt + (size_t)i * 32 * 3072) = *(const LAS u32x4*)(til + (srow + 32 * i) * 256 + sslot * 16);
      }
      if (seg == 0) DCH[c * GLA_DK + j] = __builtin_amdgcn_exp2f(LOG2E * total);
    }
  }
  if (IN(2) && IN(3)) { if (G == NCH * GLA_H) { asm volatile("s_waitcnt vmcnt(0)" ::: "memory"); __syncthreads(); } else { GSYNC(2); } }

  if (IN(3)) {
    const auto& p = fresh_params(); unsigned char* ws = p.ws; FRESH_IDS
    const bf16_t* KT = (const bf16_t*)(ws + WS_KT); const bf16_t* VT = (const bf16_t*)p.out; bf16_t* P = (bf16_t*)(ws + WS_P);
    const int r = lane & 31, h = lane >> 5, mt = wave & 3, nh = wave >> 2;
    const int prow = tid >> 3, pslot = tid & 7;
    const int pl0 = prow * 128 + ((pslot ^ ((prow >> 1) & 7)) << 4);
    const int vrow = tid >> 2, vs4 = tid & 3;
    const int vl0 = vrow * 128 + ((vs4 ^ ((vrow >> 1) & 7)) << 4), vl1 = vrow * 128 + (((4 + vs4) ^ ((vrow >> 1) & 7)) << 4);
    u32x4 pre[16];
#define P3_FETCH(IT) do { const int c_ = (IT) >> 4, hd_ = ((IT) >> 2) & 3, ns_ = (IT) & 3; \
      const bf16_t* ga_ = KT + ((size_t)(c_ * 4) * GLA_DK + hd_ * 128 + prow) * 64 + pslot * 8; const bf16_t* gb_ = VT + ((size_t)(c_ * 8) * DINNER + hd_ * 512 + ns_ * 128 + vrow) * 32 + vs4 * 8; \
      _Pragma("unroll") for (int tb_ = 0; tb_ < 4; ++tb_) { pre[4 * tb_] = *(const u32x4*)(ga_ + (size_t)tb_ * GLA_DK * 64); pre[4 * tb_ + 1] = *(const u32x4*)(ga_ + (size_t)tb_ * GLA_DK * 64 + 64 * 64); \
        pre[4 * tb_ + 2] = *(const u32x4*)(gb_ + (size_t)(2 * tb_) * DINNER * 32); pre[4 * tb_ + 3] = *(const u32x4*)(gb_ + (size_t)(2 * tb_ + 1) * DINNER * 32); } } while (0)
    const int ipw = (NCH * 16 + G - 1) / G, it0 = bx * ipw, it1 = (it0 + ipw < NCH * 16) ? it0 + ipw : NCH * 16;
    if (it0 < it1) P3_FETCH(it0);
    for (int it = it0; it < it1; ++it) {
      const int c = it >> 4, hd = (it >> 2) & 3, ns = it & 3;
      __syncthreads();
#pragma unroll
      for (int tb = 0; tb < 4; ++tb) { *(LAS u32x4*)(lds + tb * 16384 + pl0) = pre[4 * tb]; *(LAS u32x4*)(lds + tb * 16384 + pl0 + 8192) = pre[4 * tb + 1];
        *(LAS u32x4*)(lds + 65536 + tb * 16384 + vl0) = pre[4 * tb + 2]; *(LAS u32x4*)(lds + 65536 + tb * 16384 + vl1) = pre[4 * tb + 3]; }
      __syncthreads();
      if (it + 1 < it1) P3_FETCH(it + 1);
      __builtin_amdgcn_sched_barrier(0);
      f32x16 a0, a1;
#pragma unroll
      for (int i = 0; i < 16; ++i) { a0[i] = 0.f; a1[i] = 0.f; }
      const int ra = 32 * mt + r, rb = 64 * nh + r;
      const int xa = (ra >> 1) & 7, xb = (rb >> 1) & 7;
#pragma unroll
      for (int tb = 0; tb < 4; ++tb)
#pragma unroll
        for (int j = 0; j < 4; ++j) {
          const bf16x8 fa = *(const LAS bf16x8*)(lds + tb * 16384 + ra * 128 + (((4 * h + j) ^ xa) << 4));
          const bf16x8 fb0 = *(const LAS bf16x8*)(lds + 65536 + tb * 16384 + rb * 128 + (((4 * h + j) ^ xb) << 4));
          const bf16x8 fb1 = *(const LAS bf16x8*)(lds + 65536 + tb * 16384 + (rb + 32) * 128 + (((4 * h + j) ^ xb) << 4));
          a0 = MFMA32(fa, fb0, a0); a1 = MFMA32(fa, fb1, a1); }
      bf16_t* o0 = P + ((size_t)(c * 4 + hd) * 512 + ns * 128 + nh * 64 + r) * 128 + 32 * mt + 4 * h; bf16_t* o1 = o0 + 32 * 128;
#pragma unroll
      for (int i4 = 0; i4 < 4; ++i4) { u32x2 w0, w1; w0.x = pk2(a0[4 * i4], a0[4 * i4 + 1]); w0.y = pk2(a0[4 * i4 + 2], a0[4 * i4 + 3]); w1.x = pk2(a1[4 * i4], a1[4 * i4 + 1]); w1.y = pk2(a1[4 * i4 + 2], a1[4 * i4 + 3]);
        *(u32x2*)(o0 + 8 * i4) = w0; *(u32x2*)(o1 + 8 * i4) = w1; }
    }
#undef P3_FETCH
  }
  SEAM(3);

  if (IN(4)) {
    const auto& p = fresh_params(); unsigned char* ws = p.ws; FRESH_IDS
    const unsigned* P = (const unsigned*)(ws + WS_P); const float* DCH = (const float*)(ws + WS_DCH); unsigned* SB = (unsigned*)(ws + WS_H);
    for (int idx = bx * 512 + tid; idx < 131072; idx += G * 512) {
      const int e = idx * 2, k = e & 127, hd = e >> 16;
      float s0 = 0.f, s1 = 0.f;
#pragma unroll 8
      for (int c = 0; c < NCH; ++c) { const unsigned pw = P[(size_t)c * 131072 + idx]; const f32x2 pv = {bf_lo(pw), bf_hi(pw)}; const f32x2 dv = *(const f32x2*)(DCH + c * GLA_DK + hd * 128 + k);
        SB[(size_t)c * 131072 + idx] = pk2(s0, s1); s0 = dv[0] * (s0 + pv[0]); s1 = dv[1] * (s1 + pv[1]); }
    }
  }
  SEAM(4);

  if (IN(5)) {
    const auto& p = fresh_params(); unsigned char* ws = p.ws; FRESH_IDS
    const bf16_t* QKZ = (const bf16_t*)(ws + WS_QKZ); const bf16_t* VT = (const bf16_t*)p.out; const bf16_t* SB = (const bf16_t*)(ws + WS_H);
    bf16_t* OG = (bf16_t*)(ws + WS_P); const float* gout = p.in[I_AGOUT];
    LAS unsigned char* qs = lds;
    LAS unsigned char* ksl = lds + 16384;
    LAS unsigned char* ablk = lds + 81920;
    LAS float* red = (LAS float*)(lds + 133120);
    const int r = lane & 31, h = lane >> 5;
    const int wrow = lane >> 3, wslot = lane & 7;
    const int wl0 = wrow * 128 + ((wslot ^ (wrow >> 1)) << 4), wl1 = wrow * 128 + ((wslot ^ (wrow >> 1) ^ 4) << 4);
    const int srow = tid >> 4, sslot = tid & 15, sl0 = srow * 256 + ((sslot ^ (srow & 15)) << 4);
    const int ipw5 = (NCH * 16 + G - 1) / G, it5a = bx * ipw5, it5b = (it5a + ipw5 < NCH * 16) ? it5a + ipw5 : NCH * 16;
    for (int it = it5a; it < it5b; ++it) {
      const int c = it >> 4, hd = (it >> 2) & 3, ts = it & 3;
      const int t0 = c * GC + ts * 64, ns = (ts + 1) * 64, ntiles = 4 * (ts + 1);
      __syncthreads();
      { u32x4 tq2[2], tk[8];
        const bf16_t* qg = QKZ + (size_t)(t0 + srow) * 3072 + hd * 128 + sslot * 8; const bf16_t* kg = QKZ + (size_t)(c * GC + srow) * 3072 + 512 + hd * 128 + sslot * 8;
#pragma unroll
        for (int i = 0; i < 2; ++i) tq2[i] = *(const u32x4*)(qg + (size_t)i * 32 * 3072);
#pragma unroll
        for (int i = 0; i < 8; ++i) if (32 * i < ns) tk[i] = *(const u32x4*)(kg + (size_t)i * 32 * 3072);
#pragma unroll
        for (int i = 0; i < 2; ++i) *(LAS u32x4*)(qs + sl0 + i * 8192) = tq2[i];
#pragma unroll
        for (int i = 0; i < 8; ++i) if (32 * i < ns) *(LAS u32x4*)(ksl + sl0 + i * 8192) = tk[i]; }
      __syncthreads();
#pragma unroll
      for (int rep = 0; rep < 2; ++rep) { const int ti = wave + 8 * rep;
        if (ti < ntiles) { const int st = ti >> 1, tt = ti & 1;
          const LAS unsigned char* ar = ksl + (32 * st + r) * 256; const LAS unsigned char* br = qs + (32 * tt + r) * 256;
          f32x16 acc;
#pragma unroll
          for (int i = 0; i < 16; ++i) acc[i] = 0.f;
#pragma unroll
          for (int ks = 0; ks < 8; ++ks) { const int so = (((2 * ks + h) ^ (r & 15)) << 4); acc = MFMA32(*(const LAS bf16x8*)(ar + so), *(const LAS bf16x8*)(br + so), acc); }
          const int tl = ts * 64 + 32 * tt + r;
#pragma unroll
          for (int i4 = 0; i4 < 4; ++i4) { float v[4];
#pragma unroll
            for (int e = 0; e < 4; ++e) { const int sl = 32 * st + 8 * i4 + 4 * h + e; v[e] = (sl <= tl) ? acc[4 * i4 + e] : 0.f; }
            u32x2 w; w.x = pk2(v[0], v[1]); w.y = pk2(v[2], v[3]);
            *(LAS u32x2*)(ablk + (32 * tt + r) * 528 + (32 * st + 8 * i4 + 4 * h) * 2) = w; } } }
      __syncthreads();
      f32x16 acc[2][2];
#pragma unroll
      for (int a = 0; a < 2; ++a)
#pragma unroll
        for (int b = 0; b < 2; ++b)
#pragma unroll
          for (int i = 0; i < 16; ++i) acc[a][b][i] = 0.f;
      const bf16_t* sp0 = SB + ((size_t)(c * 4 + hd) * 512 + 64 * wave + wrow) * 128 + wslot * 8;
      const bf16_t* vp0 = VT + ((size_t)(c * 8) * DINNER + hd * 512 + 64 * wave + (lane >> 2)) * 32 + (lane & 3) * 8;
      LAS unsigned char* wl = lds + 16384 + wave * 8192;
      const int nbat = 2 + ns / 64;
      u32x4 pre[8];
#define P5_FETCH(b) do { if ((b) < 2) { _Pragma("unroll") for (int i_ = 0; i_ < 8; ++i_) pre[i_] = *(const u32x4*)(sp0 + (size_t)i_ * 8 * 128 + 64 * (b)); } \
        else { _Pragma("unroll") for (int i_ = 0; i_ < 8; ++i_) pre[i_] = *(const u32x4*)(vp0 + (size_t)(2 * ((b) - 2) + (i_ >> 2)) * DINNER * 32 + (i_ & 3) * 16 * 32); } } while (0)
      P5_FETCH(0);
#pragma unroll
      for (int b = 0; b < 6; ++b) {
        if (b < nbat) {
          if (b < 2) { _Pragma("unroll") for (int i = 0; i < 8; ++i) *(LAS u32x4*)(wl + ((i & 1) ? wl1 : wl0) + i * 1024) = pre[i]; }
          else { _Pragma("unroll") for (int i = 0; i < 8; ++i) { const int rw = 16 * (i & 3) + (lane >> 2), sl = 4 * (i >> 2) + (lane & 3); *(LAS u32x4*)(wl + rw * 128 + ((sl ^ ((rw >> 1) & 7)) << 4)) = pre[i]; } }
          __builtin_amdgcn_sched_barrier(0);
          if (b + 1 < nbat) P5_FETCH(b + 1);
          __builtin_amdgcn_sched_barrier(0);
#pragma unroll
          for (int j = 0; j < 4; ++j) {
            const bf16x8 a0 = *(const LAS bf16x8*)(wl + r * 128 + (((4 * h + j) ^ ((r >> 1) & 7)) << 4)), a1 = *(const LAS bf16x8*)(wl + (32 + r) * 128 + (((4 * h + j) ^ ((r >> 1) & 7)) << 4));
            bf16x8 b0, b1;
            if (b < 2) { const int so = (((8 * b + 4 * h + j) ^ (r & 15)) << 4); b0 = *(const LAS bf16x8*)(qs + r * 256 + so); b1 = *(const LAS bf16x8*)(qs + (32 + r) * 256 + so); }
            else { const int so = (64 * (b - 2) + 32 * h + 8 * j) * 2; b0 = *(const LAS bf16x8*)(ablk + r * 528 + so); b1 = *(const LAS bf16x8*)(ablk + (32 + r) * 528 + so); }
            acc[0][0] = MFMA32(a0, b0, acc[0][0]); acc[0][1] = MFMA32(a0, b1, acc[0][1]); acc[1][0] = MFMA32(a1, b0, acc[1][0]); acc[1][1] = MFMA32(a1, b1, acc[1][1]); }
          __builtin_amdgcn_sched_barrier(0);
        }
      }
#undef P5_FETCH
#pragma unroll
      for (int tt = 0; tt < 2; ++tt) { float sq = 0.f;
#pragma unroll
        for (int mi = 0; mi < 2; ++mi)
#pragma unroll
          for (int i = 0; i < 16; ++i) sq += acc[mi][tt][i] * acc[mi][tt][i];
        sq = xh_sum(sq);
        if (h == 0) red[wave * 64 + 32 * tt + r] = sq; }
      __syncthreads();
#pragma unroll
      for (int tt = 0; tt < 2; ++tt)
#pragma unroll
        for (int mi = 0; mi < 2; ++mi)
#pragma unroll
          for (int i4 = 0; i4 < 4; ++i4)
            *(LAS f32x4*)(lds + (32 * tt + r) * 2064 + (64 * wave + 32 * mi + 8 * i4 + 4 * h) * 4) = (f32x4){acc[mi][tt][4 * i4], acc[mi][tt][4 * i4 + 1], acc[mi][tt][4 * i4 + 2], acc[mi][tt][4 * i4 + 3]};
      __syncthreads();
      const f32x4 ga4 = *(const f32x4*)(gout + lane * 8), gb4 = *(const f32x4*)(gout + lane * 8 + 4);
      u32x4 zzv[8];
#pragma unroll
      for (int i = 0; i < 8; ++i) zzv[i] = *(const u32x4*)(QKZ + (size_t)(t0 + 8 * wave + i) * 3072 + 1024 + hd * 512 + lane * 8);
#pragma unroll
      for (int i = 0; i < 8; ++i) { const int tl = 8 * wave + i, t = t0 + tl;
        float sq = 0.f;
#pragma unroll
        for (int w = 0; w < 8; ++w) sq += red[w * 64 + tl];
        const float rstd = rsqrtf(sq * (1.f / GLA_DVH) + RMS_EPS);
        const f32x4 oa = *(const LAS f32x4*)(lds + tl * 2064 + lane * 32), ob = *(const LAS f32x4*)(lds + tl * 2064 + lane * 32 + 16);
        const u32x4 zz = zzv[i];
        const float z[8] = {bf_lo(zz.x), bf_hi(zz.x), bf_lo(zz.y), bf_hi(zz.y), bf_lo(zz.z), bf_hi(zz.z), bf_lo(zz.w), bf_hi(zz.w)};
        const float ov[8] = {oa[0], oa[1], oa[2], oa[3], ob[0], ob[1], ob[2], ob[3]}; float o[8];
#pragma unroll
        for (int e = 0; e < 8; ++e) o[e] = ov[e] * rstd * (e < 4 ? ga4[e] : gb4[e - 4]) * z[e] * __builtin_amdgcn_rcpf(1.f + __builtin_amdgcn_exp2f(-LOG2E * z[e]));
        u32x4 w4; w4.x = pk2(o[0], o[1]); w4.y = pk2(o[2], o[3]); w4.z = pk2(o[4], o[5]); w4.w = pk2(o[6], o[7]);
        *(u32x4*)(OG + (size_t)t * DINNER + hd * 512 + lane * 8) = w4;
        __builtin_amdgcn_sched_barrier(0); }
    }
  }
  SEAM(5);

  if (IN(6)) {
    const auto& p = fresh_params(); unsigned char* ws = p.ws; FRESH_IDS
    const bool conv_first = (bx & 1) == 0;
    if (conv_first) { convert_chunk_weights(p.in[I_BWIN], p.in[I_WKV], p.in[I_BNORM], p.in[I_KVNORM], (bf16_t*)(ws + WS_WC), 0, 0, 2048, (LAS float*)(lds + wave * 8448), gw, NGW, lane);
      __syncthreads(); }
    pg8::Order S; S.nsub = 1; S.G = G; S.c = bx; S.K = DINNER;
    S.s0 = pg8::Sub{(const char*)(ws + WS_P), (const char*)(ws + WS_WOT), 64, 4, 1, 8}; S.s1 = S.s0;
    pg8::EpiResidual<false> E{(const void*)p.in[I_X], (bf16_t*)(ws + WS_H), (float*)(ws + WS_SSQ)};
    pg8::gemm_phase<pg8::EpiResidual<false>, false, true>(lds, S, E, wave_s, 1);
    if (!conv_first) { const auto& p2 = fresh_params(); int tid2 = wave_s * 64 + lane_id(); asm volatile("" : "+v"(tid2)); const int lane2 = tid2 & 63, wave2 = wave_s, gw2 = bx * 8 + wave2, NGW2 = G * 8; __syncthreads();
      convert_chunk_weights(p2.in[I_BWIN], p2.in[I_WKV], p2.in[I_BNORM], p2.in[I_KVNORM], (bf16_t*)(p2.ws + WS_WC), 0, 0, 2048, (LAS float*)(lds + wave2 * 8448), gw2, NGW2, lane2); }
  }
  SEAM(6);

#pragma unroll 1
  for (int ci = 0; ci < 4; ++ci) {
    const int phG = 7 + 2 * ci, phA = 8 + 2 * ci;
#define CHUNK_IDS int ci_l = ci; asm volatile("" : "+s"(ci_l)); const int g = ci_l < 2 ? ci_l : 2, hbase = ci_l == 3 ? 8 : 0, cwsh = ci_l < 2 ? 11 : 10, cw = 1 << cwsh, dil = 1 << (2 * g), L = SEQ >> (2 * g); \
      const size_t qkstride = ci_l < 2 ? ((size_t)32 << 20) : ((size_t)16 << 20); (void)hbase; (void)L; (void)cw; (void)qkstride;
    if (IN(phG)) {
      const auto& p = fresh_params(); unsigned char* ws = p.ws; FRESH_IDS CHUNK_IDS
      { pg8::Order S; S.nsub = 2; S.G = G; S.c = bx; S.K = DM;
        const int tpb = cw >> 8, nN = (g == 2) ? 3 * tpb : 2 * tpb;
        S.s0 = pg8::Sub{(const char*)(ws + WS_H), (const char*)(ws + WS_WC), 64, nN, 1, 8};
        S.s1 = pg8::Sub{(const char*)(ws + WS_WC) + (size_t)nN * 256 * DM * 2, (const char*)(ws + WS_H), tpb, 64, dil, 6 - 2 * g};
        pg8::EpiChunk E{pg8::EpiRowScale3{(bf16_t*)(ws + WS_QC), (const float*)(ws + WS_SSQ), cw, cwsh - 8, qkstride}, pg8::EpiColScale{(bf16_t*)(ws + WS_VTC), (const float*)(ws + WS_SSQ), dil, 6 - 2 * g, cw}};
        pg8::gemm_phase<pg8::EpiChunk, true, true>(lds, S, E, wave_s, 1, 0, dil, 1); }
    }
    SEAM(phG);
    if (IN(phA)) {
      const auto& p = fresh_params(); unsigned char* ws = p.ws; FRESH_IDS CHUNK_IDS
      const bf16_t* QC = (const bf16_t*)(ws + WS_QC); const bf16_t* KC = QC + qkstride; const bf16_t* ZC = QC + 2 * qkstride; const bf16_t* VTC = (const bf16_t*)(ws + WS_VTC);
      bf16_t* ORUN = (bf16_t*)p.out; float* LSE = (float*)(ws + WS_LSE);
      int tid_a = tid; asm volatile("" : "+v"(tid_a));
      const int lane_a = tid_a & 63, q = lane_a & 31, h = lane_a >> 5;
      const int bprsh = 6 - 2 * g;
      const int nitems = cw >> 1, ipc = att_ipc << (cwsh - 10);
      const int i0 = bx * ipc, i1 = (i0 + ipc < nitems) ? i0 + ipc : nitems;
      u32x4 stg[12];
      const int krow0 = tid_a >> 4, kslot = tid_a & 15;
      const int klds0 = krow0 * 256 + ((kslot ^ (krow0 & 15)) << 4);
      const int vrow0 = tid_a >> 2, vslot = tid_a & 3, vlds0 = vrow0 * 784 + vslot * 16;
#define ATT_LOADK(IT) do { const int hl_ = (IT) >> 6, rem_ = (IT) & 63, rr_ = rem_ >> bprsh, jb_ = rem_ & ((1 << bprsh) - 1), kb0_ = 256 * jb_ - 128; \
        const bf16_t* kp_ = KC + (((long)rr_ + (long)dil * (kb0_ + krow0)) << cwsh) + hl_ * 128 + kslot * 8; const long kst_ = ((long)dil * 32) << cwsh; \
        _Pragma("unroll") for (int i_ = 0; i_ < 12; ++i_) { if (kb0_ + 32 * i_ >= 0) stg[i_] = *(const u32x4*)(kp_ + i_ * kst_); else stg[i_] = (u32x4){0u, 0u, 0u, 0u}; } } while (0)
#define ATT_STOREK() do { _Pragma("unroll") for (int i_ = 0; i_ < 12; ++i_) *(LAS u32x4*)(lds + klds0 + i_ * 8192) = stg[i_]; } while (0)
#define ATT_LOADV(IT) do { const int hl_ = (IT) >> 6, rem_ = (IT) & 63, rr_ = rem_ >> bprsh, jb_ = rem_ & ((1 << bprsh) - 1), kb0_ = 256 * jb_ - 128; \
        const bf16_t* vp_ = VTC + (((long)(((long)rr_ * L + kb0_) >> 5) << cwsh) + hl_ * 128 + vrow0) * 32 + vslot * 8;     \
        _Pragma("unroll") for (int i_ = 0; i_ < 12; ++i_) { if (kb0_ + 32 * i_ >= 0) stg[i_] = *(const u32x4*)(vp_ + (((long)i_ * 32) << cwsh)); else stg[i_] = (u32x4){0u, 0u, 0u, 0u}; } } while (0)
#define ATT_STOREV() do { _Pragma("unroll") for (int i_ = 0; i_ < 12; ++i_) *(LAS u32x4*)(lds + vlds0 + i_ * 64) = stg[i_]; } while (0)
      if (i0 < i1) { __syncthreads(); ATT_LOADK(i0); ATT_STOREK(); }
#pragma unroll 1
      for (int it = i0; it < i1; ++it) {
        const int hl = it >> 6, rem = it & 63, rr = rem >> bprsh, jblk = rem & ((1 << bprsh) - 1);
        const int hd = hbase + hl;
        const float slope2 = __builtin_amdgcn_exp2f((float)(g * 16 + hd + 1) * (-8.f / 48.f)) * (float)dil * LOG2E;
        const int jq = 256 * jblk + 32 * wave + q, tq = rr + dil * jq;
        const int kbw = 256 * jblk + 32 * wave - 128;
        int dbase = q + 128 - 4 * h; asm volatile("" : "+v"(dbase));
        bf16x8 qf[8];
        { const bf16_t* qp = QC + ((size_t)tq << cwsh) + hl * 128 + 8 * h;
#pragma unroll
          for (int s = 0; s < 8; ++s) qf[s] = *(const bf16x8*)(qp + 16 * s); }
        __syncthreads();
        f32x16 S5[5];
        float mx = -1e30f;
#pragma unroll
        for (int kt = 0; kt < 5; ++kt) {
          const int kb = kbw + 32 * kt;
#pragma unroll
          for (int i = 0; i < 16; ++i) S5[kt][i] = 0.f;
          if (kb >= 0) {
            const LAS unsigned char* kr = lds + (32 * wave + 32 * kt + q) * 256;
#pragma unroll
            for (int s = 0; s < 8; ++s) { const bf16x8 kf = *(const LAS bf16x8*)(kr + (((2 * s + h) ^ (q & 15)) << 4)); S5[kt] = MFMA32(kf, qf[s], S5[kt]); }
#pragma unroll
            for (int i = 0; i < 16; ++i) { const int cki = 32 * kt + (i & 3) + 8 * (i >> 2); const int delta = dbase - cki;
              const bool valid = (kt == 0) ? (delta <= 128) : ((kt == 4) ? (delta >= 0) : true);
              const float v = valid ? fmaf(slope2, (float)cki, S5[kt][i]) : -1e30f; S5[kt][i] = v; mx = fmaxf(mx, v); }
          } else {
#pragma unroll
            for (int i = 0; i < 16; ++i) S5[kt][i] = -1e30f;
          }
          __builtin_amdgcn_sched_barrier(0);
        }
        const float hb = slope2 * (float)(4 * h);
        mx += hb; mx = xh_max(mx);
        const float mxa = mx - hb;
        __builtin_amdgcn_sched_barrier(0);
        ATT_LOADV(it);
        __builtin_amdgcn_sched_barrier(0);
        float lsum = 0.f;
        bf16x8 pf[5][2];
#pragma unroll
        for (int kt = 0; kt < 5; ++kt) {
#pragma unroll
          for (int i = 0; i < 16; ++i) { const float pv = __builtin_amdgcn_exp2f(S5[kt][i] - mxa); S5[kt][i] = pv; lsum += pv; }
#pragma unroll
          for (int s2 = 0; s2 < 2; ++s2) { u32x4 w; w.x = pk2(S5[kt][8 * s2], S5[kt][8 * s2 + 1]); w.y = pk2(S5[kt][8 * s2 + 2], S5[kt][8 * s2 + 3]); w.z = pk2(S5[kt][8 * s2 + 4], S5[kt][8 * s2 + 5]); w.w = pk2(S5[kt][8 * s2 + 6], S5[kt][8 * s2 + 7]);
            pf[kt][s2] = __builtin_bit_cast(bf16x8, w); }
          __builtin_amdgcn_sched_barrier(0);
        }
        const float ltot = xh_sum(lsum);
        __syncthreads();
        ATT_STOREV();
        __syncthreads();
        f32x16 O[4];
#pragma unroll
        for (int ct = 0; ct < 4; ++ct)
#pragma unroll
          for (int i = 0; i < 16; ++i) O[ct][i] = 0.f;
#pragma unroll
        for (int kt = 0; kt < 5; ++kt) {
          if (kbw + 32 * kt >= 0) {
#pragma unroll
            for (int s2 = 0; s2 < 2; ++s2) { const int ks = 2 * wave + 2 * kt + s2;
#pragma unroll
              for (int ct = 0; ct < 4; ++ct) { const bf16x8 vf = *(const LAS bf16x8*)(lds + (32 * ct + q) * 784 + (16 * ks + 8 * h) * 2); O[ct] = MFMA32(vf, pf[kt][s2], O[ct]); }
              __builtin_amdgcn_sched_barrier(0); }
          }
        }
        const float inv = __builtin_amdgcn_rcpf(ltot); float lse2 = (mx - slope2 * (float)(dbase + 4 * h)) + __builtin_amdgcn_logf(ltot);
        float wo = 0.f, wn = inv;
        float* lsep = LSE + (size_t)tq * 16 + hd;
        if (g > 0) { const float lold = *lsep; const float mm = fmaxf(lold, lse2); const float eo = __builtin_amdgcn_exp2f(lold - mm), en = __builtin_amdgcn_exp2f(lse2 - mm), den = eo + en, rden = __builtin_amdgcn_rcpf(den);
          wo = eo * rden; wn = en * rden * inv; lse2 = mm + __builtin_amdgcn_logf(den); }
        if (g < 2 && h == 0) *lsep = lse2;
        int le = lane_a; asm volatile("" : "+v"(le));
        const int c8 = le & 15, r4 = le >> 4;
        u32x4 ovv[8], zzv[8];
#pragma unroll
        for (int k = 0; k < 8; ++k) { ovv[k] = (u32x4){0u, 0u, 0u, 0u}; zzv[k] = (u32x4){0u, 0u, 0u, 0u}; }
        const int tok0 = rr + dil * (256 * jblk + 32 * wave + r4);
        bf16_t* op0 = ORUN + (size_t)tok0 * DINNER + hd * 128 + c8 * 8; const bf16_t* zp0 = ZC + (size_t)tok0 * 1024 + hl * 128 + c8 * 8;
        const long ostep = (long)dil * 4 * DINNER, zstep = (long)dil * 4 * 1024;
#pragma unroll
        for (int k = 0; k < 8; ++k) { if (g > 0) ovv[k] = *(const u32x4*)(op0 + k * ostep); if (g == 2) zzv[k] = *(const u32x4*)(zp0 + k * zstep); }
        __builtin_amdgcn_sched_barrier(0);
        __syncthreads();
        { LAS unsigned char* ow = lds + wave * 16896;
          LAS float* wov = (LAS float*)(lds + 135168 + wave * 128);
#pragma unroll
          for (int ct = 0; ct < 4; ++ct)
#pragma unroll
            for (int i4 = 0; i4 < 4; ++i4) *(LAS f32x4*)(ow + q * 528 + (32 * ct + 8 * i4 + 4 * h) * 4) = (f32x4){O[ct][4 * i4] * wn, O[ct][4 * i4 + 1] * wn, O[ct][4 * i4 + 2] * wn, O[ct][4 * i4 + 3] * wn};
          if (h == 0) wov[q] = wo;
          LDS_WAIT();
          __builtin_amdgcn_sched_barrier(0);
          if (it + 1 < i1) ATT_LOADK(it + 1);
          __builtin_amdgcn_sched_barrier(0);
#pragma unroll
          for (int k = 0; k < 8; ++k) { const int row = 4 * k + r4;
            const f32x4 a = *(const LAS f32x4*)(ow + row * 528 + c8 * 32), b = *(const LAS f32x4*)(ow + row * 528 + c8 * 32 + 16);
            float o[8] = {a[0], a[1], a[2], a[3], b[0], b[1], b[2], b[3]};
            if (g > 0) { const float w = wov[row]; const u32x4 ov = ovv[k];
              o[0] += w * bf_lo(ov.x); o[1] += w * bf_hi(ov.x); o[2] += w * bf_lo(ov.y); o[3] += w * bf_hi(ov.y); o[4] += w * bf_lo(ov.z); o[5] += w * bf_hi(ov.z); o[6] += w * bf_lo(ov.w); o[7] += w * bf_hi(ov.w); }
            if (g == 2) { const u32x4 zz = zzv[k];
              const float z[8] = {bf_lo(zz.x), bf_hi(zz.x), bf_lo(zz.y), bf_hi(zz.y), bf_lo(zz.z), bf_hi(zz.z), bf_lo(zz.w), bf_hi(zz.w)};
#pragma unroll
              for (int e = 0; e < 8; ++e) o[e] *= z[e] * __builtin_amdgcn_rcpf(1.f + __builtin_amdgcn_exp2f(-LOG2E * z[e])); }
            u32x4 w4; w4.x = pk2(o[0], o[1]); w4.y = pk2(o[2], o[3]); w4.z = pk2(o[4], o[5]); w4.w = pk2(o[6], o[7]);
            *(u32x4*)(op0 + k * ostep) = w4; } }
        __syncthreads();
        if (it + 1 < i1) ATT_STOREK();
      }
      __syncthreads();
#undef ATT_LOADK
#undef ATT_STOREK
#undef ATT_LOADV
#undef ATT_STOREV
      if (ci_l < 3) { const int n_ = ci_l + 1; convert_chunk_weights(p.in[I_BWIN], p.in[I_WKV], p.in[I_BNORM], p.in[I_KVNORM], (bf16_t*)(ws + WS_WC), n_ < 2 ? n_ : 2, n_ == 3 ? 8 : 0, n_ < 2 ? 2048 : 1024, (LAS float*)(lds + wave * 8448), gw, NGW, lane); }
    }
    SEAM(phA);
  }

  if (IN(15)) {
    const auto& p = fresh_params(); unsigned char* ws = p.ws; FRESH_IDS
    pg8::Order S; S.nsub = 1; S.G = G; S.c = bx; S.K = DINNER;
    S.s0 = pg8::Sub{(const char*)p.out, (const char*)(ws + WS_WO2T), 64, 4, 1, 8}; S.s1 = S.s0;
    pg8::EpiFinal E{(const bf16_t*)(ws + WS_H), p.out, p.in[I_FNORM], (float*)(ws + WS_SSQ), (unsigned*)(ws + WS_CTL + 16384)};
    pg8::gemm_phase<pg8::EpiFinal, false, true>(lds, S, E, wave_s, 1);
  }
#undef IN
#undef SEAM
}

extern "C" void kernel_launch(void* const* d_in, const int* in_sizes, int n_in, void* d_out, int out_size, void* d_ws, size_t ws_size, hipStream_t stream) {
  static int grid = 0;
  if (grid == 0) {
    int dev = 0, cus = 0, per_cu = 0;
    if (n_in != 13 || out_size != SEQ * DM || ws_size < 256 * MiB) { fprintf(stderr, "kernel_launch: unexpected problem (n_in %d out %d ws %zu)\n", n_in, out_size, ws_size); grid = -1; return; }
    (void)hipGetDevice(&dev); (void)hipDeviceGetAttribute(&cus, hipDeviceAttributeMultiprocessorCount, dev);
    if (hipFuncSetAttribute((const void*)yoco_fwd, hipFuncAttributeMaxDynamicSharedMemorySize, LDS_BYTES) != hipSuccess) { fprintf(stderr, "kernel_launch: hipFuncSetAttribute failed\n"); grid = -1; return; }
    if (hipOccupancyMaxActiveBlocksPerMultiprocessor(&per_cu, (const void*)yoco_fwd, 512, LDS_BYTES) != hipSuccess || per_cu < 1) { fprintf(stderr, "kernel_launch: occupancy query says %d\n", per_cu); (void)hipGetLastError(); }
    grid = cus;
    if (grid != 256) fprintf(stderr, "kernel_launch: %d CUs; the residual GEMM epilogues assume 256\n", grid);
  }
  if (grid < 0) return;
  if (hipMemsetAsync((char*)d_ws + WS_CTL, 0, 32768, stream) != hipSuccess) { fprintf(stderr, "kernel_launch: memset of barrier words failed\n"); return; }
  Params p{};
  for (int i = 0; i < 13; ++i) p.in[i] = (const float*)d_in[i];
  p.out = (float*)d_out; p.ws = (unsigned char*)d_ws; p.ph_lo = 0; p.ph_hi = NPHASE;
  void* args[] = {&p};
  hipError_t e = hipLaunchCooperativeKernel((void*)yoco_fwd, dim3(grid), dim3(512), args, LDS_BYTES, stream);
  if (e != hipSuccess) fprintf(stderr, "cooperative launch failed: %s (grid %d)\n", hipGetErrorString(e), grid);
}
```

```cpp
#include <hip/hip_runtime.h>
#include <hip/hip_cooperative_groups.h>
#include <cstdio>
#include <cstdint>
namespace cg = cooperative_groups;

#define LAS __attribute__((address_space(3)))
#define DI __device__ __forceinline__
typedef unsigned short bf16_t;
typedef short bf16x8 __attribute__((ext_vector_type(8)));
typedef short bf16x4 __attribute__((ext_vector_type(4)));
typedef float f32x2 __attribute__((ext_vector_type(2)));
typedef float f32x4 __attribute__((ext_vector_type(4)));
typedef float f32x16 __attribute__((ext_vector_type(16)));
typedef unsigned u32x2 __attribute__((ext_vector_type(2)));
typedef unsigned u32x4 __attribute__((ext_vector_type(4)));
typedef __bf16 bf16v2 __attribute__((ext_vector_type(2)));

constexpr int SEQ = 16384, DM = 1024, DINNER = 2048;
constexpr int A_IN = 5136, GLA_DK = 512, GLA_H = 4, GLA_DVH = 512;
constexpr int GC = 256, NCH = SEQ / GC;
constexpr int KV_OUT = 12288, B_IN = 8192;
constexpr float RMS_EPS = 1e-6f;
constexpr float LOG2E = 1.4426950408889634f;
constexpr size_t MiB = 1u << 20;
constexpr size_t WS_W1T = 0;
constexpr size_t WS_WOT = 22 * MiB;
constexpr size_t WS_LR = 14 * MiB;
constexpr size_t WS_DCH = 15 * MiB;
constexpr size_t WS_SSQ = 16 * MiB;
constexpr size_t WS_LSE = 17 * MiB;
constexpr size_t WS_WO2T = 18 * MiB;
constexpr size_t WS_CTL = 30 * MiB;
constexpr size_t WS_WC = 0;
constexpr size_t WS_H = 32 * MiB;
constexpr size_t WS_QKZ = 64 * MiB;
constexpr size_t WS_KT = 160 * MiB;
constexpr size_t WS_P = 176 * MiB;
constexpr size_t WS_QC = 64 * MiB, WS_VTC = 192 * MiB;

DI unsigned pk2(float lo, float hi) { f32x2 v = {lo, hi}; return __builtin_bit_cast(unsigned, __builtin_convertvector(v, bf16v2)); }
DI float bf_lo(unsigned w) { return __uint_as_float(w << 16); }
DI float bf_hi(unsigned w) { return __uint_as_float(w & 0xffff0000u); }
DI float bf2f(bf16_t b) { return __uint_as_float(((unsigned)b) << 16); }
DI bf16_t f2bf(float f) { return (bf16_t)(pk2(f, 0.f) & 0xffffu); }
#define MFMA32(a, b, c) __builtin_amdgcn_mfma_f32_32x32x16_bf16((a), (b), (c), 0, 0, 0)
DI int lane_id() { int l; asm volatile("v_mbcnt_lo_u32_b32 %0, -1, 0\n\tv_mbcnt_hi_u32_b32 %0, -1, %0" : "=v"(l)); return l; }
DI int crow(int reg, int h) { return (reg & 3) + 8 * (reg >> 2) + 4 * h; }
DI float wave_sum(float v) {
#pragma unroll
  for (int o = 1; o < 64; o <<= 1) v += __shfl_xor(v, o);
  return v;
}
#define LDS_WAIT() asm volatile("s_waitcnt lgkmcnt(0)" ::: "memory")
DI float xh_sum(float x) { const unsigned u = __float_as_uint(x); const u32x2 r = __builtin_amdgcn_permlane32_swap(u, u, false, false); return __uint_as_float(r[0]) + __uint_as_float(r[1]); }
DI float xh_max(float x) { const unsigned u = __float_as_uint(x); const u32x2 r = __builtin_amdgcn_permlane32_swap(u, u, false, false); return fmaxf(__uint_as_float(r[0]), __uint_as_float(r[1])); }

namespace pg8 {
constexpr int BM = 256, BK = 64, HALF = 128, HTB = HALF * BK * 2, STAGE_BYTES = 8 * HTB, NXCD = 8, WGM = 8;
__host__ __device__ __forceinline__ int lds_byte(int r, int c) { const int st = (r >> 4) * 2 + (c >> 5), rr = r & 15, cc = c & 31, ob = rr * 64 + cc * 2; return st * 1024 + (ob ^ (((ob >> 9) & 1) << 5)); }
__host__ __device__ __forceinline__ void stage_rc(int b, int& R, int& C) { const int st = b / 1024, sb = b % 1024, swz = sb ^ (((sb >> 9) & 1) << 5); R = (st >> 1) * 16 + swz / 64; C = (st & 1) * 32 + (swz % 64) / 2; }
__host__ __device__ __forceinline__ int p16(int x) { return x < 4 ? x : (x < 8 ? x + 4 : (x < 12 ? x - 4 : x)); }
__host__ __device__ __forceinline__ int perm32(int rho) { const int n = rho >> 4, i = rho & 15; return 8 * (i >> 2) + 4 * n + (i & 3); }

struct Unit { int pm, pn, sub; const char* a; const char* b; };
struct Sub { const char* A; const char* Bt; int nM, nN, dil, tprsh; };
struct Order {
  Sub s0, s1; int nsub, G, c, K;
  DI bool next(int i, Unit& u) const {
    long L = (long)i * G + c; const int n0 = s0.nM * s0.nN;
    int si = 0;
    if (L >= n0) { if (nsub < 2) return false; L -= n0; si = 1; if (L >= (long)s1.nM * s1.nN) return false; }
    const int nM = si ? s1.nM : s0.nM, nN = si ? s1.nN : s0.nN, dil = si ? s1.dil : s0.dil, tprsh = si ? s1.tprsh : s0.tprsh;
    const char* A = si ? s1.A : s0.A; const char* Bt = si ? s1.Bt : s0.Bt;
    const int nwg = nM * nN;
    int wgid = (int)L; { const int q = nwg / NXCD, r = nwg % NXCD, xcd = wgid % NXCD, off = wgid / NXCD; wgid = (xcd < r ? xcd * (q + 1) : r * (q + 1) + (xcd - r) * q) + off; }
    const int nig = WGM * nN, gid = wgid / nig, fm = gid * WGM, gsz = (nM - fm) < WGM ? (nM - fm) : WGM;
    u.pm = fm + ((wgid % nig) % gsz); u.pn = (wgid % nig) / gsz; u.sub = si;
    u.a = A + (size_t)u.pm * BM * K * 2;
    u.b = Bt + ((size_t)(u.pn >> tprsh) + (size_t)dil * BM * (u.pn & ((1 << tprsh) - 1))) * K * 2;
    return true;
  }
};

template <class Epi, bool ALIGN_EPI, bool SP2>
DI void gemm_phase(LAS unsigned char* lds, const Order& S, const Epi& E, int wave_s, int ldb_mult, int bperm16 = 0, int ldb_mult1 = 1, int bperm16_1 = 0) {
  int tid = wave_s * 64 + lane_id(); asm volatile("" : "+v"(tid));
  const int wid = __builtin_amdgcn_readfirstlane(tid >> 6), lane = tid & 63, wr = wid >> 2, wc = wid & 3, fr = lane & 15, fq = lane >> 4;
  const int K = S.K, nt = K / BK;
  unsigned voffA[2], voffB0[2], voffB1[2];
#pragma unroll
  for (int i = 0; i < 2; ++i) { int R, C; stage_rc(tid * 16 + i * 8192, R, C); const int Rp = (R & ~31) + perm32(R & 31); const int Rb0 = bperm16 ? ((Rp & ~15) | p16(Rp & 15)) : Rp, Rb1 = bperm16_1 ? ((Rp & ~15) | p16(Rp & 15)) : Rp;
    voffA[i] = (unsigned)(R * K + C) * 2u; voffB0[i] = (unsigned)(Rb0 * K * ldb_mult + C) * 2u; voffB1[i] = (unsigned)(Rb1 * K * ldb_mult1 + C) * 2u; }
  const size_t kstep = (size_t)(BK * 2);
  const size_t hstepA = (size_t)HALF * K * 2, hstepB0 = (size_t)HALF * K * 2 * ldb_mult, hstepB1 = (size_t)HALF * K * 2 * ldb_mult1;
  const unsigned ldsw = (unsigned)wid * 1024u;
  const int aoff = lds_byte(wr * 64 + fr, fq * 8), boff = lds_byte(wc * 32 + fr, fq * 8);
#define PG8_SA(b, h) (((b) * 2 + (h)) * HTB)
#define PG8_SB(b, h) ((4 + (b) * 2 + (h)) * HTB)
#define PG8_STAGE(bufoff, gbase, voff) do { _Pragma("unroll") for (int _i = 0; _i < 2; ++_i) \
        __builtin_amdgcn_global_load_lds((const unsigned*)((const char*)(gbase) + (voff)[_i]), (LAS unsigned*)(lds + (bufoff) + ldsw + _i * 8192), 16, 0, 0); } while (0)
#define PG8_LDA(dst, b, h) do { _Pragma("unroll") for (int m = 0; m < 4; ++m) _Pragma("unroll") for (int k = 0; k < 2; ++k) dst[m][k] = *(const LAS bf16x8*)(lds + PG8_SA(b, h) + aoff + m * 2048 + k * 1024); } while (0)
#define PG8_LDB(dst, b, h) do { _Pragma("unroll") for (int n = 0; n < 2; ++n) _Pragma("unroll") for (int k = 0; k < 2; ++k) dst[n][k] = *(const LAS bf16x8*)(lds + PG8_SB(b, h) + boff + n * 2048 + k * 1024); } while (0)
#define PG8_MMA(ai, bj, At, Bt) do { __builtin_amdgcn_s_setprio(1); _Pragma("unroll") for (int m = 0; m < 4; ++m) _Pragma("unroll") for (int n = 0; n < 2; ++n) _Pragma("unroll") for (int k = 0; k < 2; ++k) \
        acc[ai][bj][m][n] = __builtin_amdgcn_mfma_f32_16x16x32_bf16(Bt[n][k], At[m][k], acc[ai][bj][m][n], 0, 0, 0); __builtin_amdgcn_s_setprio(0); } while (0)
#define PG8_WAIT_V(n) asm volatile("s_waitcnt vmcnt(" #n ")" ::: "memory")
#define PG8_WAIT_L(n) asm volatile("s_waitcnt lgkmcnt(" #n ")" ::: "memory")
#define PG8_BAR __builtin_amdgcn_s_barrier()
#define PG8_SCHED __builtin_amdgcn_sched_barrier(0)
  Unit cur, nxt; int ui = 0;
  if (!S.next(0, cur)) return;
  f32x4 acc[2][2][4][2];
#pragma unroll
  for (int a = 0; a < 2; ++a)
#pragma unroll
    for (int b = 0; b < 2; ++b)
#pragma unroll
      for (int m = 0; m < 4; ++m)
#pragma unroll
        for (int n = 0; n < 2; ++n) acc[a][b][m][n] = (f32x4){0.f, 0.f, 0.f, 0.f};
  bf16x8 At[4][2], B0[2][2], B1[2][2];
  const char* cA = cur.a; const char* cB = cur.b;
  unsigned voffB[2] = {cur.sub ? voffB1[0] : voffB0[0], cur.sub ? voffB1[1] : voffB0[1]}; size_t hstepB = cur.sub ? hstepB1 : hstepB0;
  if constexpr (SP2) {
    PG8_STAGE(PG8_SB(0, 0), cB, voffB); PG8_STAGE(PG8_SB(0, 1), cB + hstepB, voffB); PG8_STAGE(PG8_SA(0, 0), cA, voffA); PG8_STAGE(PG8_SA(0, 1), cA + hstepA, voffA);
    if (wr == 1) PG8_BAR;
    PG8_WAIT_V(2); PG8_BAR;
    PG8_STAGE(PG8_SB(1, 0), cB + kstep, voffB); PG8_STAGE(PG8_SA(1, 0), cA + kstep, voffA); PG8_STAGE(PG8_SB(1, 1), cB + hstepB + kstep, voffB);
    PG8_WAIT_V(6); PG8_BAR;
  } else {
    PG8_STAGE(PG8_SB(0, 0), cB, voffB); PG8_STAGE(PG8_SA(0, 0), cA, voffA); PG8_STAGE(PG8_SB(0, 1), cB + hstepB, voffB); PG8_STAGE(PG8_SA(0, 1), cA + hstepA, voffA);
    if (wr == 1) PG8_BAR;
    PG8_WAIT_V(4); PG8_BAR;
    PG8_STAGE(PG8_SB(1, 0), cB + kstep, voffB); PG8_STAGE(PG8_SA(1, 0), cA + kstep, voffA); PG8_STAGE(PG8_SB(1, 1), cB + hstepB + kstep, voffB);
    PG8_WAIT_V(6); PG8_BAR;
  }
  for (;;) {
    const bool has_next = S.next(ui + 1, nxt);
    const char* nA = has_next ? nxt.a : cA; const char* nB = has_next ? nxt.b : cB;
    for (int t = 0; t < nt; t += 2) {
      const bool last = (t == nt - 2);
      if (last && has_next) { voffB[0] = nxt.sub ? voffB1[0] : voffB0[0]; voffB[1] = nxt.sub ? voffB1[1] : voffB0[1]; hstepB = nxt.sub ? hstepB1 : hstepB0; }
      const char* a1 = cA + (size_t)(t + 1) * kstep;
      const char* a2 = last ? nA : cA + (size_t)(t + 2) * kstep; const char* b2 = last ? nB : cB + (size_t)(t + 2) * kstep;
      const char* a3 = a2 + kstep; const char* b3 = b2 + kstep;
      if constexpr (SP2) {
        PG8_LDB(B0, 0, 0); PG8_LDB(B1, 0, 1); PG8_SCHED; PG8_LDA(At, 0, 0); PG8_STAGE(PG8_SA(1, 1), a1 + hstepA, voffA);
        PG8_WAIT_V(8); PG8_WAIT_L(0); PG8_BAR; PG8_MMA(0, 0, At, B0); PG8_MMA(0, 1, At, B1); PG8_BAR; PG8_SCHED;
        PG8_LDA(At, 0, 1); PG8_STAGE(PG8_SB(0, 0), b2, voffB); PG8_STAGE(PG8_SB(0, 1), b2 + hstepB, voffB); PG8_STAGE(PG8_SA(0, 0), a2, voffA);
        PG8_WAIT_V(8); PG8_WAIT_L(0); PG8_BAR; PG8_MMA(1, 0, At, B0); PG8_MMA(1, 1, At, B1); PG8_BAR; PG8_SCHED;
        PG8_LDB(B0, 1, 0); PG8_LDB(B1, 1, 1); PG8_SCHED; PG8_LDA(At, 1, 0); PG8_STAGE(PG8_SA(0, 1), a2 + hstepA, voffA);
        PG8_WAIT_V(8); PG8_WAIT_L(0); PG8_BAR; PG8_MMA(0, 0, At, B0); PG8_MMA(0, 1, At, B1); PG8_BAR; PG8_SCHED;
        PG8_LDA(At, 1, 1); PG8_STAGE(PG8_SB(1, 0), b3, voffB); PG8_STAGE(PG8_SB(1, 1), b3 + hstepB, voffB); PG8_STAGE(PG8_SA(1, 0), a3, voffA);
        PG8_WAIT_V(8); PG8_WAIT_L(0); PG8_BAR; PG8_MMA(1, 0, At, B0); PG8_MMA(1, 1, At, B1); PG8_BAR; PG8_SCHED;
      } else {
        PG8_LDB(B0, 0, 0); PG8_SCHED; PG8_LDA(At, 0, 0); PG8_STAGE(PG8_SA(1, 1), a1 + hstepA, voffA);
        PG8_WAIT_L(8); PG8_BAR; PG8_WAIT_L(0); PG8_MMA(0, 0, At, B0); PG8_BAR; PG8_SCHED;
        PG8_LDB(B1, 0, 1); PG8_STAGE(PG8_SB(0, 0), b2, voffB);
        PG8_BAR; PG8_WAIT_L(0); PG8_MMA(0, 1, At, B1); PG8_BAR;
        PG8_LDA(At, 0, 1); PG8_STAGE(PG8_SA(0, 0), a2, voffA);
        PG8_BAR; PG8_WAIT_L(0); PG8_MMA(1, 0, At, B0); PG8_BAR; PG8_SCHED;
        PG8_STAGE(PG8_SB(0, 1), b2 + hstepB, voffB);
        PG8_WAIT_V(6); PG8_BAR; PG8_MMA(1, 1, At, B1); PG8_BAR;
        PG8_LDB(B0, 1, 0); PG8_SCHED; PG8_LDA(At, 1, 0); PG8_STAGE(PG8_SA(0, 1), a2 + hstepA, voffA);
        PG8_WAIT_L(8); PG8_BAR; PG8_WAIT_L(0); PG8_MMA(0, 0, At, B0); PG8_BAR; PG8_SCHED;
        PG8_LDB(B1, 1, 1); PG8_STAGE(PG8_SB(1, 0), b3, voffB);
        PG8_BAR; PG8_WAIT_L(0); PG8_MMA(0, 1, At, B1); PG8_BAR;
        PG8_LDA(At, 1, 1); PG8_STAGE(PG8_SA(1, 0), a3, voffA);
        PG8_BAR; PG8_WAIT_L(0); PG8_MMA(1, 0, At, B0); PG8_BAR; PG8_SCHED;
        PG8_STAGE(PG8_SB(1, 1), b3 + hstepB, voffB);
        PG8_WAIT_V(6); PG8_BAR; PG8_MMA(1, 1, At, B1); PG8_BAR;
      }
    }
    if constexpr (ALIGN_EPI) { if (wr == 0) PG8_BAR; }
    if constexpr (!Epi::AFTER_DRAIN) { E(acc, cur, wr, wc, fr, fq); }
    if (!has_next) break;
#pragma unroll
    for (int a = 0; a < 2; ++a)
#pragma unroll
      for (int b = 0; b < 2; ++b)
#pragma unroll
        for (int m = 0; m < 4; ++m)
#pragma unroll
          for (int n = 0; n < 2; ++n) acc[a][b][m][n] = (f32x4){0.f, 0.f, 0.f, 0.f};
    cur = nxt; cA = nA; cB = nB; ++ui;
    if constexpr (ALIGN_EPI) { if (wr == 1) PG8_BAR; }
  }
  PG8_WAIT_V(0);
  if constexpr (!ALIGN_EPI) { if (wr == 0) PG8_BAR; }
  PG8_BAR;
  if constexpr (Epi::AFTER_DRAIN) { E.fused(acc, cur, wr, wc, fr, fq, lds, wid, lane); }
#undef PG8_SA
#undef PG8_SB
#undef PG8_STAGE
#undef PG8_LDA
#undef PG8_LDB
#undef PG8_MMA
#undef PG8_WAIT_V
#undef PG8_WAIT_L
#undef PG8_BAR
#undef PG8_SCHED
}

struct EpiBf16Two {
  static constexpr bool AFTER_DRAIN = false;
  bf16_t* O0; int ldc0; bf16_t* O1; int ldc1;
  DI void operator()(const f32x4 (&acc)[2][2][4][2], const Unit& u, int wr, int wc, int fr_, int fq_) const {
    (void)fr_; (void)fq_; const int l_ = lane_id(); const int fr = l_ & 15, fq = l_ >> 4;
    const int row0 = u.pm * BM + wr * 64 + fr, col0 = u.pn * BM + wc * 32 + 8 * fq;
#pragma unroll
    for (int ai = 0; ai < 2; ++ai)
#pragma unroll
      for (int m = 0; m < 4; ++m) { const int row = row0 + ai * HALF + m * 16;
#pragma unroll
        for (int bj = 0; bj < 2; ++bj) { const f32x4 v0 = acc[ai][bj][m][0], v1 = acc[ai][bj][m][1]; const int col = col0 + bj * HALF;
          u32x4 w; w.x = pk2(v0[0], v0[1]); w.y = pk2(v0[2], v0[3]); w.z = pk2(v1[0], v1[1]); w.w = pk2(v1[2], v1[3]);
          bf16_t* dst = u.sub ? O1 + ((size_t)(col >> 5) * ldc1 + row) * 32 + (col & 31)
                              : O0 + (size_t)row * ldc0 + col;
          *(u32x4*)dst = w; } }
  }
};
struct EpiRowScale3 {
  static constexpr bool AFTER_DRAIN = false;
  bf16_t* O0; const float* ssq; int cw, tpbsh; size_t bstride; int dsh;
  DI void operator()(const f32x4 (&acc)[2][2][4][2], const Unit& u, int wr, int wc, int fr_, int fq_) const {
    (void)fr_; (void)fq_; const int l_ = lane_id(); const int fr = l_ & 15, fq = l_ >> 4;
    const int t = u.pn >> tpbsh; bf16_t* base = O0 + (size_t)t * bstride;
    const int row0 = u.pm * BM + wr * 64 + fr, col0 = (u.pn & ((1 << tpbsh) - 1)) * BM + wc * 32 + 8 * fq;
#pragma unroll
    for (int ai = 0; ai < 2; ++ai)
#pragma unroll
      for (int m = 0; m < 4; ++m) { const int row = row0 + ai * HALF + m * 16;
        const f32x4 sq = *(const f32x4*)(ssq + (size_t)row * 4); const float rs = rsqrtf(((sq[0] + sq[1]) + (sq[2] + sq[3])) * (1.0f / DM) + RMS_EPS);
        const int tp = ((row & ((1 << dsh) - 1)) << (14 - dsh)) + (row >> dsh);
        bf16_t* rowp = (t < 2) ? base + ((((size_t)(col0 >> 7)) << 14) + tp) * 128 + (col0 & 127) : base + (size_t)row * cw + col0;
        const size_t bjstep = (t < 2) ? ((size_t)128 << 14) : (size_t)HALF;
#pragma unroll
        for (int bj = 0; bj < 2; ++bj) { const f32x4 v0 = acc[ai][bj][m][0] * rs, v1 = acc[ai][bj][m][1] * rs;
          u32x4 w; w.x = pk2(v0[0], v0[1]); w.y = pk2(v0[2], v0[3]); w.z = pk2(v1[0], v1[1]); w.w = pk2(v1[2], v1[3]);
          *(u32x4*)(rowp + bj * bjstep) = w; } }
  }
};
struct EpiColScale {
  static constexpr bool AFTER_DRAIN = false;
  bf16_t* O; const float* ssq; int dil, tprsh, cw;
  DI void operator()(const f32x4 (&acc)[2][2][4][2], const Unit& u, int wr, int wc, int fr_, int fq_) const {
    (void)fr_; (void)fq_; const int l_ = lane_id(); const int fr = l_ & 15, fq = l_ >> 4;
    const int row0 = u.pm * BM + wr * 64 + fr, col0 = u.pn * BM + wc * 32 + 8 * fq;
    const int r = u.pn >> tprsh, j0 = (u.pn & ((1 << tprsh) - 1)) * BM + wc * 32 + 8 * fq;
#pragma unroll
    for (int bj = 0; bj < 2; ++bj) {
      float rs[8];
#pragma unroll
      for (int e = 0; e < 8; ++e) { const int cc = j0 + bj * HALF + e; const int tok = r + dil * ((cc & ~15) | p16(cc & 15)); const f32x4 sq = *(const f32x4*)(ssq + (size_t)tok * 4);
        rs[e] = rsqrtf(((sq[0] + sq[1]) + (sq[2] + sq[3])) * (1.0f / DM) + RMS_EPS); }
#pragma unroll
      for (int ai = 0; ai < 2; ++ai)
#pragma unroll
        for (int m = 0; m < 4; ++m) { bf16_t* dst = O + ((size_t)((col0 + bj * HALF) >> 5) * cw + row0 + ai * HALF + m * 16) * 32 + ((col0 + bj * HALF) & 31);
          const f32x4 v0 = acc[ai][bj][m][0], v1 = acc[ai][bj][m][1];
          u32x4 w; w.x = pk2(v0[0] * rs[0], v0[1] * rs[1]); w.y = pk2(v0[2] * rs[2], v0[3] * rs[3]);
          w.z = pk2(v1[0] * rs[4], v1[1] * rs[5]); w.w = pk2(v1[2] * rs[6], v1[3] * rs[7]);
          *(u32x4*)dst = w; }
      __builtin_amdgcn_sched_barrier(0);
    }
  }
};
struct EpiChunk {
  static constexpr bool AFTER_DRAIN = false;
  EpiRowScale3 e0; EpiColScale e1;
  DI void operator()(const f32x4 (&acc)[2][2][4][2], const Unit& u, int wr, int wc, int fr, int fq) const { if (u.sub) e1(acc, u, wr, wc, fr, fq); else e0(acc, u, wr, wc, fr, fq); }
};
template <bool BASE_BF16> struct EpiResidual {
  static constexpr bool AFTER_DRAIN = true;
  const void* base; bf16_t* outb; float* ssq;
  DI void operator()(const f32x4 (&)[2][2][4][2], const Unit&, int, int, int, int) const {}
  DI void fused(f32x4 (&acc)[2][2][4][2], const Unit& u, int wr, int wc, int fr_, int fq_, LAS unsigned char* lds, int wid, int lane_) const {
    (void)fr_; (void)fq_; (void)lane_;
    const int l = lane_id(), fr = l & 15, fq = l >> 4;
#pragma unroll
    for (int ps = 0; ps < 4; ++ps) {
      const int ai = ps >> 1, mh = ps & 1;
#pragma unroll
      for (int m1 = 0; m1 < 2; ++m1) { const int lr = wr * 32 + m1 * 16 + fr;
#pragma unroll
        for (int bj = 0; bj < 2; ++bj)
#pragma unroll
          for (int n = 0; n < 2; ++n) *(LAS f32x4*)(lds + lr * 1040 + (128 * bj + 32 * wc + 8 * fq + 4 * n) * 4) = acc[ai][bj][2 * mh + m1][n]; }
      __syncthreads();
      f32x4 xv[8];
#pragma unroll
      for (int i = 0; i < 8; ++i) { const int lr = 8 * wid + i; const int row = 128 * ai + 64 * (lr >> 5) + 16 * (2 * mh + ((lr >> 4) & 1)) + (lr & 15);
        const size_t off = (size_t)(u.pm * BM + row) * DM + u.pn * BM + 4 * l;
        if constexpr (BASE_BF16) { const u32x2 b2 = *(const u32x2*)((const bf16_t*)base + off); xv[i] = (f32x4){bf_lo(b2.x), bf_hi(b2.x), bf_lo(b2.y), bf_hi(b2.y)}; }
        else xv[i] = *(const f32x4*)((const float*)base + off); }
#pragma unroll
      for (int i = 0; i < 8; ++i) { const int lr = 8 * wid + i; const int row = 128 * ai + 64 * (lr >> 5) + 16 * (2 * mh + ((lr >> 4) & 1)) + (lr & 15);
        const size_t off = (size_t)(u.pm * BM + row) * DM + u.pn * BM + 4 * l;
        const f32x4 a = *(const LAS f32x4*)(lds + lr * 1040 + l * 16);
        const f32x4 v = a + xv[i];
        { u32x2 w; w.x = pk2(v[0], v[1]); w.y = pk2(v[2], v[3]); *(u32x2*)(outb + off) = w; }
        float sq = (v[0] * v[0] + v[1] * v[1]) + (v[2] * v[2] + v[3] * v[3]);
#pragma unroll
        for (int o = 1; o < 64; o <<= 1) sq += __uint_as_float((unsigned)__builtin_amdgcn_ds_bpermute((l ^ o) << 2, (int)__float_as_uint(sq)));
        if (l == 0) ssq[(size_t)(u.pm * BM + row) * 4 + u.pn] = sq; }
      __syncthreads();
    }
  }
};
struct EpiFinal {
  static constexpr bool AFTER_DRAIN = true;
  const bf16_t* base; float* out; const float* gain; float* ssq; unsigned* cnt;
  DI void operator()(const f32x4 (&)[2][2][4][2], const Unit&, int, int, int, int) const {}
  template <int SWEEP> DI void sweep(f32x4 (&acc)[2][2][4][2], const Unit& u, int wr, int wc, LAS unsigned char* lds, int wid, int l, const f32x4& g4) const {
    const int fr = l & 15, fq = l >> 4;
#pragma unroll
    for (int ps = 0; ps < 4; ++ps) {
      const int ai = ps >> 1, mh = ps & 1;
#pragma unroll
      for (int m1 = 0; m1 < 2; ++m1) { const int lr = wr * 32 + m1 * 16 + fr;
#pragma unroll
        for (int bj = 0; bj < 2; ++bj)
#pragma unroll
          for (int n = 0; n < 2; ++n) *(LAS f32x4*)(lds + lr * 1040 + (128 * bj + 32 * wc + 8 * fq + 4 * n) * 4) = acc[ai][bj][2 * mh + m1][n]; }
      __syncthreads();
      u32x2 xv[8]; f32x4 sqv[8];
#pragma unroll
      for (int i = 0; i < 8; ++i) { const int lr = 8 * wid + i; const int row = 128 * ai + 64 * (lr >> 5) + 16 * (2 * mh + ((lr >> 4) & 1)) + (lr & 15);
        xv[i] = *(const u32x2*)(base + (size_t)(u.pm * BM + row) * DM + u.pn * BM + 4 * l);
        if (SWEEP == 1) sqv[i] = *(const f32x4*)(ssq + (size_t)(u.pm * BM + row) * 4); else sqv[i] = (f32x4){0.f, 0.f, 0.f, 0.f}; }
#pragma unroll
      for (int i = 0; i < 8; ++i) { const int lr = 8 * wid + i; const int row = 128 * ai + 64 * (lr >> 5) + 16 * (2 * mh + ((lr >> 4) & 1)) + (lr & 15);
        const f32x4 a = *(const LAS f32x4*)(lds + lr * 1040 + l * 16);
        const f32x4 v = a + (f32x4){bf_lo(xv[i].x), bf_hi(xv[i].x), bf_lo(xv[i].y), bf_hi(xv[i].y)};
        if (SWEEP == 0) {
          float sq = (v[0] * v[0] + v[1] * v[1]) + (v[2] * v[2] + v[3] * v[3]);
#pragma unroll
          for (int o = 1; o < 64; o <<= 1) sq += __uint_as_float((unsigned)__builtin_amdgcn_ds_bpermute((l ^ o) << 2, (int)__float_as_uint(sq)));
          if (l == 0) ssq[(size_t)(u.pm * BM + row) * 4 + u.pn] = sq;
        } else {
          const float rstd = rsqrtf(((sqv[i][0] + sqv[i][1]) + (sqv[i][2] + sqv[i][3])) * (1.0f / DM) + RMS_EPS);
          *(f32x4*)(out + (size_t)(u.pm * BM + row) * DM + u.pn * BM + 4 * l) = v * rstd * g4; } }
      __syncthreads();
    }
  }
  DI void fused(f32x4 (&acc)[2][2][4][2], const Unit& u, int wr, int wc, int, int, LAS unsigned char* lds, int wid, int) const {
    const int l = lane_id();
    const f32x4 g4 = *(const f32x4*)(gain + u.pn * BM + 4 * l);
    sweep<0>(acc, u, wr, wc, lds, wid, l, g4);
    asm volatile("s_waitcnt vmcnt(0)" ::: "memory");
    __syncthreads();
    if (wid == 0 && l == 0) {
      __builtin_amdgcn_fence(__ATOMIC_RELEASE, "agent"); asm volatile("s_waitcnt vmcnt(0)" ::: "memory");
      (void)__hip_atomic_fetch_add(cnt + 64 * u.pm, 1u, __ATOMIC_RELAXED, __HIP_MEMORY_SCOPE_AGENT);
      unsigned sp = 0;
      while (__hip_atomic_load(cnt + 64 * u.pm, __ATOMIC_RELAXED, __HIP_MEMORY_SCOPE_AGENT) < 4u) { __builtin_amdgcn_s_sleep(2); if (++sp > (1u << 22)) break; }
      __builtin_amdgcn_fence(__ATOMIC_ACQUIRE, "agent"); asm volatile("s_waitcnt vmcnt(0)" ::: "memory");
    }
    __syncthreads();
    sweep<1>(acc, u, wr, wc, lds, wid, l, g4);
  }
};
}


#define XB_TMO      128
#define XB_XCNT(j)  (256  + 64 * (j))
#define XB_XSUB(j)  (1280 + 64 * (j))
#define XB_XGEN(j)  (2304 + 64 * (j))
#define XB_TOP      3328
#define XB_TOPGEN   3392
#define XCD_BAR_WORDS 3456
#define XB_SPIN_CAP (1u << 18)
DI unsigned xb_ld(unsigned* p)              { return __hip_atomic_load(p, __ATOMIC_RELAXED, __HIP_MEMORY_SCOPE_AGENT); }
DI unsigned xb_add(unsigned* p, unsigned v) { return __hip_atomic_fetch_add(p, v, __ATOMIC_RELAXED, __HIP_MEMORY_SCOPE_AGENT); }
DI unsigned xb_xcc_id() { return (unsigned)__builtin_amdgcn_s_getreg((3 << 11) | 20) & 0xFu; }
#define XB_SPIN(cond, bar) do { unsigned _sp = 0; while (cond) { __builtin_amdgcn_s_sleep(1); \
    if ((++_sp & 255u) == 0u) { if (xb_ld(&(bar)[XB_TMO])) break; if (_sp > XB_SPIN_CAP) { atomicAdd(&(bar)[XB_TMO], 1u); break; } } } } while (0)
struct XcdBarrier { unsigned* bar; unsigned x; volatile LAS unsigned* st; };
DI XcdBarrier xcd_barrier_post(unsigned* bar, volatile LAS unsigned* st) {
  XcdBarrier b; b.bar = bar; b.x = xb_xcc_id(); b.st = st;
  if (threadIdx.x == 0) (void)xb_add(&bar[XB_XCNT(b.x)], 1u);
  return b;
}
DI void xcd_barrier_complete(unsigned* bar, unsigned x, unsigned& nloc, unsigned& nx) {
  const unsigned G = gridDim.x * gridDim.y * gridDim.z;
  unsigned sum, cnt, mine, sp = 0u;
  for (;;) {
    sum = 0u; cnt = 0u; mine = 0u;
#pragma unroll
    for (unsigned j = 0; j < 16; ++j) { const unsigned c = xb_ld(&bar[XB_XCNT(j)]); sum += c; cnt += (c > 0u) ? 1u : 0u; mine = (j == x) ? c : mine; }
    if (sum == G) break;
    __builtin_amdgcn_s_sleep(1);
    if ((++sp & 255u) == 0u) { if (xb_ld(&bar[XB_TMO])) break; if (sp > XB_SPIN_CAP) { atomicAdd(&bar[XB_TMO], 1u); break; } }
  }
  nloc = mine > 0u ? mine : 1u; nx = cnt > 0u ? cnt : 1u;
}
DI void xcd_barrier(const XcdBarrier& b, bool is_t0) {
  asm volatile("s_waitcnt vmcnt(0)" ::: "memory");
  __syncthreads();
  if (is_t0) {
    unsigned* bar = b.bar;
    __builtin_amdgcn_s_waitcnt(0);
    unsigned nloc = b.st[0], nx = b.st[1];
    if (nloc == 0u) { xcd_barrier_complete(bar, b.x, nloc, nx); b.st[0] = nloc; b.st[1] = nx; }
    const unsigned old = xb_add(&bar[XB_XSUB(b.x)], 1u);
    const unsigned gen = old / nloc;
    if (old + 1u == (gen + 1u) * nloc) {
      __builtin_amdgcn_fence(__ATOMIC_RELEASE, "agent");
      asm volatile("s_waitcnt vmcnt(0)" ::: "memory");
      const unsigned og = xb_add(&bar[XB_TOP], 1u);
      const unsigned tg = og / nx;
      if (og + 1u == (tg + 1u) * nx) xb_add(&bar[XB_TOPGEN], 1u);
      else XB_SPIN(xb_ld(&bar[XB_TOPGEN]) == tg, bar);
      __builtin_amdgcn_fence(__ATOMIC_ACQUIRE, "agent");
      xb_add(&bar[XB_XGEN(b.x)], 1u);
      asm volatile("s_waitcnt vmcnt(0)" ::: "memory");
    } else {
      XB_SPIN(xb_ld(&bar[XB_XGEN(b.x)]) == gen, bar);
      __builtin_amdgcn_fence(__ATOMIC_ACQUIRE, "agent");
      asm volatile("s_waitcnt vmcnt(0)" ::: "memory");
    }
  }
  __syncthreads();
}

struct Params { const float* in[13]; float* out; unsigned char* ws; int ph_lo, ph_hi; };
enum { I_X = 0, I_ANORM, I_AWIN, I_AWGU, I_ABG, I_AGOUT, I_AWOUT, I_KVNORM, I_WKV, I_BNORM, I_BWIN, I_BWOUT, I_FNORM };
constexpr int NPHASE = 16;
constexpr int LDS_BYTES = 147456;

DI void transpose_item(const float* W, int ldw, int c0, const float* gk, float sc, bf16_t* WT, int K, int r0, LAS float* scr, int kb, int nb, int lane) {
  const int k0 = 64 * kb, n0 = 32 * nb;
  float wv[32];
  { const float* wp = W + (size_t)(k0 + (lane >> 5)) * ldw + c0 + n0 + (lane & 31);
#pragma unroll
    for (int i = 0; i < 32; ++i) wv[i] = wp[(size_t)(2 * i) * ldw]; }
#pragma unroll
  for (int i = 0; i < 32; ++i) { const int kk = 2 * i + (lane >> 5); const float g = gk ? gk[k0 + kk] * sc : sc; scr[kk * 33 + (lane & 31)] = wv[i] * g; }
  LDS_WAIT(); asm volatile("" ::: "memory");
  const int c = lane & 7;
#pragma unroll
  for (int j = 0; j < 4; ++j) { const int n = (lane >> 3) + 8 * j; const LAS float* s = scr + (8 * c) * 33 + n;
    u32x4 o; o.x = pk2(s[0 * 33], s[1 * 33]); o.y = pk2(s[2 * 33], s[3 * 33]); o.z = pk2(s[4 * 33], s[5 * 33]); o.w = pk2(s[6 * 33], s[7 * 33]);
    *(u32x4*)(WT + (size_t)(r0 + n0 + n) * K + k0 + 8 * c) = o; }
  LDS_WAIT(); asm volatile("" ::: "memory");
}
DI void convert_chunk_weights(const float* bwin, const float* wkv, const float* bnorm, const float* kvnorm, bf16_t* WC, int g, int hbase, int cw, LAS float* scr, int gw, int NGW, int lane) {
  const float qscale = 0.08838834764831845f * LOG2E;
  const int nseg = (g == 2) ? 4 : 3, nbs = cw >> 5, ips = 16 * nbs;
  for (int it = gw; it < nseg * ips; it += NGW) {
    const int seg = it / ips, r = it - seg * ips, kb = r / nbs, nb = r - kb * nbs;
    const int c0 = g * 2048 + hbase * 128;
    if (seg == 0) transpose_item(bwin, B_IN, c0, bnorm, qscale, WC, DM, 0, scr, kb, nb, lane);
    else if (seg == 1) transpose_item(wkv, KV_OUT, c0, kvnorm, 1.f, WC, DM, cw, scr, kb, nb, lane);
    else if (seg == nseg - 1) transpose_item(wkv, KV_OUT, 6144 + c0, kvnorm, 1.f, WC, DM, (nseg - 1) * cw, scr, kb, nb, lane);
    else transpose_item(bwin, B_IN, 6144 + hbase * 128, bnorm, 1.f, WC, DM, 2 * cw, scr, kb, nb, lane);
  }
}

#define CAS __attribute__((address_space(4)))
#if defined(__HIP_DEVICE_COMPILE__)
DI const CAS Params& fresh_params() { const CAS Params* q = (const CAS Params*)__builtin_amdgcn_kernarg_segment_ptr(); asm volatile("" : "+s"(q)); return *q; }
#else
DI const Params& fresh_params() { return *(const Params*)nullptr; }
#endif
__global__ void __launch_bounds__(512, 2) yoco_fwd(Params p_unused) {
  extern __shared__ __attribute__((aligned(16))) unsigned char lds_raw[];
  LAS unsigned char* lds = (LAS unsigned char*)lds_raw;
  cg::grid_group grid = cg::this_grid();
  const int G = gridDim.x, bx = blockIdx.x, NGW = G * 8;
  const int att_ipc = __builtin_amdgcn_readfirstlane((512 + (int)gridDim.x - 1) / (int)gridDim.x);
  const int wave_s = __builtin_amdgcn_readfirstlane(threadIdx.x >> 6);
#define FRESH_IDS int tid = wave_s * 64 + lane_id(); asm volatile("" : "+v"(tid)); const int lane = tid & 63, wave = wave_s, gw = bx * 8 + wave; (void)lane; (void)gw;
  const int lo = fresh_params().ph_lo, hi = fresh_params().ph_hi;
  volatile LAS unsigned* bst = (volatile LAS unsigned*)(lds + LDS_BYTES - 64);
  if (threadIdx.x < 2) bst[threadIdx.x] = 0u;
  __syncthreads();
  const XcdBarrier xbar = xcd_barrier_post((unsigned*)(fresh_params().ws + WS_CTL), bst);
#ifndef PHASE_MASK
#define PHASE_MASK 0xffffffffu
#endif
#define PH_EN(k) (((PHASE_MASK) >> ((k) > 8 && (k) < 15 ? 7 + (((k) - 7) & 1) : ((k) >= 15 ? (k) - 6 : (k)))) & 1u)
#define IN(k) (PH_EN(k) && lo <= (k) && (k) < hi)
#ifndef PROBE_REGION
#define PROBE_REGION 0
#endif
#if PROBE_REGION
#define RGN_BEGIN(id) unsigned long long rgn_t0_##id = 0; if (PROBE_REGION == (id)) { __syncthreads(); rgn_t0_##id = __builtin_amdgcn_s_memrealtime(); }
#define RGN_END(id) if (PROBE_REGION == (id)) { __syncthreads(); if (threadIdx.x == 0) { const unsigned long long n_ = __builtin_amdgcn_s_memrealtime(); const unsigned long long e_ = n_ + 2 * (n_ - rgn_t0_##id); while (__builtin_amdgcn_s_memrealtime() < e_) __builtin_amdgcn_s_sleep(8); } __syncthreads(); }
#else
#define RGN_BEGIN(id)
#define RGN_END(id)
#endif
#define GSYNC(k) do { if (lo < 0) grid.sync(); xcd_barrier(xbar, wave_s == 0 && lane_id() == 0); } while (0)
#ifndef PROBE_CLASS
#define PROBE_CLASS 0
#endif
#define PROBE_MULT 2
#define PH_CLASS(k) ((k) == 0 ? 1 : (k) == 1 ? 2 : (k) <= 5 ? 3 : (k) == 6 ? 4 : (k) >= 15 ? 7 : (((k) - 7) & 1) ? 6 : 5)
#if PROBE_CLASS
  unsigned long long t_prev = __builtin_amdgcn_s_memrealtime();
#define SEAM(k) do { if (IN(k) && IN((k) + 1)) { GSYNC(k); { if (threadIdx.x == 0) { unsigned long long t_now = __builtin_amdgcn_s_memrealtime(); \
      if (PH_CLASS(k) == PROBE_CLASS) { const unsigned long long t_end = t_now + PROBE_MULT * (t_now - t_prev); while (__builtin_amdgcn_s_memrealtime() < t_end) __builtin_amdgcn_s_sleep(8); t_now = __builtin_amdgcn_s_memrealtime(); } \
      t_prev = t_now; } __syncthreads(); } } } while (0)
#else
#define SEAM(k) do { if (IN(k) && IN((k) + 1)) GSYNC(k); } while (0)
#endif

  if (IN(0)) {
    const auto& p = fresh_params(); unsigned char* ws = p.ws; FRESH_IDS
    LAS float* wlrT = (LAS float*)lds;
    LAS float* scr = (LAS float*)(lds + 65536 + wave * 8448);
    const float* awin = p.in[I_AWIN];
    for (int k = tid; k < DM; k += 512) {
      const f32x4* src = (const f32x4*)(awin + (size_t)k * A_IN + 5120);
#pragma unroll
      for (int q = 0; q < 4; ++q) { const f32x4 v = src[q]; wlrT[(4 * q + 0) * DM + k] = v[0]; wlrT[(4 * q + 1) * DM + k] = v[1]; wlrT[(4 * q + 2) * DM + k] = v[2]; wlrT[(4 * q + 3) * DM + k] = v[3]; }
    }
    bf16_t* W1T = (bf16_t*)(ws + WS_W1T); bf16_t* WOT = (bf16_t*)(ws + WS_WOT); bf16_t* WO2T = (bf16_t*)(ws + WS_WO2T);
    for (int it = gw; it < 2560 + 1024 + 1024; it += NGW) {
      if (it < 2560) { const int kb = it / 160, nbb = it % 160; int c0, r0, nb;
        if (nbb < 16) { c0 = 0; r0 = 0; nb = nbb; } else if (nbb < 32) { c0 = 512; r0 = 512; nb = nbb - 16; } else if (nbb < 96) { c0 = 3072; r0 = 1024; nb = nbb - 32; } else { c0 = 1024; r0 = 3072; nb = nbb - 96; }
        transpose_item(awin, A_IN, c0, nullptr, 1.f, W1T, DM, r0, scr, kb, nb, lane); }
      else if (it < 3584) { const int r = it - 2560; transpose_item(p.in[I_AWOUT], DM, 0, nullptr, 1.f, WOT, DINNER, 0, scr, r >> 5, r & 31, lane); }
      else { const int r = it - 3584; transpose_item(p.in[I_BWOUT], DM, 0, nullptr, 1.f, WO2T, DINNER, 0, scr, r >> 5, r & 31, lane); }
    }
    __syncthreads();
    const float* x = p.in[I_X]; const float* gA = p.in[I_ANORM];
    bf16_t* H = (bf16_t*)(ws + WS_H); float* LR = (float*)(ws + WS_LR);
    f32x4 gv[4];
#pragma unroll
    for (int j = 0; j < 4; ++j) gv[j] = *(const f32x4*)(gA + 4 * lane + 256 * j);
    const int lid = lane_id();
    for (int m0 = gw; m0 < SEQ; m0 += 4 * NGW) {
      f32x4 xv[4][4];
#pragma unroll
      for (int i = 0; i < 4; ++i) { const int m = m0 + i * NGW; const f32x4* xr = (const f32x4*)(x + (size_t)(m < SEQ ? m : gw) * DM) + lane;
#pragma unroll
        for (int j = 0; j < 4; ++j) xv[i][j] = xr[64 * j]; }
#pragma unroll
      for (int i = 0; i < 4; ++i) { const int m = m0 + i * NGW;
        if (m < SEQ) {
          f32x4 v[4]; float s2 = 0.f;
#pragma unroll
          for (int j = 0; j < 4; ++j) { v[j] = xv[i][j]; s2 += (v[j][0] * v[j][0] + v[j][1] * v[j][1]) + (v[j][2] * v[j][2] + v[j][3] * v[j][3]); }
          const float rstd = rsqrtf(wave_sum(s2) * (1.f / DM) + RMS_EPS);
#pragma unroll
          for (int j = 0; j < 4; ++j) v[j] = v[j] * rstd * gv[j];
          u32x2* o8 = (u32x2*)(H + (size_t)m * DM) + lane;
#pragma unroll
          for (int j = 0; j < 4; ++j) { u32x2 w; w.x = pk2(v[j][0], v[j][1]); w.y = pk2(v[j][2], v[j][3]); o8[64 * j] = w; }
          float pa[16];
#pragma unroll
          for (int o = 0; o < 16; ++o) { float a = 0.f;
#pragma unroll
            for (int j = 0; j < 4; ++j) { const f32x4 w = *(const LAS f32x4*)(wlrT + o * DM + 4 * lane + 256 * j); a += (v[j][0] * w[0] + v[j][1] * w[1]) + (v[j][2] * w[2] + v[j][3] * w[3]); }
            pa[o] = a; __builtin_amdgcn_sched_barrier(0); }
          float c8v[8];
#pragma unroll
          for (int j = 0; j < 8; ++j) { const u32x2 rr2 = __builtin_amdgcn_permlane32_swap(__float_as_uint(pa[j]), __float_as_uint(pa[8 + j]), false, false); c8v[j] = __uint_as_float(rr2[0]) + __uint_as_float(rr2[1]); }
          float c4v[4], c2v[2], c1v;
          { const bool up = (lid & 16) != 0;
#pragma unroll
            for (int j = 0; j < 4; ++j) { const float snd = up ? c8v[j] : c8v[4 + j], kp = up ? c8v[4 + j] : c8v[j];
              c4v[j] = kp + __uint_as_float((unsigned)__builtin_amdgcn_ds_bpermute((lid ^ 16) << 2, (int)__float_as_uint(snd))); } }
          { const bool up = (lid & 8) != 0;
#pragma unroll
            for (int j = 0; j < 2; ++j) { const float snd = up ? c4v[j] : c4v[2 + j], kp = up ? c4v[2 + j] : c4v[j];
              c2v[j] = kp + __uint_as_float((unsigned)__builtin_amdgcn_ds_bpermute((lid ^ 8) << 2, (int)__float_as_uint(snd))); } }
          { const bool up = (lid & 4) != 0; const float snd = up ? c2v[0] : c2v[1], kp = up ? c2v[1] : c2v[0];
            c1v = kp + __uint_as_float((unsigned)__builtin_amdgcn_ds_bpermute((lid ^ 4) << 2, (int)__float_as_uint(snd))); }
          c1v += __uint_as_float((unsigned)__builtin_amdgcn_ds_bpermute((lid ^ 2) << 2, (int)__float_as_uint(c1v)));
          c1v += __uint_as_float((unsigned)__builtin_amdgcn_ds_bpermute((lid ^ 1) << 2, (int)__float_as_uint(c1v)));
          if ((lid & 3) == 0) LR[(size_t)m * 16 + (lid >> 2)] = c1v;
        }
      }
    }
  }
  SEAM(0);

  if (IN(1)) {
    const auto& p = fresh_params(); unsigned char* ws = p.ws; FRESH_IDS
    pg8::Order S; S.nsub = 2; S.G = G; S.c = bx; S.K = DM;
    S.s0 = pg8::Sub{(const char*)(ws + WS_H), (const char*)(ws + WS_W1T), 64, 12, 1, 8};
    S.s1 = pg8::Sub{(const char*)(ws + WS_W1T) + (size_t)3072 * DM * 2, (const char*)(ws + WS_H), 8, 64, 1, 8};
    pg8::EpiBf16Two E{(bf16_t*)(ws + WS_QKZ), 3072, (bf16_t*)p.out, DINNER};
    pg8::gemm_phase<pg8::EpiBf16Two, true, true>(lds, S, E, wave_s, 1);
  }
  SEAM(1);

  if (IN(2)) {
    const auto& p = fresh_params(); unsigned char* ws = p.ws; FRESH_IDS
    LAS float* lrs = (LAS float*)lds;
    LAS float* tot = (LAS float*)(lds + 16384);
    bf16_t* QKZ = (bf16_t*)(ws + WS_QKZ); bf16_t* KT = (bf16_t*)(ws + WS_KT); float* DCH = (float*)(ws + WS_DCH);
    const float* LR = (const float*)(ws + WS_LR);
    const int ch = tid & 127, seg = wave >> 1;
    for (int it = bx; it < NCH * GLA_H; it += G) {
      const int c = it >> 2, hd = it & 3, j = hd * 128 + ch;
      __syncthreads();
      { const f32x4* src = (const f32x4*)(LR + (size_t)c * GC * 16); LAS f32x4* dst = (LAS f32x4*)lrs; dst[tid] = src[tid]; dst[tid + 512] = src[tid + 512]; }
      float wg[16];
#pragma unroll
      for (int e = 0; e < 16; ++e) wg[e] = p.in[I_AWGU][e * GLA_DK + j];
      const float bias = p.in[I_ABG][j];
      __syncthreads();
      float cumv[64]; float cum = 0.f;
#pragma unroll
      for (int i = 0; i < 64; ++i) { const LAS f32x4* r4 = (const LAS f32x4*)(lrs + (seg * 64 + i) * 16); float pre = bias;
#pragma unroll
        for (int q = 0; q < 4; ++q) { const f32x4 v = r4[q]; pre += (v[0] * wg[4 * q] + v[1] * wg[4 * q + 1]) + (v[2] * wg[4 * q + 2] + v[3] * wg[4 * q + 3]); }
        const float ls = fminf(pre, 0.f) - 0.6931471805599453f * __builtin_amdgcn_logf(1.f + __builtin_amdgcn_exp2f(-LOG2E * fabsf(pre)));
        cum += ls * (1.f / 16.f); cumv[i] = cum; }
      tot[seg * 128 + ch] = cum;
      __syncthreads();
      float off = 0.f, total = 0.f;
#pragma unroll
      for (int s = 0; s < 4; ++s) { const float t = tot[s * 128 + ch]; total += t; if (s < seg) off += t; }
      const int t0 = c * GC + seg * 64;
      LAS unsigned char* til = lds + 18432;
      const int srow = tid >> 4, sslot = tid & 15;
#pragma unroll 1
      for (int qk = 0; qk < 2; ++qk) {
        bf16_t* gt = QKZ + (size_t)(c * GC + srow) * 3072 + qk * 512 + hd * 128 + sslot * 8;
        { u32x4 tv[8];
#pragma unroll
          for (int i = 0; i < 8; ++i) tv[i] = *(const u32x4*)(gt + (size_t)i * 32 * 3072);
          __syncthreads();
#pragma unroll
          for (int i = 0; i < 8; ++i) *(LAS u32x4*)(til + (srow + 32 * i) * 256 + sslot * 16) = tv[i]; }
        __syncthreads();
        if (qk == 0) {
#pragma unroll
          for (int i = 0; i < 64; ++i) { LAS bf16_t* e = (LAS bf16_t*)(til + (seg * 64 + i) * 256 + ch * 2); const float B = off + cumv[i];
            *e = f2bf(bf2f(*e) * (__builtin_amdgcn_exp2f(LOG2E * B) * 0.08838834764831845f)); }
        } else {
#pragma unroll
          for (int i8 = 0; i8 < 8; ++i8) { float kk[8];
#pragma unroll
            for (int e8 = 0; e8 < 8; ++e8) { const int i = i8 * 8 + e8; LAS bf16_t* e = (LAS bf16_t*)(til + (seg * 64 + i) * 256 + ch * 2); const float B = off + cumv[i];
              const float kv = bf2f(*e) * __builtin_amdgcn_exp2f(fminf(-LOG2E * B, 115.f)); *e = f2bf(kv); kk[e8] = kv; }
            u32x4 w; w.x = pk2(kk[0], kk[1]); w.y = pk2(kk[2], kk[3]); w.z = pk2(kk[4], kk[5]); w.w = pk2(kk[6], kk[7]);
            *(u32x4*)(KT + ((size_t)((t0 + i8 * 8) >> 6) * GLA_DK + j) * 64 + ((t0 + i8 * 8) & 63)) = w; }
        }
        __syncthreads();
#pragma unroll
        for (int i = 0; i < 8; ++i) *(u32x4*)(gt + (size_t)i * 32 * 3072) = *(const LAS u32x4*)(til + (srow + 32 * i) * 256 + sslot * 16);
      }
      if (seg == 0) DCH[c * GLA_DK + j] = __builtin_amdgcn_exp2f(LOG2E * total);
    }
  }
  if (IN(2) && IN(3)) { if (G == NCH * GLA_H) { asm volatile("s_waitcnt vmcnt(0)" ::: "memory"); __syncthreads(); } else { GSYNC(2); } }

  if (IN(3)) {
    const auto& p = fresh_params(); unsigned char* ws = p.ws; FRESH_IDS
    const bf16_t* KT = (const bf16_t*)(ws + WS_KT); const bf16_t* VT = (const bf16_t*)p.out; bf16_t* P = (bf16_t*)(ws + WS_P);
    const int r = lane & 31, h = lane >> 5, mt = wave & 3, nh = wave >> 2;
    const int prow = tid >> 3, pslot = tid & 7;
    const int pl0 = prow * 128 + ((pslot ^ ((prow >> 1) & 7)) << 4);
    const int vrow = tid >> 2, vs4 = tid & 3;
    const int vl0 = vrow * 128 + ((vs4 ^ ((vrow >> 1) & 7)) << 4), vl1 = vrow * 128 + (((4 + vs4) ^ ((vrow >> 1) & 7)) << 4);
    u32x4 pre[16];
#define P3_FETCH(IT) do { const int c_ = (IT) >> 4, hd_ = ((IT) >> 2) & 3, ns_ = (IT) & 3; \
      const bf16_t* ga_ = KT + ((size_t)(c_ * 4) * GLA_DK + hd_ * 128 + prow) * 64 + pslot * 8; const bf16_t* gb_ = VT + ((size_t)(c_ * 8) * DINNER + hd_ * 512 + ns_ * 128 + vrow) * 32 + vs4 * 8; \
      _Pragma("unroll") for (int tb_ = 0; tb_ < 4; ++tb_) { pre[4 * tb_] = *(const u32x4*)(ga_ + (size_t)tb_ * GLA_DK * 64); pre[4 * tb_ + 1] = *(const u32x4*)(ga_ + (size_t)tb_ * GLA_DK * 64 + 64 * 64); \
        pre[4 * tb_ + 2] = *(const u32x4*)(gb_ + (size_t)(2 * tb_) * DINNER * 32); pre[4 * tb_ + 3] = *(const u32x4*)(gb_ + (size_t)(2 * tb_ + 1) * DINNER * 32); } } while (0)
    const int ipw = (NCH * 16 + G - 1) / G, it0 = bx * ipw, it1 = (it0 + ipw < NCH * 16) ? it0 + ipw : NCH * 16;
    if (it0 < it1) P3_FETCH(it0);
    for (int it = it0; it < it1; ++it) {
      const int c = it >> 4, hd = (it >> 2) & 3, ns = it & 3;
      __syncthreads();
#pragma unroll
      for (int tb = 0; tb < 4; ++tb) { *(LAS u32x4*)(lds + tb * 16384 + pl0) = pre[4 * tb]; *(LAS u32x4*)(lds + tb * 16384 + pl0 + 8192) = pre[4 * tb + 1];
        *(LAS u32x4*)(lds + 65536 + tb * 16384 + vl0) = pre[4 * tb + 2]; *(LAS u32x4*)(lds + 65536 + tb * 16384 + vl1) = pre[4 * tb + 3]; }
      __syncthreads();
      if (it + 1 < it1) P3_FETCH(it + 1);
      __builtin_amdgcn_sched_barrier(0);
      f32x16 a0, a1;
#pragma unroll
      for (int i = 0; i < 16; ++i) { a0[i] = 0.f; a1[i] = 0.f; }
      const int ra = 32 * mt + r, rb = 64 * nh + r;
      const int xa = (ra >> 1) & 7, xb = (rb >> 1) & 7;
#pragma unroll
      for (int tb = 0; tb < 4; ++tb)
#pragma unroll
        for (int j = 0; j < 4; ++j) {
          const bf16x8 fa = *(const LAS bf16x8*)(lds + tb * 16384 + ra * 128 + (((4 * h + j) ^ xa) << 4));
          const bf16x8 fb0 = *(const LAS bf16x8*)(lds + 65536 + tb * 16384 + rb * 128 + (((4 * h + j) ^ xb) << 4));
          const bf16x8 fb1 = *(const LAS bf16x8*)(lds + 65536 + tb * 16384 + (rb + 32) * 128 + (((4 * h + j) ^ xb) << 4));
          a0 = MFMA32(fa, fb0, a0); a1 = MFMA32(fa, fb1, a1); }
      bf16_t* o0 = P + ((size_t)(c * 4 + hd) * 512 + ns * 128 + nh * 64 + r) * 128 + 32 * mt + 4 * h; bf16_t* o1 = o0 + 32 * 128;
#pragma unroll
      for (int i4 = 0; i4 < 4; ++i4) { u32x2 w0, w1; w0.x = pk2(a0[4 * i4], a0[4 * i4 + 1]); w0.y = pk2(a0[4 * i4 + 2], a0[4 * i4 + 3]); w1.x = pk2(a1[4 * i4], a1[4 * i4 + 1]); w1.y = pk2(a1[4 * i4 + 2], a1[4 * i4 + 3]);
        *(u32x2*)(o0 + 8 * i4) = w0; *(u32x2*)(o1 + 8 * i4) = w1; }
    }
#undef P3_FETCH
  }
  SEAM(3);

  if (IN(4)) {
    const auto& p = fresh_params(); unsigned char* ws = p.ws; FRESH_IDS
    const unsigned* P = (const unsigned*)(ws + WS_P); const float* DCH = (const float*)(ws + WS_DCH); unsigned* SB = (unsigned*)(ws + WS_H);
    for (int idx = bx * 512 + tid; idx < 131072; idx += G * 512) {
      const int e = idx * 2, k = e & 127, hd = e >> 16;
      float s0 = 0.f, s1 = 0.f;
#pragma unroll 8
      for (int c = 0; c < NCH; ++c) { const unsigned pw = P[(size_t)c * 131072 + idx]; const f32x2 pv = {bf_lo(pw), bf_hi(pw)}; const f32x2 dv = *(const f32x2*)(DCH + c * GLA_DK + hd * 128 + k);
        SB[(size_t)c * 131072 + idx] = pk2(s0, s1); s0 = dv[0] * (s0 + pv[0]); s1 = dv[1] * (s1 + pv[1]); }
    }
  }
  SEAM(4);

  if (IN(5)) {
    const auto& p = fresh_params(); unsigned char* ws = p.ws; FRESH_IDS
    const bf16_t* QKZ = (const bf16_t*)(ws + WS_QKZ); const bf16_t* VT = (const bf16_t*)p.out; const bf16_t* SB = (const bf16_t*)(ws + WS_H);
    bf16_t* OG = (bf16_t*)(ws + WS_P); const float* gout = p.in[I_AGOUT];
    LAS unsigned char* qs = lds;
    LAS unsigned char* ksl = lds + 16384;
    LAS unsigned char* ablk = lds + 81920;
    LAS float* red = (LAS float*)(lds + 133120);
    const int r = lane & 31, h = lane >> 5;
    const int wrow = lane >> 3, wslot = lane & 7;
    const int wl0 = wrow * 128 + ((wslot ^ (wrow >> 1)) << 4), wl1 = wrow * 128 + ((wslot ^ (wrow >> 1) ^ 4) << 4);
    const int srow = tid >> 4, sslot = tid & 15, sl0 = srow * 256 + ((sslot ^ (srow & 15)) << 4);
    const int ipw5 = (NCH * 16 + G - 1) / G, it5a = bx * ipw5, it5b = (it5a + ipw5 < NCH * 16) ? it5a + ipw5 : NCH * 16;
    for (int it = it5a; it < it5b; ++it) {
      const int c = it >> 4, hd = (it >> 2) & 3, ts = it & 3;
      const int t0 = c * GC + ts * 64, ns = (ts + 1) * 64, ntiles = 4 * (ts + 1);
      __syncthreads();
      { u32x4 tq2[2], tk[8];
        const bf16_t* qg = QKZ + (size_t)(t0 + srow) * 3072 + hd * 128 + sslot * 8; const bf16_t* kg = QKZ + (size_t)(c * GC + srow) * 3072 + 512 + hd * 128 + sslot * 8;
#pragma unroll
        for (int i = 0; i < 2; ++i) tq2[i] = *(const u32x4*)(qg + (size_t)i * 32 * 3072);
#pragma unroll
        for (int i = 0; i < 8; ++i) if (32 * i < ns) tk[i] = *(const u32x4*)(kg + (size_t)i * 32 * 3072);
#pragma unroll
        for (int i = 0; i < 2; ++i) *(LAS u32x4*)(qs + sl0 + i * 8192) = tq2[i];
#pragma unroll
        for (int i = 0; i < 8; ++i) if (32 * i < ns) *(LAS u32x4*)(ksl + sl0 + i * 8192) = tk[i]; }
      __syncthreads();
#pragma unroll
      for (int rep = 0; rep < 2; ++rep) { const int ti = wave + 8 * rep;
        if (ti < ntiles) { const int st = ti >> 1, tt = ti & 1;
          const LAS unsigned char* ar = ksl + (32 * st + r) * 256; const LAS unsigned char* br = qs + (32 * tt + r) * 256;
          f32x16 acc;
#pragma unroll
          for (int i = 0; i < 16; ++i) acc[i] = 0.f;
#pragma unroll
          for (int ks = 0; ks < 8; ++ks) { const int so = (((2 * ks + h) ^ (r & 15)) << 4); acc = MFMA32(*(const LAS bf16x8*)(ar + so), *(const LAS bf16x8*)(br + so), acc); }
          const int tl = ts * 64 + 32 * tt + r;
#pragma unroll
          for (int i4 = 0; i4 < 4; ++i4) { float v[4];
#pragma unroll
            for (int e = 0; e < 4; ++e) { const int sl = 32 * st + 8 * i4 + 4 * h + e; v[e] = (sl <= tl) ? acc[4 * i4 + e] : 0.f; }
            u32x2 w; w.x = pk2(v[0], v[1]); w.y = pk2(v[2], v[3]);
            *(LAS u32x2*)(ablk + (32 * tt + r) * 528 + (32 * st + 8 * i4 + 4 * h) * 2) = w; } } }
      __syncthreads();
      f32x16 acc[2][2];
#pragma unroll
      for (int a = 0; a < 2; ++a)
#pragma unroll
        for (int b = 0; b < 2; ++b)
#pragma unroll
          for (int i = 0; i < 16; ++i) acc[a][b][i] = 0.f;
      const bf16_t* sp0 = SB + ((size_t)(c * 4 + hd) * 512 + 64 * wave + wrow) * 128 + wslot * 8;
      const bf16_t* vp0 = VT + ((size_t)(c * 8) * DINNER + hd * 512 + 64 * wave + (lane >> 2)) * 32 + (lane & 3) * 8;
      LAS unsigned char* wl = lds + 16384 + wave * 8192;
      const int nbat = 2 + ns / 64;
      u32x4 pre[8];
#define P5_FETCH(b) do { if ((b) < 2) { _Pragma("unroll") for (int i_ = 0; i_ < 8; ++i_) pre[i_] = *(const u32x4*)(sp0 + (size_t)i_ * 8 * 128 + 64 * (b)); } \
        else { _Pragma("unroll") for (int i_ = 0; i_ < 8; ++i_) pre[i_] = *(const u32x4*)(vp0 + (size_t)(2 * ((b) - 2) + (i_ >> 2)) * DINNER * 32 + (i_ & 3) * 16 * 32); } } while (0)
      P5_FETCH(0);
#pragma unroll
      for (int b = 0; b < 6; ++b) {
        if (b < nbat) {
          if (b < 2) { _Pragma("unroll") for (int i = 0; i < 8; ++i) *(LAS u32x4*)(wl + ((i & 1) ? wl1 : wl0) + i * 1024) = pre[i]; }
          else { _Pragma("unroll") for (int i = 0; i < 8; ++i) { const int rw = 16 * (i & 3) + (lane >> 2), sl = 4 * (i >> 2) + (lane & 3); *(LAS u32x4*)(wl + rw * 128 + ((sl ^ ((rw >> 1) & 7)) << 4)) = pre[i]; } }
          __builtin_amdgcn_sched_barrier(0);
          if (b + 1 < nbat) P5_FETCH(b + 1);
          __builtin_amdgcn_sched_barrier(0);
#pragma unroll
          for (int j = 0; j < 4; ++j) {
            const bf16x8 a0 = *(const LAS bf16x8*)(wl + r * 128 + (((4 * h + j) ^ ((r >> 1) & 7)) << 4)), a1 = *(const LAS bf16x8*)(wl + (32 + r) * 128 + (((4 * h + j) ^ ((r >> 1) & 7)) << 4));
            bf16x8 b0, b1;
            if (b < 2) { const int so = (((8 * b + 4 * h + j) ^ (r & 15)) << 4); b0 = *(const LAS bf16x8*)(qs + r * 256 + so); b1 = *(const LAS bf16x8*)(qs + (32 + r) * 256 + so); }
            else { const int so = (64 * (b - 2) + 32 * h + 8 * j) * 2; b0 = *(const LAS bf16x8*)(ablk + r * 528 + so); b1 = *(const LAS bf16x8*)(ablk + (32 + r) * 528 + so); }
            acc[0][0] = MFMA32(a0, b0, acc[0][0]); acc[0][1] = MFMA32(a0, b1, acc[0][1]); acc[1][0] = MFMA32(a1, b0, acc[1][0]); acc[1][1] = MFMA32(a1, b1, acc[1][1]); }
          __builtin_amdgcn_sched_barrier(0);
        }
      }
#undef P5_FETCH
#pragma unroll
      for (int tt = 0; tt < 2; ++tt) { float sq = 0.f;
#pragma unroll
        for (int mi = 0; mi < 2; ++mi)
#pragma unroll
          for (int i = 0; i < 16; ++i) sq += acc[mi][tt][i] * acc[mi][tt][i];
        sq = xh_sum(sq);
        if (h == 0) red[wave * 64 + 32 * tt + r] = sq; }
      __syncthreads();
#pragma unroll
      for (int tt = 0; tt < 2; ++tt)
#pragma unroll
        for (int mi = 0; mi < 2; ++mi)
#pragma unroll
          for (int i4 = 0; i4 < 4; ++i4)
            *(LAS f32x4*)(lds + (32 * tt + r) * 2064 + (64 * wave + 32 * mi + 8 * i4 + 4 * h) * 4) = (f32x4){acc[mi][tt][4 * i4], acc[mi][tt][4 * i4 + 1], acc[mi][tt][4 * i4 + 2], acc[mi][tt][4 * i4 + 3]};
      __syncthreads();
      const f32x4 ga4 = *(const f32x4*)(gout + lane * 8), gb4 = *(const f32x4*)(gout + lane * 8 + 4);
      u32x4 zzv[8];
#pragma unroll
      for (int i = 0; i < 8; ++i) zzv[i] = *(const u32x4*)(QKZ + (size_t)(t0 + 8 * wave + i) * 3072 + 1024 + hd * 512 + lane * 8);
#pragma unroll
      for (int i = 0; i < 8; ++i) { const int tl = 8 * wave + i, t = t0 + tl;
        float sq = 0.f;
#pragma unroll
        for (int w = 0; w < 8; ++w) sq += red[w * 64 + tl];
        const float rstd = rsqrtf(sq * (1.f / GLA_DVH) + RMS_EPS);
        const f32x4 oa = *(const LAS f32x4*)(lds + tl * 2064 + lane * 32), ob = *(const LAS f32x4*)(lds + tl * 2064 + lane * 32 + 16);
        const u32x4 zz = zzv[i];
        const float z[8] = {bf_lo(zz.x), bf_hi(zz.x), bf_lo(zz.y), bf_hi(zz.y), bf_lo(zz.z), bf_hi(zz.z), bf_lo(zz.w), bf_hi(zz.w)};
        const float ov[8] = {oa[0], oa[1], oa[2], oa[3], ob[0], ob[1], ob[2], ob[3]}; float o[8];
#pragma unroll
        for (int e = 0; e < 8; ++e) o[e] = ov[e] * rstd * (e < 4 ? ga4[e] : gb4[e - 4]) * z[e] * __builtin_amdgcn_rcpf(1.f + __builtin_amdgcn_exp2f(-LOG2E * z[e]));
        u32x4 w4; w4.x = pk2(o[0], o[1]); w4.y = pk2(o[2], o[3]); w4.z = pk2(o[4], o[5]); w4.w = pk2(o[6], o[7]);
        *(u32x4*)(OG + (size_t)t * DINNER + hd * 512 + lane * 8) = w4;
        __builtin_amdgcn_sched_barrier(0); }
    }
  }
  SEAM(5);

  if (IN(6)) {
    const auto& p = fresh_params(); unsigned char* ws = p.ws; FRESH_IDS
    convert_chunk_weights(p.in[I_BWIN], p.in[I_WKV], p.in[I_BNORM], p.in[I_KVNORM], (bf16_t*)(ws + WS_WC), 0, 0, 2048, (LAS float*)(lds + wave * 8448), gw, NGW, lane);
    __syncthreads();
    pg8::Order S; S.nsub = 1; S.G = G; S.c = bx; S.K = DINNER;
    S.s0 = pg8::Sub{(const char*)(ws + WS_P), (const char*)(ws + WS_WOT), 64, 4, 1, 8}; S.s1 = S.s0;
    pg8::EpiResidual<false> E{(const void*)p.in[I_X], (bf16_t*)(ws + WS_H), (float*)(ws + WS_SSQ)};
    pg8::gemm_phase<pg8::EpiResidual<false>, false, true>(lds, S, E, wave_s, 1);
  }
  SEAM(6);

#pragma unroll 1
  for (int ci = 0; ci < 4; ++ci) {
    const int phG = 7 + 2 * ci, phA = 8 + 2 * ci;
#define CHUNK_IDS int ci_l = ci; asm volatile("" : "+s"(ci_l)); const int g = ci_l < 2 ? ci_l : 2, hbase = ci_l == 3 ? 8 : 0, cwsh = ci_l < 2 ? 11 : 10, cw = 1 << cwsh, dil = 1 << (2 * g), L = SEQ >> (2 * g); \
      const size_t qkstride = ci_l < 2 ? ((size_t)32 << 20) : ((size_t)16 << 20); (void)hbase; (void)L; (void)cw; (void)qkstride;
    if (IN(phG)) {
      const auto& p = fresh_params(); unsigned char* ws = p.ws; FRESH_IDS CHUNK_IDS
      { pg8::Order S; S.nsub = 2; S.G = G; S.c = bx; S.K = DM;
        const int tpb = cw >> 8, nN = (g == 2) ? 3 * tpb : 2 * tpb;
        S.s0 = pg8::Sub{(const char*)(ws + WS_H), (const char*)(ws + WS_WC), 64, nN, 1, 8};
        S.s1 = pg8::Sub{(const char*)(ws + WS_WC) + (size_t)nN * 256 * DM * 2, (const char*)(ws + WS_H), tpb, 64, dil, 6 - 2 * g};
        pg8::EpiChunk E{pg8::EpiRowScale3{(bf16_t*)(ws + WS_QC), (const float*)(ws + WS_SSQ), cw, cwsh - 8, qkstride, 2 * g}, pg8::EpiColScale{(bf16_t*)(ws + WS_VTC), (const float*)(ws + WS_SSQ), dil, 6 - 2 * g, cw}};
        pg8::gemm_phase<pg8::EpiChunk, true, true>(lds, S, E, wave_s, 1, 0, dil, 1); }
    }
    SEAM(phG);
    if (IN(phA)) {
      const auto& p = fresh_params(); unsigned char* ws = p.ws; FRESH_IDS CHUNK_IDS
      const bf16_t* QC = (const bf16_t*)(ws + WS_QC); const bf16_t* KC = QC + qkstride; const bf16_t* ZC = QC + 2 * qkstride; const bf16_t* VTC = (const bf16_t*)(ws + WS_VTC);
      bf16_t* ORUN = (bf16_t*)p.out; float* LSE = (float*)(ws + WS_LSE);
      int tid_a = tid; asm volatile("" : "+v"(tid_a));
      const int lane_a = tid_a & 63, q = lane_a & 31, h = lane_a >> 5;
      const int bprsh = 6 - 2 * g;
      const int nitems = cw >> 1, ipc = att_ipc << (cwsh - 10);
      const int i0 = bx * ipc, i1 = (i0 + ipc < nitems) ? i0 + ipc : nitems;
      u32x4 stg[12];
      const int krow0 = tid_a >> 4, kslot = tid_a & 15;
      const int klds0 = krow0 * 256 + ((kslot ^ (krow0 & 15)) << 4);
      const int vrow0 = tid_a >> 2, vslot = tid_a & 3, vlds0 = vrow0 * 784 + vslot * 16;
#define ATT_LOADK(IT) do { const int hl_ = (IT) >> 6, rem_ = (IT) & 63, rr_ = rem_ >> bprsh, jb_ = rem_ & ((1 << bprsh) - 1), kb0_ = 256 * jb_ - 128; \
        const bf16_t* kp_ = KC + ((((long)hl_ << 14) + (long)rr_ * L + kb0_ + krow0) << 7) + kslot * 8; const long kst_ = 32 << 7; \
        _Pragma("unroll") for (int i_ = 0; i_ < 12; ++i_) { if (kb0_ + 32 * i_ >= 0) stg[i_] = *(const u32x4*)(kp_ + i_ * kst_); else stg[i_] = (u32x4){0u, 0u, 0u, 0u}; } } while (0)
#define ATT_STOREK() do { _Pragma("unroll") for (int i_ = 0; i_ < 12; ++i_) *(LAS u32x4*)(lds + klds0 + i_ * 8192) = stg[i_]; } while (0)
#define ATT_LOADV(IT) do { const int hl_ = (IT) >> 6, rem_ = (IT) & 63, rr_ = rem_ >> bprsh, jb_ = rem_ & ((1 << bprsh) - 1), kb0_ = 256 * jb_ - 128; \
        const bf16_t* vp_ = VTC + (((long)(((long)rr_ * L + kb0_) >> 5) << cwsh) + hl_ * 128 + vrow0) * 32 + vslot * 8;     \
        _Pragma("unroll") for (int i_ = 0; i_ < 12; ++i_) { if (kb0_ + 32 * i_ >= 0) stg[i_] = *(const u32x4*)(vp_ + (((long)i_ * 32) << cwsh)); else stg[i_] = (u32x4){0u, 0u, 0u, 0u}; } } while (0)
#define ATT_STOREV() do { _Pragma("unroll") for (int i_ = 0; i_ < 12; ++i_) *(LAS u32x4*)(lds + vlds0 + i_ * 64) = stg[i_]; } while (0)
      if (i0 < i1) { __syncthreads(); ATT_LOADK(i0); ATT_STOREK(); }
#pragma unroll 1
      for (int it = i0; it < i1; ++it) {
        const int hl = it >> 6, rem = it & 63, rr = rem >> bprsh, jblk = rem & ((1 << bprsh) - 1);
        const int hd = hbase + hl;
        const float slope2 = __builtin_amdgcn_exp2f((float)(g * 16 + hd + 1) * (-8.f / 48.f)) * (float)dil * LOG2E;
        const int jq = 256 * jblk + 32 * wave + q, tq = rr + dil * jq;
        const int kbw = 256 * jblk + 32 * wave - 128;
        int dbase = q + 128 - 4 * h; asm volatile("" : "+v"(dbase));
        bf16x8 qf[8];
        { const bf16_t* qp = QC + ((((size_t)hl << 14) + (size_t)rr * L + jq) << 7) + 8 * h;
#pragma unroll
          for (int s = 0; s < 8; ++s) qf[s] = *(const bf16x8*)(qp + 16 * s); }
        __syncthreads();
        f32x16 S5[5];
        float mx = -1e30f;
#pragma unroll
        for (int kt = 0; kt < 5; ++kt) {
          const int kb = kbw + 32 * kt;
#pragma unroll
          for (int i = 0; i < 16; ++i) S5[kt][i] = 0.f;
          if (kb >= 0) {
            const LAS unsigned char* kr = lds + (32 * wave + 32 * kt + q) * 256;
#pragma unroll
            for (int s = 0; s < 8; ++s) { const bf16x8 kf = *(const LAS bf16x8*)(kr + (((2 * s + h) ^ (q & 15)) << 4)); S5[kt] = MFMA32(kf, qf[s], S5[kt]); }
#pragma unroll
            for (int i = 0; i < 16; ++i) { const int cki = 32 * kt + (i & 3) + 8 * (i >> 2); const int delta = dbase - cki;
              const bool valid = (kt == 0) ? (delta <= 128) : ((kt == 4) ? (delta >= 0) : true);
              const float v = valid ? fmaf(slope2, (float)cki, S5[kt][i]) : -1e30f; S5[kt][i] = v; mx = fmaxf(mx, v); }
          } else {
#pragma unroll
            for (int i = 0; i < 16; ++i) S5[kt][i] = -1e30f;
          }
          __builtin_amdgcn_sched_barrier(0);
        }
        const float hb = slope2 * (float)(4 * h);
        mx += hb; mx = xh_max(mx);
        const float mxa = mx - hb;
        __builtin_amdgcn_sched_barrier(0);
        ATT_LOADV(it);
        __builtin_amdgcn_sched_barrier(0);
        float lsum = 0.f;
        bf16x8 pf[5][2];
#pragma unroll
        for (int kt = 0; kt < 5; ++kt) {
#pragma unroll
          for (int i = 0; i < 16; ++i) { const float pv = __builtin_amdgcn_exp2f(S5[kt][i] - mxa); S5[kt][i] = pv; lsum += pv; }
#pragma unroll
          for (int s2 = 0; s2 < 2; ++s2) { u32x4 w; w.x = pk2(S5[kt][8 * s2], S5[kt][8 * s2 + 1]); w.y = pk2(S5[kt][8 * s2 + 2], S5[kt][8 * s2 + 3]); w.z = pk2(S5[kt][8 * s2 + 4], S5[kt][8 * s2 + 5]); w.w = pk2(S5[kt][8 * s2 + 6], S5[kt][8 * s2 + 7]);
            pf[kt][s2] = __builtin_bit_cast(bf16x8, w); }
          __builtin_amdgcn_sched_barrier(0);
        }
        const float ltot = xh_sum(lsum);
        __syncthreads();
        ATT_STOREV();
        __syncthreads();
        f32x16 O[4];
#pragma unroll
        for (int ct = 0; ct < 4; ++ct)
#pragma unroll
          for (int i = 0; i < 16; ++i) O[ct][i] = 0.f;
#pragma unroll
        for (int kt = 0; kt < 5; ++kt) {
          if (kbw + 32 * kt >= 0) {
#pragma unroll
            for (int s2 = 0; s2 < 2; ++s2) { const int ks = 2 * wave + 2 * kt + s2;
#pragma unroll
              for (int ct = 0; ct < 4; ++ct) { const bf16x8 vf = *(const LAS bf16x8*)(lds + (32 * ct + q) * 784 + (16 * ks + 8 * h) * 2); O[ct] = MFMA32(vf, pf[kt][s2], O[ct]); }
              __builtin_amdgcn_sched_barrier(0); }
          }
        }
        const float inv = __builtin_amdgcn_rcpf(ltot); float lse2 = (mx - slope2 * (float)(dbase + 4 * h)) + __builtin_amdgcn_logf(ltot);
        float wo = 0.f, wn = inv;
        float* lsep = LSE + (size_t)tq * 16 + hd;
        if (g > 0) { const float lold = *lsep; const float mm = fmaxf(lold, lse2); const float eo = __builtin_amdgcn_exp2f(lold - mm), en = __builtin_amdgcn_exp2f(lse2 - mm), den = eo + en, rden = __builtin_amdgcn_rcpf(den);
          wo = eo * rden; wn = en * rden * inv; lse2 = mm + __builtin_amdgcn_logf(den); }
        if (g < 2 && h == 0) *lsep = lse2;
        int le = lane_a; asm volatile("" : "+v"(le));
        const int c8 = le & 15, r4 = le >> 4;
        u32x4 ovv[8], zzv[8];
#pragma unroll
        for (int k = 0; k < 8; ++k) { ovv[k] = (u32x4){0u, 0u, 0u, 0u}; zzv[k] = (u32x4){0u, 0u, 0u, 0u}; }
        const int tok0 = rr + dil * (256 * jblk + 32 * wave + r4);
        bf16_t* op0 = ORUN + (size_t)tok0 * DINNER + hd * 128 + c8 * 8; const bf16_t* zp0 = ZC + (size_t)tok0 * 1024 + hl * 128 + c8 * 8;
        const long ostep = (long)dil * 4 * DINNER, zstep = (long)dil * 4 * 1024;
#pragma unroll
        for (int k = 0; k < 8; ++k) { if (g > 0) ovv[k] = *(const u32x4*)(op0 + k * ostep); if (g == 2) zzv[k] = *(const u32x4*)(zp0 + k * zstep); }
        __builtin_amdgcn_sched_barrier(0);
        __syncthreads();
        { LAS unsigned char* ow = lds + wave * 16896;
          LAS float* wov = (LAS float*)(lds + 135168 + wave * 128);
#pragma unroll
          for (int ct = 0; ct < 4; ++ct)
#pragma unroll
            for (int i4 = 0; i4 < 4; ++i4) *(LAS f32x4*)(ow + q * 528 + (32 * ct + 8 * i4 + 4 * h) * 4) = (f32x4){O[ct][4 * i4] * wn, O[ct][4 * i4 + 1] * wn, O[ct][4 * i4 + 2] * wn, O[ct][4 * i4 + 3] * wn};
          if (h == 0) wov[q] = wo;
          LDS_WAIT();
          __builtin_amdgcn_sched_barrier(0);
          if (it + 1 < i1) ATT_LOADK(it + 1);
          __builtin_amdgcn_sched_barrier(0);
#pragma unroll
          for (int k = 0; k < 8; ++k) { const int row = 4 * k + r4;
            const f32x4 a = *(const LAS f32x4*)(ow + row * 528 + c8 * 32), b = *(const LAS f32x4*)(ow + row * 528 + c8 * 32 + 16);
            float o[8] = {a[0], a[1], a[2], a[3], b[0], b[1], b[2], b[3]};
            if (g > 0) { const float w = wov[row]; const u32x4 ov = ovv[k];
              o[0] += w * bf_lo(ov.x); o[1] += w * bf_hi(ov.x); o[2] += w * bf_lo(ov.y); o[3] += w * bf_hi(ov.y); o[4] += w * bf_lo(ov.z); o[5] += w * bf_hi(ov.z); o[6] += w * bf_lo(ov.w); o[7] += w * bf_hi(ov.w); }
            if (g == 2) { const u32x4 zz = zzv[k];
              const float z[8] = {bf_lo(zz.x), bf_hi(zz.x), bf_lo(zz.y), bf_hi(zz.y), bf_lo(zz.z), bf_hi(zz.z), bf_lo(zz.w), bf_hi(zz.w)};
#pragma unroll
              for (int e = 0; e < 8; ++e) o[e] *= z[e] * __builtin_amdgcn_rcpf(1.f + __builtin_amdgcn_exp2f(-LOG2E * z[e])); }
            u32x4 w4; w4.x = pk2(o[0], o[1]); w4.y = pk2(o[2], o[3]); w4.z = pk2(o[4], o[5]); w4.w = pk2(o[6], o[7]);
            *(u32x4*)(op0 + k * ostep) = w4; } }
        __syncthreads();
        if (it + 1 < i1) ATT_STOREK();
      }
      __syncthreads();
#undef ATT_LOADK
#undef ATT_STOREK
#undef ATT_LOADV
#undef ATT_STOREV
      if (ci_l < 3) { const int n_ = ci_l + 1; convert_chunk_weights(p.in[I_BWIN], p.in[I_WKV], p.in[I_BNORM], p.in[I_KVNORM], (bf16_t*)(ws + WS_WC), n_ < 2 ? n_ : 2, n_ == 3 ? 8 : 0, n_ < 2 ? 2048 : 1024, (LAS float*)(lds + wave * 8448), gw, NGW, lane); }
    }
    SEAM(phA);
  }

  if (IN(15)) {
    const auto& p = fresh_params(); unsigned char* ws = p.ws; FRESH_IDS
    pg8::Order S; S.nsub = 1; S.G = G; S.c = bx; S.K = DINNER;
    S.s0 = pg8::Sub{(const char*)p.out, (const char*)(ws + WS_WO2T), 64, 4, 1, 8}; S.s1 = S.s0;
    pg8::EpiFinal E{(const bf16_t*)(ws + WS_H), p.out, p.in[I_FNORM], (float*)(ws + WS_SSQ), (unsigned*)(ws + WS_CTL + 16384)};
    pg8::gemm_phase<pg8::EpiFinal, false, true>(lds, S, E, wave_s, 1);
  }
#undef IN
#undef SEAM
}

extern "C" void kernel_launch(void* const* d_in, const int* in_sizes, int n_in, void* d_out, int out_size, void* d_ws, size_t ws_size, hipStream_t stream) {
  static int grid = 0;
  if (grid == 0) {
    int dev = 0, cus = 0, per_cu = 0;
    if (n_in != 13 || out_size != SEQ * DM || ws_size < 256 * MiB) { fprintf(stderr, "kernel_launch: unexpected problem (n_in %d out %d ws %zu)\n", n_in, out_size, ws_size); grid = -1; return; }
    (void)hipGetDevice(&dev); (void)hipDeviceGetAttribute(&cus, hipDeviceAttributeMultiprocessorCount, dev);
    if (hipFuncSetAttribute((const void*)yoco_fwd, hipFuncAttributeMaxDynamicSharedMemorySize, LDS_BYTES) != hipSuccess) { fprintf(stderr, "kernel_launch: hipFuncSetAttribute failed\n"); grid = -1; return; }
    if (hipOccupancyMaxActiveBlocksPerMultiprocessor(&per_cu, (const void*)yoco_fwd, 512, LDS_BYTES) != hipSuccess || per_cu < 1) { fprintf(stderr, "kernel_launch: occupancy query says %d\n", per_cu); (void)hipGetLastError(); }
    grid = cus;
    if (grid != 256) fprintf(stderr, "kernel_launch: %d CUs; the residual GEMM epilogues assume 256\n", grid);
  }
  if (grid < 0) return;
  if (hipMemsetAsync((char*)d_ws + WS_CTL, 0, 32768, stream) != hipSuccess) { fprintf(stderr, "kernel_launch: memset of barrier words failed\n"); return; }
  Params p{};
  for (int i = 0; i < 13; ++i) p.in[i] = (const float*)d_in[i];
  p.out = (float*)d_out; p.ws = (unsigned char*)d_ws; p.ph_lo = 0; p.ph_hi = NPHASE;
  void* args[] = {&p};
  hipError_t e = hipLaunchCooperativeKernel((void*)yoco_fwd, dim3(grid), dim3(512), args, LDS_BYTES, stream);
  if (e != hipSuccess) fprintf(stderr, "cooperative launch failed: %s (grid %d)\n", hipGetErrorString(e), grid);
}
```

```cpp
#include <hip/hip_runtime.h>
#include <hip/hip_cooperative_groups.h>
#include <cstdio>
#include <cstdint>
namespace cg = cooperative_groups;

#define LAS __attribute__((address_space(3)))
#define DI __device__ __forceinline__
typedef unsigned short bf16_t;
typedef short bf16x8 __attribute__((ext_vector_type(8)));
typedef short bf16x4 __attribute__((ext_vector_type(4)));
typedef float f32x2 __attribute__((ext_vector_type(2)));
typedef float f32x4 __attribute__((ext_vector_type(4)));
typedef float f32x16 __attribute__((ext_vector_type(16)));
typedef unsigned u32x2 __attribute__((ext_vector_type(2)));
typedef unsigned u32x4 __attribute__((ext_vector_type(4)));
typedef __bf16 bf16v2 __attribute__((ext_vector_type(2)));

constexpr int SEQ = 16384, DM = 1024, DINNER = 2048;
constexpr int A_IN = 5136, GLA_DK = 512, GLA_H = 4, GLA_DVH = 512;
constexpr int GC = 256, NCH = SEQ / GC;
constexpr int KV_OUT = 12288, B_IN = 8192;
constexpr float RMS_EPS = 1e-6f;
constexpr float LOG2E = 1.4426950408889634f;
constexpr size_t MiB = 1u << 20;
constexpr size_t WS_W1T = 0;
constexpr size_t WS_WOT = 22 * MiB;
constexpr size_t WS_LR = 14 * MiB;
constexpr size_t WS_DCH = 15 * MiB;
constexpr size_t WS_SSQ = 16 * MiB;
constexpr size_t WS_LSE = 17 * MiB;
constexpr size_t WS_WO2T = 18 * MiB;
constexpr size_t WS_CTL = 30 * MiB;
constexpr size_t WS_WC = 0;
constexpr size_t WS_H = 32 * MiB;
constexpr size_t WS_QKZ = 64 * MiB;
constexpr size_t WS_KT = 160 * MiB;
constexpr size_t WS_P = 176 * MiB;
constexpr size_t WS_QC = 64 * MiB, WS_VTC = 192 * MiB;

DI unsigned pk2(float lo, float hi) { f32x2 v = {lo, hi}; return __builtin_bit_cast(unsigned, __builtin_convertvector(v, bf16v2)); }
DI float bf_lo(unsigned w) { return __uint_as_float(w << 16); }
DI float bf_hi(unsigned w) { return __uint_as_float(w & 0xffff0000u); }
DI float bf2f(bf16_t b) { return __uint_as_float(((unsigned)b) << 16); }
DI bf16_t f2bf(float f) { return (bf16_t)(pk2(f, 0.f) & 0xffffu); }
#define MFMA32(a, b, c) __builtin_amdgcn_mfma_f32_32x32x16_bf16((a), (b), (c), 0, 0, 0)
DI int lane_id() { int l; asm volatile("v_mbcnt_lo_u32_b32 %0, -1, 0\n\tv_mbcnt_hi_u32_b32 %0, -1, %0" : "=v"(l)); return l; }
DI int crow(int reg, int h) { return (reg & 3) + 8 * (reg >> 2) + 4 * h; }
DI float wave_sum(float v) {
  v += __uint_as_float((unsigned)__builtin_amdgcn_mov_dpp((int)__float_as_uint(v), 0xB1, 0xF, 0xF, true));
  v += __uint_as_float((unsigned)__builtin_amdgcn_mov_dpp((int)__float_as_uint(v), 0x4E, 0xF, 0xF, true));
  v += __uint_as_float((unsigned)__builtin_amdgcn_mov_dpp((int)__float_as_uint(v), 0x141, 0xF, 0xF, true));
  v += __uint_as_float((unsigned)__builtin_amdgcn_mov_dpp((int)__float_as_uint(v), 0x140, 0xF, 0xF, true));
  { const unsigned u = __float_as_uint(v); const u32x2 r = __builtin_amdgcn_permlane16_swap(u, u, false, false); v = __uint_as_float(r[0]) + __uint_as_float(r[1]); }
  { const unsigned u = __float_as_uint(v); const u32x2 r = __builtin_amdgcn_permlane32_swap(u, u, false, false); v = __uint_as_float(r[0]) + __uint_as_float(r[1]); }
  return v;
}
#define LDS_WAIT() asm volatile("s_waitcnt lgkmcnt(0)" ::: "memory")
DI float xh_sum(float x) { const unsigned u = __float_as_uint(x); const u32x2 r = __builtin_amdgcn_permlane32_swap(u, u, false, false); return __uint_as_float(r[0]) + __uint_as_float(r[1]); }
DI float x16_sum(float x) { const unsigned u = __float_as_uint(x); const u32x2 r = __builtin_amdgcn_permlane16_swap(u, u, false, false); return __uint_as_float(r[0]) + __uint_as_float(r[1]); }
DI float xh_max(float x) { const unsigned u = __float_as_uint(x); const u32x2 r = __builtin_amdgcn_permlane32_swap(u, u, false, false); return fmaxf(__uint_as_float(r[0]), __uint_as_float(r[1])); }

namespace pg8 {
constexpr int BM = 256, BK = 64, HALF = 128, HTB = HALF * BK * 2, STAGE_BYTES = 8 * HTB, NXCD = 8, WGM = 8;
__host__ __device__ __forceinline__ int lds_byte(int r, int c) { const int st = (r >> 4) * 2 + (c >> 5), rr = r & 15, cc = c & 31, ob = rr * 64 + cc * 2; return st * 1024 + (ob ^ (((ob >> 9) & 1) << 5)); }
__host__ __device__ __forceinline__ void stage_rc(int b, int& R, int& C) { const int st = b / 1024, sb = b % 1024, swz = sb ^ (((sb >> 9) & 1) << 5); R = (st >> 1) * 16 + swz / 64; C = (st & 1) * 32 + (swz % 64) / 2; }
__host__ __device__ __forceinline__ int p16(int x) { return x < 4 ? x : (x < 8 ? x + 4 : (x < 12 ? x - 4 : x)); }
__host__ __device__ __forceinline__ int perm32(int rho) { const int n = rho >> 4, i = rho & 15; return 8 * (i >> 2) + 4 * n + (i & 3); }

struct Unit { int pm, pn, sub; const char* a; const char* b; int slot; };
struct Sub { const char* A; const char* Bt; int nM, nN, dil, tprsh; };
struct Order {
  Sub s0, s1; int nsub, G, c, K;
  DI bool next(int i, Unit& u) const {
    u.slot = i;
    long L = (long)i * G + c; const int n0 = s0.nM * s0.nN;
    int si = 0;
    if (L >= n0) { if (nsub < 2) return false; L -= n0; si = 1; if (L >= (long)s1.nM * s1.nN) return false; }
    const int nM = si ? s1.nM : s0.nM, nN = si ? s1.nN : s0.nN, dil = si ? s1.dil : s0.dil, tprsh = si ? s1.tprsh : s0.tprsh;
    const char* A = si ? s1.A : s0.A; const char* Bt = si ? s1.Bt : s0.Bt;
    const int nwg = nM * nN;
    int wgid = (int)L; { const int q = nwg / NXCD, r = nwg % NXCD, xcd = wgid % NXCD, off = wgid / NXCD; wgid = (xcd < r ? xcd * (q + 1) : r * (q + 1) + (xcd - r) * q) + off; }
    const int nig = WGM * nN, gid = wgid / nig, fm = gid * WGM, gsz = (nM - fm) < WGM ? (nM - fm) : WGM;
    u.pm = fm + ((wgid % nig) % gsz); u.pn = (wgid % nig) / gsz; u.sub = si;
    u.a = A + (size_t)u.pm * BM * K * 2;
    u.b = Bt + ((size_t)(u.pn >> tprsh) + (size_t)dil * BM * (u.pn & ((1 << tprsh) - 1))) * K * 2;
    return true;
  }
};

template <class Epi, bool ALIGN_EPI, bool SP2>
DI void gemm_phase(LAS unsigned char* lds, const Order& S, const Epi& E, int wave_s, int ldb_mult, int bperm16 = 0, int ldb_mult1 = 1, int bperm16_1 = 0) {
  int tid = wave_s * 64 + lane_id(); asm volatile("" : "+v"(tid));
  const int wid = __builtin_amdgcn_readfirstlane(tid >> 6), lane = tid & 63, wr = wid >> 2, wc = wid & 3, fr = lane & 15, fq = lane >> 4;
  const int K = S.K, nt = K / BK;
  unsigned voffA[2], voffB0[2], voffB1[2];
#pragma unroll
  for (int i = 0; i < 2; ++i) { int R, C; stage_rc(tid * 16 + i * 8192, R, C); const int Rp = (R & ~31) + perm32(R & 31); const int Rb0 = bperm16 ? ((Rp & ~15) | p16(Rp & 15)) : Rp, Rb1 = bperm16_1 ? ((Rp & ~15) | p16(Rp & 15)) : Rp;
    voffA[i] = (unsigned)(R * K + C) * 2u; voffB0[i] = (unsigned)(Rb0 * K * ldb_mult + C) * 2u; voffB1[i] = (unsigned)(Rb1 * K * ldb_mult1 + C) * 2u; }
  const size_t kstep = (size_t)(BK * 2);
  const size_t hstepA = (size_t)HALF * K * 2, hstepB0 = (size_t)HALF * K * 2 * ldb_mult, hstepB1 = (size_t)HALF * K * 2 * ldb_mult1;
  const unsigned ldsw = (unsigned)wid * 1024u;
  const int aoff = lds_byte(wr * 64 + fr, fq * 8), boff = lds_byte(wc * 32 + fr, fq * 8);
#define PG8_SA(b, h) (((b) * 2 + (h)) * HTB)
#define PG8_SB(b, h) ((4 + (b) * 2 + (h)) * HTB)
#define PG8_STAGE(bufoff, gbase, voff) do { _Pragma("unroll") for (int _i = 0; _i < 2; ++_i) \
        __builtin_amdgcn_global_load_lds((const unsigned*)((const char*)(gbase) + (voff)[_i]), (LAS unsigned*)(lds + (bufoff) + ldsw + _i * 8192), 16, 0, 0); } while (0)
#define PG8_LDA(dst, b, h) do { _Pragma("unroll") for (int m = 0; m < 4; ++m) _Pragma("unroll") for (int k = 0; k < 2; ++k) dst[m][k] = *(const LAS bf16x8*)(lds + PG8_SA(b, h) + aoff + m * 2048 + k * 1024); } while (0)
#define PG8_LDB(dst, b, h) do { _Pragma("unroll") for (int n = 0; n < 2; ++n) _Pragma("unroll") for (int k = 0; k < 2; ++k) dst[n][k] = *(const LAS bf16x8*)(lds + PG8_SB(b, h) + boff + n * 2048 + k * 1024); } while (0)
#define PG8_MMA(ai, bj, At, Bt) do { __builtin_amdgcn_s_setprio(1); _Pragma("unroll") for (int m = 0; m < 4; ++m) _Pragma("unroll") for (int n = 0; n < 2; ++n) _Pragma("unroll") for (int k = 0; k < 2; ++k) \
        acc[ai][bj][m][n] = __builtin_amdgcn_mfma_f32_16x16x32_bf16(Bt[n][k], At[m][k], acc[ai][bj][m][n], 0, 0, 0); __builtin_amdgcn_s_setprio(0); } while (0)
#define PG8_WAIT_V(n) asm volatile("s_waitcnt vmcnt(" #n ")" ::: "memory")
#define PG8_WAIT_L(n) asm volatile("s_waitcnt lgkmcnt(" #n ")" ::: "memory")
#define PG8_BAR __builtin_amdgcn_s_barrier()
#define PG8_SCHED __builtin_amdgcn_sched_barrier(0)
  Unit cur, nxt; int ui = 0;
  if (!S.next(0, cur)) return;
  f32x4 acc[2][2][4][2];
#pragma unroll
  for (int a = 0; a < 2; ++a)
#pragma unroll
    for (int b = 0; b < 2; ++b)
#pragma unroll
      for (int m = 0; m < 4; ++m)
#pragma unroll
        for (int n = 0; n < 2; ++n) acc[a][b][m][n] = (f32x4){0.f, 0.f, 0.f, 0.f};
  bf16x8 At[4][2], B0[2][2], B1[2][2];
  const char* cA = cur.a; const char* cB = cur.b;
  unsigned voffB[2] = {cur.sub ? voffB1[0] : voffB0[0], cur.sub ? voffB1[1] : voffB0[1]}; size_t hstepB = cur.sub ? hstepB1 : hstepB0;
  if constexpr (SP2) {
    PG8_STAGE(PG8_SB(0, 0), cB, voffB); PG8_STAGE(PG8_SB(0, 1), cB + hstepB, voffB); PG8_STAGE(PG8_SA(0, 0), cA, voffA); PG8_STAGE(PG8_SA(0, 1), cA + hstepA, voffA);
    if (wr == 1) PG8_BAR;
    PG8_WAIT_V(2); PG8_BAR;
    PG8_STAGE(PG8_SB(1, 0), cB + kstep, voffB); PG8_STAGE(PG8_SA(1, 0), cA + kstep, voffA); PG8_STAGE(PG8_SB(1, 1), cB + hstepB + kstep, voffB);
    PG8_WAIT_V(6); PG8_BAR;
  } else {
    PG8_STAGE(PG8_SB(0, 0), cB, voffB); PG8_STAGE(PG8_SA(0, 0), cA, voffA); PG8_STAGE(PG8_SB(0, 1), cB + hstepB, voffB); PG8_STAGE(PG8_SA(0, 1), cA + hstepA, voffA);
    if (wr == 1) PG8_BAR;
    PG8_WAIT_V(4); PG8_BAR;
    PG8_STAGE(PG8_SB(1, 0), cB + kstep, voffB); PG8_STAGE(PG8_SA(1, 0), cA + kstep, voffA); PG8_STAGE(PG8_SB(1, 1), cB + hstepB + kstep, voffB);
    PG8_WAIT_V(6); PG8_BAR;
  }
  for (;;) {
    const bool has_next = S.next(ui + 1, nxt);
    const char* nA = has_next ? nxt.a : cA; const char* nB = has_next ? nxt.b : cB;
    for (int t = 0; t < nt; t += 2) {
      const bool last = (t == nt - 2);
      if (last && has_next) { voffB[0] = nxt.sub ? voffB1[0] : voffB0[0]; voffB[1] = nxt.sub ? voffB1[1] : voffB0[1]; hstepB = nxt.sub ? hstepB1 : hstepB0; }
      const char* a1 = cA + (size_t)(t + 1) * kstep;
      const char* a2 = last ? nA : cA + (size_t)(t + 2) * kstep; const char* b2 = last ? nB : cB + (size_t)(t + 2) * kstep;
      const char* a3 = a2 + kstep; const char* b3 = b2 + kstep;
      if constexpr (SP2) {
        PG8_LDB(B0, 0, 0); PG8_LDB(B1, 0, 1); PG8_SCHED; PG8_LDA(At, 0, 0); PG8_STAGE(PG8_SA(1, 1), a1 + hstepA, voffA);
        PG8_WAIT_V(8); PG8_WAIT_L(0); PG8_BAR; PG8_MMA(0, 0, At, B0); PG8_MMA(0, 1, At, B1); PG8_BAR; PG8_SCHED;
        PG8_LDA(At, 0, 1); PG8_STAGE(PG8_SB(0, 0), b2, voffB); PG8_STAGE(PG8_SB(0, 1), b2 + hstepB, voffB); PG8_STAGE(PG8_SA(0, 0), a2, voffA);
        PG8_WAIT_V(8); PG8_WAIT_L(0); PG8_BAR; PG8_MMA(1, 0, At, B0); PG8_MMA(1, 1, At, B1); PG8_BAR; PG8_SCHED;
        PG8_LDB(B0, 1, 0); PG8_LDB(B1, 1, 1); PG8_SCHED; PG8_LDA(At, 1, 0); PG8_STAGE(PG8_SA(0, 1), a2 + hstepA, voffA);
        PG8_WAIT_V(8); PG8_WAIT_L(0); PG8_BAR; PG8_MMA(0, 0, At, B0); PG8_MMA(0, 1, At, B1); PG8_BAR; PG8_SCHED;
        PG8_LDA(At, 1, 1); PG8_STAGE(PG8_SB(1, 0), b3, voffB); PG8_STAGE(PG8_SB(1, 1), b3 + hstepB, voffB); PG8_STAGE(PG8_SA(1, 0), a3, voffA);
        PG8_WAIT_V(8); PG8_WAIT_L(0); PG8_BAR; PG8_MMA(1, 0, At, B0); PG8_MMA(1, 1, At, B1); PG8_BAR; PG8_SCHED;
      } else {
        PG8_LDB(B0, 0, 0); PG8_SCHED; PG8_LDA(At, 0, 0); PG8_STAGE(PG8_SA(1, 1), a1 + hstepA, voffA);
        PG8_WAIT_L(8); PG8_BAR; PG8_WAIT_L(0); PG8_MMA(0, 0, At, B0); PG8_BAR; PG8_SCHED;
        PG8_LDB(B1, 0, 1); PG8_STAGE(PG8_SB(0, 0), b2, voffB);
        PG8_BAR; PG8_WAIT_L(0); PG8_MMA(0, 1, At, B1); PG8_BAR;
        PG8_LDA(At, 0, 1); PG8_STAGE(PG8_SA(0, 0), a2, voffA);
        PG8_BAR; PG8_WAIT_L(0); PG8_MMA(1, 0, At, B0); PG8_BAR; PG8_SCHED;
        PG8_STAGE(PG8_SB(0, 1), b2 + hstepB, voffB);
        PG8_WAIT_V(6); PG8_BAR; PG8_MMA(1, 1, At, B1); PG8_BAR;
        PG8_LDB(B0, 1, 0); PG8_SCHED; PG8_LDA(At, 1, 0); PG8_STAGE(PG8_SA(0, 1), a2 + hstepA, voffA);
        PG8_WAIT_L(8); PG8_BAR; PG8_WAIT_L(0); PG8_MMA(0, 0, At, B0); PG8_BAR; PG8_SCHED;
        PG8_LDB(B1, 1, 1); PG8_STAGE(PG8_SB(1, 0), b3, voffB);
        PG8_BAR; PG8_WAIT_L(0); PG8_MMA(0, 1, At, B1); PG8_BAR;
        PG8_LDA(At, 1, 1); PG8_STAGE(PG8_SA(1, 0), a3, voffA);
        PG8_BAR; PG8_WAIT_L(0); PG8_MMA(1, 0, At, B0); PG8_BAR; PG8_SCHED;
        PG8_STAGE(PG8_SB(1, 1), b3 + hstepB, voffB);
        PG8_WAIT_V(6); PG8_BAR; PG8_MMA(1, 1, At, B1); PG8_BAR;
      }
    }
    if constexpr (ALIGN_EPI) { if (wr == 0) PG8_BAR; }
    if constexpr (!Epi::AFTER_DRAIN) { E(acc, cur, wr, wc, fr, fq); }
    if (!has_next) break;
#pragma unroll
    for (int a = 0; a < 2; ++a)
#pragma unroll
      for (int b = 0; b < 2; ++b)
#pragma unroll
        for (int m = 0; m < 4; ++m)
#pragma unroll
          for (int n = 0; n < 2; ++n) acc[a][b][m][n] = (f32x4){0.f, 0.f, 0.f, 0.f};
    cur = nxt; cA = nA; cB = nB; ++ui;
    if constexpr (ALIGN_EPI) { if (wr == 1) PG8_BAR; }
  }
  PG8_WAIT_V(0);
  if constexpr (!ALIGN_EPI) { if (wr == 0) PG8_BAR; }
  PG8_BAR;
  if constexpr (Epi::AFTER_DRAIN) { E.fused(acc, cur, wr, wc, fr, fq, lds, wid, lane); }
#undef PG8_SA
#undef PG8_SB
#undef PG8_STAGE
#undef PG8_LDA
#undef PG8_LDB
#undef PG8_MMA
#undef PG8_WAIT_V
#undef PG8_WAIT_L
#undef PG8_BAR
#undef PG8_SCHED
}

struct EpiBf16Two {
  static constexpr bool AFTER_DRAIN = false;
  bf16_t* O0; int ldc0; bf16_t* O1; int ldc1;
  DI void operator()(const f32x4 (&acc)[2][2][4][2], const Unit& u, int wr, int wc, int fr_, int fq_) const {
    (void)fr_; (void)fq_; const int l_ = lane_id(); const int fr = l_ & 15, fq = l_ >> 4;
    const int row0 = u.pm * BM + wr * 64 + fr, col0 = u.pn * BM + wc * 32 + 8 * fq;
#pragma unroll
    for (int ai = 0; ai < 2; ++ai)
#pragma unroll
      for (int m = 0; m < 4; ++m) { const int row = row0 + ai * HALF + m * 16;
#pragma unroll
        for (int bj = 0; bj < 2; ++bj) { const f32x4 v0 = acc[ai][bj][m][0], v1 = acc[ai][bj][m][1]; const int col = col0 + bj * HALF;
          u32x4 w; w.x = pk2(v0[0], v0[1]); w.y = pk2(v0[2], v0[3]); w.z = pk2(v1[0], v1[1]); w.w = pk2(v1[2], v1[3]);
          bf16_t* dst = u.sub ? O1 + ((size_t)(col >> 5) * ldc1 + row) * 32 + (col & 31)
                              : O0 + (size_t)row * ldc0 + col;
          *(u32x4*)dst = w; } }
  }
};
struct EpiRowScale3 {
  static constexpr bool AFTER_DRAIN = false;
  bf16_t* O0; const float* ssq; int cw, tpbsh; size_t bstride; int dsh; const LAS float* rtab;
  DI void operator()(const f32x4 (&acc)[2][2][4][2], const Unit& u, int wr, int wc, int fr_, int fq_) const {
    (void)fr_; (void)fq_; const int l_ = lane_id(); const int fr = l_ & 15, fq = l_ >> 4;
    const int t = u.pn >> tpbsh; bf16_t* base = O0 + (size_t)t * bstride;
    const int row0 = u.pm * BM + wr * 64 + fr, col0 = (u.pn & ((1 << tpbsh) - 1)) * BM + wc * 32 + 8 * fq;
#pragma unroll
    for (int ai = 0; ai < 2; ++ai)
#pragma unroll
      for (int m = 0; m < 4; ++m) { const int row = row0 + ai * HALF + m * 16;
        float rs;
        if (rtab) rs = rtab[u.slot * 256 + wr * 64 + fr + ai * HALF + m * 16];
        else { const f32x4 sq = *(const f32x4*)(ssq + (size_t)row * 4); rs = rsqrtf(((sq[0] + sq[1]) + (sq[2] + sq[3])) * (1.0f / DM) + RMS_EPS); }
        const int tp = ((row & ((1 << dsh) - 1)) << (14 - dsh)) + (row >> dsh);
        bf16_t* rowp = (t < 2) ? base + ((((size_t)(col0 >> 7)) << 14) + tp) * 128 + (col0 & 127) : base + (size_t)row * cw + col0;
        const size_t bjstep = (t < 2) ? ((size_t)128 << 14) : (size_t)HALF;
#pragma unroll
        for (int bj = 0; bj < 2; ++bj) { const f32x4 v0 = acc[ai][bj][m][0] * rs, v1 = acc[ai][bj][m][1] * rs;
          u32x4 w; w.x = pk2(v0[0], v0[1]); w.y = pk2(v0[2], v0[3]); w.z = pk2(v1[0], v1[1]); w.w = pk2(v1[2], v1[3]);
          *(u32x4*)(rowp + bj * bjstep) = w; } }
  }
};
struct EpiColScale {
  static constexpr bool AFTER_DRAIN = false;
  bf16_t* O; const float* ssq; int dil, tprsh, cw; const LAS float* rtab;
  DI void operator()(const f32x4 (&acc)[2][2][4][2], const Unit& u, int wr, int wc, int fr_, int fq_) const {
    (void)fr_; (void)fq_; const int l_ = lane_id(); const int fr = l_ & 15, fq = l_ >> 4;
    const int row0 = u.pm * BM + wr * 64 + fr, col0 = u.pn * BM + wc * 32 + 8 * fq;
    const int r = u.pn >> tprsh, j0 = (u.pn & ((1 << tprsh) - 1)) * BM + wc * 32 + 8 * fq;
#pragma unroll
    for (int bj = 0; bj < 2; ++bj) {
      float rs[8];
      if (rtab) { const LAS f32x4* tp4 = (const LAS f32x4*)(rtab + u.slot * 256 + wc * 32 + 8 * fq + bj * HALF); const f32x4 t0 = tp4[0], t1 = tp4[1];
        rs[0] = t0[0]; rs[1] = t0[1]; rs[2] = t0[2]; rs[3] = t0[3]; rs[4] = t1[0]; rs[5] = t1[1]; rs[6] = t1[2]; rs[7] = t1[3]; }
      else {
#pragma unroll
        for (int e = 0; e < 8; ++e) { const int cc = j0 + bj * HALF + e; const int tok = r + dil * ((cc & ~15) | p16(cc & 15)); const f32x4 sq = *(const f32x4*)(ssq + (size_t)tok * 4);
          rs[e] = rsqrtf(((sq[0] + sq[1]) + (sq[2] + sq[3])) * (1.0f / DM) + RMS_EPS); } }
#pragma unroll
      for (int ai = 0; ai < 2; ++ai)
#pragma unroll
        for (int m = 0; m < 4; ++m) { bf16_t* dst = O + ((size_t)((col0 + bj * HALF) >> 5) * cw + row0 + ai * HALF + m * 16) * 32 + ((col0 + bj * HALF) & 31);
          const f32x4 v0 = acc[ai][bj][m][0], v1 = acc[ai][bj][m][1];
          u32x4 w; w.x = pk2(v0[0] * rs[0], v0[1] * rs[1]); w.y = pk2(v0[2] * rs[2], v0[3] * rs[3]);
          w.z = pk2(v1[0] * rs[4], v1[1] * rs[5]); w.w = pk2(v1[2] * rs[6], v1[3] * rs[7]);
          *(u32x4*)dst = w; }
      __builtin_amdgcn_sched_barrier(0);
    }
  }
};
struct EpiChunk {
  static constexpr bool AFTER_DRAIN = false;
  EpiRowScale3 e0; EpiColScale e1;
  DI void operator()(const f32x4 (&acc)[2][2][4][2], const Unit& u, int wr, int wc, int fr, int fq) const { if (u.sub) e1(acc, u, wr, wc, fr, fq); else e0(acc, u, wr, wc, fr, fq); }
};
template <bool BASE_BF16> struct EpiResidual {
  static constexpr bool AFTER_DRAIN = true;
  const void* base; bf16_t* outb; float* ssq;
  DI void operator()(const f32x4 (&)[2][2][4][2], const Unit&, int, int, int, int) const {}
  DI void fused(f32x4 (&acc)[2][2][4][2], const Unit& u, int wr, int wc, int fr_, int fq_, LAS unsigned char* lds, int wid, int lane_) const {
    (void)fr_; (void)fq_; (void)lane_;
    const int l = lane_id(), fr = l & 15, fq = l >> 4;
#pragma unroll
    for (int ps = 0; ps < 4; ++ps) {
      const int ai = ps >> 1, mh = ps & 1;
#pragma unroll
      for (int m1 = 0; m1 < 2; ++m1) { const int lr = wr * 32 + m1 * 16 + fr;
#pragma unroll
        for (int bj = 0; bj < 2; ++bj)
#pragma unroll
          for (int n = 0; n < 2; ++n) *(LAS f32x4*)(lds + lr * 1040 + (128 * bj + 32 * wc + 8 * fq + 4 * n) * 4) = acc[ai][bj][2 * mh + m1][n]; }
      __syncthreads();
      f32x4 xv[8];
#pragma unroll
      for (int i = 0; i < 8; ++i) { const int lr = 8 * wid + i; const int row = 128 * ai + 64 * (lr >> 5) + 16 * (2 * mh + ((lr >> 4) & 1)) + (lr & 15);
        const size_t off = (size_t)(u.pm * BM + row) * DM + u.pn * BM + 4 * l;
        if constexpr (BASE_BF16) { const u32x2 b2 = *(const u32x2*)((const bf16_t*)base + off); xv[i] = (f32x4){bf_lo(b2.x), bf_hi(b2.x), bf_lo(b2.y), bf_hi(b2.y)}; }
        else xv[i] = *(const f32x4*)((const float*)base + off); }
#pragma unroll
      for (int i = 0; i < 8; ++i) { const int lr = 8 * wid + i; const int row = 128 * ai + 64 * (lr >> 5) + 16 * (2 * mh + ((lr >> 4) & 1)) + (lr & 15);
        const size_t off = (size_t)(u.pm * BM + row) * DM + u.pn * BM + 4 * l;
        const f32x4 a = *(const LAS f32x4*)(lds + lr * 1040 + l * 16);
        const f32x4 v = a + xv[i];
        { u32x2 w; w.x = pk2(v[0], v[1]); w.y = pk2(v[2], v[3]); *(u32x2*)(outb + off) = w; }
        const float sq = wave_sum((v[0] * v[0] + v[1] * v[1]) + (v[2] * v[2] + v[3] * v[3]));
        if (l == 0) ssq[(size_t)(u.pm * BM + row) * 4 + u.pn] = sq; }
      __syncthreads();
    }
  }
};
struct EpiFinal {
  static constexpr bool AFTER_DRAIN = true;
  const bf16_t* base; float* out; const float* gain; float* ssq; unsigned* cnt;
  DI void operator()(const f32x4 (&)[2][2][4][2], const Unit&, int, int, int, int) const {}
  template <int SWEEP> DI void sweep(f32x4 (&acc)[2][2][4][2], const Unit& u, int wr, int wc, LAS unsigned char* lds, int wid, int l, const f32x4& g4) const {
    const int fr = l & 15, fq = l >> 4;
#pragma unroll
    for (int ps = 0; ps < 4; ++ps) {
      const int ai = ps >> 1, mh = ps & 1;
#pragma unroll
      for (int m1 = 0; m1 < 2; ++m1) { const int lr = wr * 32 + m1 * 16 + fr;
#pragma unroll
        for (int bj = 0; bj < 2; ++bj)
#pragma unroll
          for (int n = 0; n < 2; ++n) *(LAS f32x4*)(lds + lr * 1040 + (128 * bj + 32 * wc + 8 * fq + 4 * n) * 4) = acc[ai][bj][2 * mh + m1][n]; }
      __syncthreads();
      u32x2 xv[8]; f32x4 sqv[8];
#pragma unroll
      for (int i = 0; i < 8; ++i) { const int lr = 8 * wid + i; const int row = 128 * ai + 64 * (lr >> 5) + 16 * (2 * mh + ((lr >> 4) & 1)) + (lr & 15);
        if (SWEEP == 0) xv[i] = *(const u32x2*)(base + (size_t)(u.pm * BM + row) * DM + u.pn * BM + 4 * l); else xv[i] = (u32x2){0u, 0u};
        if (SWEEP == 1) sqv[i] = *(const f32x4*)(ssq + (size_t)(u.pm * BM + row) * 4); else sqv[i] = (f32x4){0.f, 0.f, 0.f, 0.f}; }
#pragma unroll
      for (int i = 0; i < 8; ++i) { const int lr = 8 * wid + i; const int row = 128 * ai + 64 * (lr >> 5) + 16 * (2 * mh + ((lr >> 4) & 1)) + (lr & 15);
        const f32x4 a = *(const LAS f32x4*)(lds + lr * 1040 + l * 16);
        const f32x4 v = (SWEEP == 0) ? a + (f32x4){bf_lo(xv[i].x), bf_hi(xv[i].x), bf_lo(xv[i].y), bf_hi(xv[i].y)} : a;
        if (SWEEP == 0) {
          float sq = (v[0] * v[0] + v[1] * v[1]) + (v[2] * v[2] + v[3] * v[3]);
#pragma unroll
          for (int o = 1; o < 64; o <<= 1) sq += __uint_as_float((unsigned)__builtin_amdgcn_ds_bpermute((l ^ o) << 2, (int)__float_as_uint(sq)));
          if (l == 0) ssq[(size_t)(u.pm * BM + row) * 4 + u.pn] = sq;
        } else {
          const float rstd = rsqrtf(((sqv[i][0] + sqv[i][1]) + (sqv[i][2] + sqv[i][3])) * (1.0f / DM) + RMS_EPS);
          *(f32x4*)(out + (size_t)(u.pm * BM + row) * DM + u.pn * BM + 4 * l) = v * rstd * g4; } }
      __syncthreads();
    }
  }
  DI void direct0(f32x4 (&acc)[2][2][4][2], const Unit& u, int wr, int wc, LAS unsigned char* lds, int wid, int l) const {
    const int fr = l & 15, fq = l >> 4;
    LAS float* red = (LAS float*)lds;
#pragma unroll
    for (int ai = 0; ai < 2; ++ai) {
      u32x4 bv[4][2];
#pragma unroll
      for (int m = 0; m < 4; ++m) { const int row = 128 * ai + 64 * wr + 16 * m + fr; const bf16_t* bp = base + (size_t)(u.pm * BM + row) * DM + u.pn * BM + 32 * wc + 8 * fq;
        bv[m][0] = *(const u32x4*)bp; bv[m][1] = *(const u32x4*)(bp + HALF); }
      __builtin_amdgcn_sched_barrier(0);
#pragma unroll
      for (int m = 0; m < 4; ++m) { const int row = 128 * ai + 64 * wr + 16 * m + fr; float sq = 0.f;
#pragma unroll
        for (int bj = 0; bj < 2; ++bj) { const u32x4 b = bv[m][bj];
          acc[ai][bj][m][0] += (f32x4){bf_lo(b.x), bf_hi(b.x), bf_lo(b.y), bf_hi(b.y)}; acc[ai][bj][m][1] += (f32x4){bf_lo(b.z), bf_hi(b.z), bf_lo(b.w), bf_hi(b.w)};
#pragma unroll
          for (int n = 0; n < 2; ++n) { const f32x4 v = acc[ai][bj][m][n]; sq += (v[0] * v[0] + v[1] * v[1]) + (v[2] * v[2] + v[3] * v[3]); } }
        sq += __uint_as_float((unsigned)__builtin_amdgcn_ds_bpermute((l ^ 16) << 2, (int)__float_as_uint(sq)));
        sq += __uint_as_float((unsigned)__builtin_amdgcn_ds_bpermute((l ^ 32) << 2, (int)__float_as_uint(sq)));
        if (fq == 0) red[row * 4 + wc] = sq; }
    }
    __syncthreads();
    const int t = wid * 64 + l;
    if (t < 256) { const f32x4 r4 = *(const LAS f32x4*)(red + t * 4); ssq[(size_t)(u.pm * BM + t) * 4 + u.pn] = (r4[0] + r4[1]) + (r4[2] + r4[3]); }
  }
  DI void fused(f32x4 (&acc)[2][2][4][2], const Unit& u, int wr, int wc, int, int, LAS unsigned char* lds, int wid, int) const {
    const int l = lane_id();
    const f32x4 g4 = *(const f32x4*)(gain + u.pn * BM + 4 * l);
    direct0(acc, u, wr, wc, lds, wid, l);
    asm volatile("s_waitcnt vmcnt(0)" ::: "memory");
    __syncthreads();
    if (wid == 0 && l == 0) {
      __builtin_amdgcn_fence(__ATOMIC_RELEASE, "agent"); asm volatile("s_waitcnt vmcnt(0)" ::: "memory");
      (void)__hip_atomic_fetch_add(cnt + 64 * u.pm, 1u, __ATOMIC_RELAXED, __HIP_MEMORY_SCOPE_AGENT);
      unsigned sp = 0;
      while (__hip_atomic_load(cnt + 64 * u.pm, __ATOMIC_RELAXED, __HIP_MEMORY_SCOPE_AGENT) < 4u) { __builtin_amdgcn_s_sleep(2); if (++sp > (1u << 22)) break; }
      __builtin_amdgcn_fence(__ATOMIC_ACQUIRE, "agent"); asm volatile("s_waitcnt vmcnt(0)" ::: "memory");
    }
    __syncthreads();
    sweep<1>(acc, u, wr, wc, lds, wid, l, g4);
  }
};
}


#define XB_TMO      128
#define XB_XCNT(j)  (256  + 64 * (j))
#define XB_XSUB(j)  (1280 + 64 * (j))
#define XB_XGEN(j)  (2304 + 64 * (j))
#define XB_TOP      3328
#define XB_TOPGEN   3392
#define XCD_BAR_WORDS 3456
#define XB_SPIN_CAP (1u << 18)
DI unsigned xb_ld(unsigned* p)              { return __hip_atomic_load(p, __ATOMIC_RELAXED, __HIP_MEMORY_SCOPE_AGENT); }
DI unsigned xb_add(unsigned* p, unsigned v) { return __hip_atomic_fetch_add(p, v, __ATOMIC_RELAXED, __HIP_MEMORY_SCOPE_AGENT); }
DI unsigned xb_xcc_id() { return (unsigned)__builtin_amdgcn_s_getreg((3 << 11) | 20) & 0xFu; }
#define XB_SPIN(cond, bar) do { unsigned _sp = 0; while (cond) { __builtin_amdgcn_s_sleep(1); \
    if ((++_sp & 255u) == 0u) { if (xb_ld(&(bar)[XB_TMO])) break; if (_sp > XB_SPIN_CAP) { atomicAdd(&(bar)[XB_TMO], 1u); break; } } } } while (0)
struct XcdBarrier { unsigned* bar; unsigned x; volatile LAS unsigned* st; };
DI XcdBarrier xcd_barrier_post(unsigned* bar, volatile LAS unsigned* st) {
  XcdBarrier b; b.bar = bar; b.x = xb_xcc_id(); b.st = st;
  if (threadIdx.x == 0) (void)xb_add(&bar[XB_XCNT(b.x)], 1u);
  return b;
}
DI void xcd_barrier_complete(unsigned* bar, unsigned x, unsigned& nloc, unsigned& nx) {
  const unsigned G = gridDim.x * gridDim.y * gridDim.z;
  unsigned sum, cnt, mine, sp = 0u;
  for (;;) {
    sum = 0u; cnt = 0u; mine = 0u;
#pragma unroll
    for (unsigned j = 0; j < 16; ++j) { const unsigned c = xb_ld(&bar[XB_XCNT(j)]); sum += c; cnt += (c > 0u) ? 1u : 0u; mine = (j == x) ? c : mine; }
    if (sum == G) break;
    __builtin_amdgcn_s_sleep(1);
    if ((++sp & 255u) == 0u) { if (xb_ld(&bar[XB_TMO])) break; if (sp > XB_SPIN_CAP) { atomicAdd(&bar[XB_TMO], 1u); break; } }
  }
  nloc = mine > 0u ? mine : 1u; nx = cnt > 0u ? cnt : 1u;
}
DI void xcd_barrier(const XcdBarrier& b, bool is_t0) {
  asm volatile("s_waitcnt vmcnt(0)" ::: "memory");
  __syncthreads();
  if (is_t0) {
    unsigned* bar = b.bar;
    __builtin_amdgcn_s_waitcnt(0);
    unsigned nloc = b.st[0], nx = b.st[1];
    if (nloc == 0u) { xcd_barrier_complete(bar, b.x, nloc, nx); b.st[0] = nloc; b.st[1] = nx; }
    const unsigned old = xb_add(&bar[XB_XSUB(b.x)], 1u);
    const unsigned gen = old / nloc;
    if (old + 1u == (gen + 1u) * nloc) {
      __builtin_amdgcn_fence(__ATOMIC_RELEASE, "agent");
      asm volatile("s_waitcnt vmcnt(0)" ::: "memory");
      const unsigned og = xb_add(&bar[XB_TOP], 1u);
      const unsigned tg = og / nx;
      if (og + 1u == (tg + 1u) * nx) xb_add(&bar[XB_TOPGEN], 1u);
      else XB_SPIN(xb_ld(&bar[XB_TOPGEN]) == tg, bar);
      __builtin_amdgcn_fence(__ATOMIC_ACQUIRE, "agent");
      xb_add(&bar[XB_XGEN(b.x)], 1u);
      asm volatile("s_waitcnt vmcnt(0)" ::: "memory");
    } else {
      XB_SPIN(xb_ld(&bar[XB_XGEN(b.x)]) == gen, bar);
      __builtin_amdgcn_fence(__ATOMIC_ACQUIRE, "agent");
      asm volatile("s_waitcnt vmcnt(0)" ::: "memory");
    }
  }
  __syncthreads();
}

struct Params { const float* in[13]; float* out; unsigned char* ws; int ph_lo, ph_hi; };
enum { I_X = 0, I_ANORM, I_AWIN, I_AWGU, I_ABG, I_AGOUT, I_AWOUT, I_KVNORM, I_WKV, I_BNORM, I_BWIN, I_BWOUT, I_FNORM };
constexpr int NPHASE = 16;
constexpr int LDS_BYTES = 147456;

DI void transpose_item(const float* W, int ldw, int c0, const float* gk, float sc, bf16_t* WT, int K, int r0, LAS float* scr, int kb, int nb, int lane) {
  const int k0 = 64 * kb, n0 = 32 * nb;
  float wv[32];
  { const float* wp = W + (size_t)(k0 + (lane >> 5)) * ldw + c0 + n0 + (lane & 31);
#pragma unroll
    for (int i = 0; i < 32; ++i) wv[i] = wp[(size_t)(2 * i) * ldw]; }
#pragma unroll
  for (int i = 0; i < 32; ++i) { const int kk = 2 * i + (lane >> 5); const float g = gk ? gk[k0 + kk] * sc : sc; scr[kk * 33 + (lane & 31)] = wv[i] * g; }
  LDS_WAIT(); asm volatile("" ::: "memory");
  const int c = lane & 7;
#pragma unroll
  for (int j = 0; j < 4; ++j) { const int n = (lane >> 3) + 8 * j; const LAS float* s = scr + (8 * c) * 33 + n;
    u32x4 o; o.x = pk2(s[0 * 33], s[1 * 33]); o.y = pk2(s[2 * 33], s[3 * 33]); o.z = pk2(s[4 * 33], s[5 * 33]); o.w = pk2(s[6 * 33], s[7 * 33]);
    *(u32x4*)(WT + (size_t)(r0 + n0 + n) * K + k0 + 8 * c) = o; }
  LDS_WAIT(); asm volatile("" ::: "memory");
}
DI void convert_chunk_weights(const float* bwin, const float* wkv, const float* bnorm, const float* kvnorm, bf16_t* WC, int g, int hbase, int cw, LAS float* scr, int gw, int NGW, int lane) {
  const float qscale = 0.08838834764831845f * LOG2E;
  const int nseg = (g == 2) ? 4 : 3, nbs = cw >> 5, ips = 16 * nbs;
  for (int it = gw; it < nseg * ips; it += NGW) {
    const int seg = it / ips, r = it - seg * ips, kb = r / nbs, nb = r - kb * nbs;
    const int c0 = g * 2048 + hbase * 128;
    if (seg == 0) transpose_item(bwin, B_IN, c0, bnorm, qscale, WC, DM, 0, scr, kb, nb, lane);
    else if (seg == 1) transpose_item(wkv, KV_OUT, c0, kvnorm, 1.f, WC, DM, cw, scr, kb, nb, lane);
    else if (seg == nseg - 1) transpose_item(wkv, KV_OUT, 6144 + c0, kvnorm, 1.f, WC, DM, (nseg - 1) * cw, scr, kb, nb, lane);
    else transpose_item(bwin, B_IN, 6144 + hbase * 128, bnorm, 1.f, WC, DM, 2 * cw, scr, kb, nb, lane);
  }
}

#define CAS __attribute__((address_space(4)))
#if defined(__HIP_DEVICE_COMPILE__)
DI const CAS Params& fresh_params() { const CAS Params* q = (const CAS Params*)__builtin_amdgcn_kernarg_segment_ptr(); asm volatile("" : "+s"(q)); return *q; }
#else
DI const Params& fresh_params() { return *(const Params*)nullptr; }
#endif
__global__ void __launch_bounds__(512, 2) yoco_fwd(Params p_unused) {
  extern __shared__ __attribute__((aligned(16))) unsigned char lds_raw[];
  LAS unsigned char* lds = (LAS unsigned char*)lds_raw;
  cg::grid_group grid = cg::this_grid();
  const int G = gridDim.x, bx = blockIdx.x, NGW = G * 8;
  const int att_ipc = __builtin_amdgcn_readfirstlane((512 + (int)gridDim.x - 1) / (int)gridDim.x);
  const int wave_s = __builtin_amdgcn_readfirstlane(threadIdx.x >> 6);
#define FRESH_IDS int tid = wave_s * 64 + lane_id(); asm volatile("" : "+v"(tid)); const int lane = tid & 63, wave = wave_s, gw = bx * 8 + wave; (void)lane; (void)gw;
  const int lo = fresh_params().ph_lo, hi = fresh_params().ph_hi;
  volatile LAS unsigned* bst = (volatile LAS unsigned*)(lds + LDS_BYTES - 64);
  if (threadIdx.x < 2) bst[threadIdx.x] = 0u;
  __syncthreads();
  const XcdBarrier xbar = xcd_barrier_post((unsigned*)(fresh_params().ws + WS_CTL), bst);
#ifndef PHASE_MASK
#define PHASE_MASK 0xffffffffu
#endif
#define PH_EN(k) (((PHASE_MASK) >> ((k) > 8 && (k) < 15 ? 7 + (((k) - 7) & 1) : ((k) >= 15 ? (k) - 6 : (k)))) & 1u)
#define IN(k) (PH_EN(k) && lo <= (k) && (k) < hi)
#ifndef PROBE_REGION
#define PROBE_REGION 0
#endif
#if PROBE_REGION
#define RGN_BEGIN(id) unsigned long long rgn_t0_##id = 0; if (PROBE_REGION == (id)) { __syncthreads(); rgn_t0_##id = __builtin_amdgcn_s_memrealtime(); }
#define RGN_END(id) if (PROBE_REGION == (id)) { __syncthreads(); if (threadIdx.x == 0) { const unsigned long long n_ = __builtin_amdgcn_s_memrealtime(); const unsigned long long e_ = n_ + 2 * (n_ - rgn_t0_##id); while (__builtin_amdgcn_s_memrealtime() < e_) __builtin_amdgcn_s_sleep(8); } __syncthreads(); }
#else
#define RGN_BEGIN(id)
#define RGN_END(id)
#endif
#define GSYNC(k) do { if (lo < 0) grid.sync(); xcd_barrier(xbar, wave_s == 0 && lane_id() == 0); } while (0)
#ifndef PROBE_CLASS
#define PROBE_CLASS 0
#endif
#define PROBE_MULT 2
#define PH_CLASS(k) ((k) == 0 ? 1 : (k) == 1 ? 2 : (k) <= 5 ? 3 : (k) == 6 ? 4 : (k) >= 15 ? 7 : (((k) - 7) & 1) ? 6 : 5)
#if PROBE_CLASS
  unsigned long long t_prev = __builtin_amdgcn_s_memrealtime();
#define SEAM(k) do { if (IN(k) && IN((k) + 1)) { GSYNC(k); { if (threadIdx.x == 0) { unsigned long long t_now = __builtin_amdgcn_s_memrealtime(); \
      if (PH_CLASS(k) == PROBE_CLASS) { const unsigned long long t_end = t_now + PROBE_MULT * (t_now - t_prev); while (__builtin_amdgcn_s_memrealtime() < t_end) __builtin_amdgcn_s_sleep(8); t_now = __builtin_amdgcn_s_memrealtime(); } \
      t_prev = t_now; } __syncthreads(); } } } while (0)
#else
#define SEAM(k) do { if (IN(k) && IN((k) + 1)) GSYNC(k); } while (0)
#endif

  if (IN(0)) {
    const auto& p = fresh_params(); unsigned char* ws = p.ws; FRESH_IDS
    LAS unsigned char* wl = lds;
    LAS unsigned char* hb = lds + 33280 + wave * 8256;
    LAS float* scr = (LAS float*)(lds + 33280 + wave * 8448);
    const float* awin = p.in[I_AWIN];
    for (int k = tid; k < DM; k += 512) {
      const f32x4* src = (const f32x4*)(awin + (size_t)k * A_IN + 5120);
#pragma unroll
      for (int q = 0; q < 4; ++q) { const f32x4 v = src[q];
#pragma unroll
        for (int e = 0; e < 4; ++e) *(LAS bf16_t*)(wl + (4 * q + e) * 2064 + k * 2) = f2bf(v[e]); }
    }
    bf16_t* W1T = (bf16_t*)(ws + WS_W1T); bf16_t* WOT = (bf16_t*)(ws + WS_WOT); bf16_t* WO2T = (bf16_t*)(ws + WS_WO2T);
    (void)WOT; (void)WO2T;
    for (int it = gw; it < 2560; it += NGW) {
      { const int kb = it / 160, nbb = it % 160; int c0, r0, nb;
        if (nbb < 16) { c0 = 0; r0 = 0; nb = nbb; } else if (nbb < 32) { c0 = 512; r0 = 512; nb = nbb - 16; } else if (nbb < 96) { c0 = 3072; r0 = 1024; nb = nbb - 32; } else { c0 = 1024; r0 = 3072; nb = nbb - 96; }
        transpose_item(awin, A_IN, c0, nullptr, 1.f, W1T, DM, r0, scr, kb, nb, lane); }
    }
    __syncthreads();
    const float* x = p.in[I_X]; const float* gA = p.in[I_ANORM];
    bf16_t* H = (bf16_t*)(ws + WS_H); float* LR = (float*)(ws + WS_LR);
    f32x4 gv[4];
#pragma unroll
    for (int j = 0; j < 4; ++j) gv[j] = *(const f32x4*)(gA + 4 * lane + 256 * j);
    const int lid = lane_id();
    for (int m0 = gw; m0 < SEQ; m0 += 4 * NGW) {
      f32x4 xv[4][4];
#pragma unroll
      for (int i = 0; i < 4; ++i) { const int m = m0 + i * NGW; const f32x4* xr = (const f32x4*)(x + (size_t)(m < SEQ ? m : gw) * DM) + lane;
#pragma unroll
        for (int j = 0; j < 4; ++j) xv[i][j] = xr[64 * j]; }
#pragma unroll
      for (int i = 0; i < 4; ++i) { const int m = m0 + i * NGW;
        if (m < SEQ) {
          f32x4 v[4]; float s2 = 0.f;
#pragma unroll
          for (int j = 0; j < 4; ++j) { v[j] = xv[i][j]; s2 += (v[j][0] * v[j][0] + v[j][1] * v[j][1]) + (v[j][2] * v[j][2] + v[j][3] * v[j][3]); }
          const float rstd = rsqrtf(wave_sum(s2) * (1.f / DM) + RMS_EPS);
#pragma unroll
          for (int j = 0; j < 4; ++j) v[j] = v[j] * rstd * gv[j];
          u32x2* o8 = (u32x2*)(H + (size_t)m * DM) + lane;
#pragma unroll
          for (int j = 0; j < 4; ++j) { u32x2 w; w.x = pk2(v[j][0], v[j][1]); w.y = pk2(v[j][2], v[j][3]); o8[64 * j] = w; }
#pragma unroll
          for (int j = 0; j < 4; ++j) { u32x2 w; w.x = pk2(v[j][0], v[j][1]); w.y = pk2(v[j][2], v[j][3]); *(LAS u32x2*)(hb + i * 2064 + j * 512 + lid * 8) = w; }
        }
      }
      { const int fr = lid & 15, fq = lid >> 4;
        f32x4 lacc = {0.f, 0.f, 0.f, 0.f};
#pragma unroll 8
        for (int sk = 0; sk < 32; ++sk) {
          const bf16x8 af = *(const LAS bf16x8*)(hb + (fr & 3) * 2064 + (32 * sk + 8 * fq) * 2);
          const bf16x8 bf = *(const LAS bf16x8*)(wl + fr * 2064 + (32 * sk + 8 * fq) * 2);
          lacc = __builtin_amdgcn_mfma_f32_16x16x32_bf16(af, bf, lacc, 0, 0, 0); }
        if (lid < 16) {
#pragma unroll
          for (int i = 0; i < 4; ++i) { const int m = m0 + i * NGW; if (m < SEQ) LR[(size_t)m * 16 + lid] = lacc[i]; } }
        asm volatile("s_waitcnt lgkmcnt(0)" ::: "memory"); }
    }
  }
  SEAM(0);

  if (IN(1)) {
    const auto& p = fresh_params(); unsigned char* ws = p.ws; FRESH_IDS
    pg8::Order S; S.nsub = 2; S.G = G; S.c = bx; S.K = DM;
    S.s0 = pg8::Sub{(const char*)(ws + WS_H), (const char*)(ws + WS_W1T), 64, 12, 1, 8};
    S.s1 = pg8::Sub{(const char*)(ws + WS_W1T) + (size_t)3072 * DM * 2, (const char*)(ws + WS_H), 8, 64, 1, 8};
    pg8::EpiBf16Two E{(bf16_t*)(ws + WS_QKZ), 3072, (bf16_t*)p.out, DINNER};
    pg8::gemm_phase<pg8::EpiBf16Two, true, true>(lds, S, E, wave_s, 1);
  }
  SEAM(1);

  if (IN(2)) {
    const auto& p = fresh_params(); unsigned char* ws = p.ws; FRESH_IDS
    LAS float* lrs = (LAS float*)lds;
    LAS float* tot = (LAS float*)(lds + 16384);
    bf16_t* QKZ = (bf16_t*)(ws + WS_QKZ); float* DCH = (float*)(ws + WS_DCH);
    const float* LR = (const float*)(ws + WS_LR);
    const bf16_t* VT = (const bf16_t*)p.out; bf16_t* P = (bf16_t*)(ws + WS_P);
    const int ch = tid & 127, seg = wave >> 1;
    for (int it = bx; it < NCH * GLA_H; it += G) {
      const int c = it >> 2, hd = it & 3, j = hd * 128 + ch;
      __syncthreads();
      { const f32x4* src = (const f32x4*)(LR + (size_t)c * GC * 16); LAS f32x4* dst = (LAS f32x4*)lrs; dst[tid] = src[tid]; dst[tid + 512] = src[tid + 512]; }
      float wg[16];
#pragma unroll
      for (int e = 0; e < 16; ++e) wg[e] = p.in[I_AWGU][e * GLA_DK + j];
      const float bias = p.in[I_ABG][j];
      __syncthreads();
      float cumv[64]; float cum = 0.f;
#pragma unroll
      for (int i = 0; i < 64; ++i) { const LAS f32x4* r4 = (const LAS f32x4*)(lrs + (seg * 64 + i) * 16); float pre = bias;
#pragma unroll
        for (int q = 0; q < 4; ++q) { const f32x4 v = r4[q]; pre += (v[0] * wg[4 * q] + v[1] * wg[4 * q + 1]) + (v[2] * wg[4 * q + 2] + v[3] * wg[4 * q + 3]); }
        const float ls = fminf(pre, 0.f) - 0.6931471805599453f * __builtin_amdgcn_logf(1.f + __builtin_amdgcn_exp2f(-LOG2E * fabsf(pre)));
        cum += ls * (1.f / 16.f); cumv[i] = cum; }
      tot[seg * 128 + ch] = cum;
      __syncthreads();
      float off = 0.f, total = 0.f;
#pragma unroll
      for (int s = 0; s < 4; ++s) { const float t = tot[s * 128 + ch]; total += t; if (s < seg) off += t; }
      const int t0 = c * GC + seg * 64;
      LAS unsigned char* til = lds + 67584;
      LAS unsigned char* kT = lds;
      const int srow = tid >> 4, sslot = tid & 15;
#pragma unroll 1
      for (int qk = 0; qk < 2; ++qk) {
        bf16_t* gt = QKZ + (size_t)(c * GC + srow) * 3072 + qk * 512 + hd * 128 + sslot * 8;
        { u32x4 tv[8];
#pragma unroll
          for (int i = 0; i < 8; ++i) tv[i] = *(const u32x4*)(gt + (size_t)i * 32 * 3072);
          __syncthreads();
#pragma unroll
          for (int i = 0; i < 8; ++i) *(LAS u32x4*)(til + (srow + 32 * i) * 256 + ((sslot ^ (srow & 15)) << 4)) = tv[i]; }
        __syncthreads();
        if (qk == 0) {
#pragma unroll
          for (int i = 0; i < 64; ++i) { LAS bf16_t* e = (LAS bf16_t*)(til + (seg * 64 + i) * 256 + ((((ch >> 3) ^ (i & 15)) << 4) | ((ch & 7) << 1))); const float B = off + cumv[i];
            *e = f2bf(bf2f(*e) * (__builtin_amdgcn_exp2f(LOG2E * B) * 0.08838834764831845f)); }
        } else {
#pragma unroll
          for (int i8 = 0; i8 < 8; ++i8) { float kk[8];
#pragma unroll
            for (int e8 = 0; e8 < 8; ++e8) { const int i = i8 * 8 + e8; LAS bf16_t* e = (LAS bf16_t*)(til + (seg * 64 + i) * 256 + ((((ch >> 3) ^ (i & 15)) << 4) | ((ch & 7) << 1))); const float B = off + cumv[i];
              const float kv = bf2f(*e) * __builtin_amdgcn_exp2f(fminf(-LOG2E * B, 115.f)); *e = f2bf(kv); kk[e8] = kv; }
            u32x4 w; w.x = pk2(kk[0], kk[1]); w.y = pk2(kk[2], kk[3]); w.z = pk2(kk[4], kk[5]); w.w = pk2(kk[6], kk[7]);
            *(LAS u32x4*)(kT + ch * 512 + (((seg * 8 + i8) ^ (ch & 15)) << 4)) = w; }
        }
        __syncthreads();
        if (qk == 0 || G != NCH * GLA_H) {
#pragma unroll
          for (int i = 0; i < 8; ++i) *(u32x4*)(gt + (size_t)i * 32 * 3072) = *(const LAS u32x4*)(til + (srow + 32 * i) * 256 + ((sslot ^ (srow & 15)) << 4)); }
      }
      if (seg == 0) DCH[c * GLA_DK + j] = __builtin_amdgcn_exp2f(LOG2E * total);
      { int tid3 = tid; asm volatile("" : "+v"(tid3));
        const int lane3 = tid3 & 63, fr = lane3 & 15, fq = lane3 >> 4;
        const bf16_t* vpn = VT + ((size_t)(c * 8) * DINNER + hd * 512 + 64 * wave + fr) * 32 + 8 * fq;
        f32x4 pacc[8][4];
#pragma unroll
        for (int a = 0; a < 8; ++a)
#pragma unroll
          for (int b = 0; b < 4; ++b) pacc[a][b] = (f32x4){0.f, 0.f, 0.f, 0.f};
        bf16x8 vb0[4], vb1[4];
#define P3_BFETCH(DST, KB) do { _Pragma("unroll") for (int nt_ = 0; nt_ < 4; ++nt_) DST[nt_] = *(const bf16x8*)(vpn + (size_t)(KB) * DINNER * 32 + nt_ * 16 * 32); } while (0)
#define P3_STEP(SRC, KB) do { _Pragma("unroll") for (int hf_ = 0; hf_ < 2; ++hf_) { bf16x8 ka_[4]; \
          _Pragma("unroll") for (int m_ = 0; m_ < 4; ++m_) ka_[m_] = *(const LAS bf16x8*)(kT + (16 * (4 * hf_ + m_) + fr) * 512 + (((4 * (KB) + fq) ^ fr) << 4)); \
          _Pragma("unroll") for (int m_ = 0; m_ < 4; ++m_) _Pragma("unroll") for (int nt_ = 0; nt_ < 4; ++nt_) \
            pacc[4 * hf_ + m_][nt_] = __builtin_amdgcn_mfma_f32_16x16x32_bf16(ka_[m_], SRC[nt_], pacc[4 * hf_ + m_][nt_], 0, 0, 0); } } while (0)
        P3_BFETCH(vb0, 0); P3_BFETCH(vb1, 1);
#pragma unroll
        for (int kb = 0; kb < 8; kb += 2) {
          P3_STEP(vb0, kb);
          __builtin_amdgcn_sched_barrier(0);
          if (kb + 2 < 8) P3_BFETCH(vb0, kb + 2);
          __builtin_amdgcn_sched_barrier(0);
          P3_STEP(vb1, kb + 1);
          __builtin_amdgcn_sched_barrier(0);
          if (kb + 3 < 8) P3_BFETCH(vb1, kb + 3);
          __builtin_amdgcn_sched_barrier(0);
        }
#undef P3_BFETCH
#undef P3_STEP
        bf16_t* po = P + ((size_t)(c * 4 + hd) * 512 + 64 * wave + fr) * 128 + ((fq & 1) ? 16 : 0) + 8 * (fq >> 1);
#pragma unroll
        for (int nt = 0; nt < 4; ++nt)
#pragma unroll
          for (int mq = 0; mq < 4; ++mq) { float v[8];
#pragma unroll
            for (int i = 0; i < 4; ++i) { const u32x2 r = __builtin_amdgcn_permlane16_swap(__float_as_uint(pacc[2 * mq][nt][i]), __float_as_uint(pacc[2 * mq + 1][nt][i]), false, false);
              v[i] = __uint_as_float(r[0]); v[4 + i] = __uint_as_float(r[1]); }
            u32x4 w; w.x = pk2(v[0], v[1]); w.y = pk2(v[2], v[3]); w.z = pk2(v[4], v[5]); w.w = pk2(v[6], v[7]);
            *(u32x4*)(po + (size_t)nt * 16 * 128 + 32 * mq) = w; } }
    }
  }
  SEAM(3);

  if (IN(4)) {
    const auto& p = fresh_params(); unsigned char* ws = p.ws; FRESH_IDS
    const unsigned* P = (const unsigned*)(ws + WS_P); const float* DCH = (const float*)(ws + WS_DCH); unsigned* SB = (unsigned*)(ws + WS_H);
    for (int idx = bx * 512 + tid; idx < 131072; idx += G * 512) {
      const int e = idx * 2, k = e & 127, hd = e >> 16;
      float s0 = 0.f, s1 = 0.f;
#pragma unroll 8
      for (int c = 0; c < NCH; ++c) { const unsigned pw = P[(size_t)c * 131072 + idx]; const f32x2 pv = {bf_lo(pw), bf_hi(pw)}; const f32x2 dv = *(const f32x2*)(DCH + c * GLA_DK + hd * 128 + k);
        SB[(size_t)c * 131072 + idx] = pk2(s0, s1); s0 = dv[0] * (s0 + pv[0]); s1 = dv[1] * (s1 + pv[1]); }
    }
  }
  SEAM(4);

  if (IN(5)) {
    const auto& p = fresh_params(); unsigned char* ws = p.ws; FRESH_IDS
    const bf16_t* QKZ = (const bf16_t*)(ws + WS_QKZ); const bf16_t* VT = (const bf16_t*)p.out; const bf16_t* SB = (const bf16_t*)(ws + WS_H);
    bf16_t* OG = (bf16_t*)(ws + WS_P); const float* gout = p.in[I_AGOUT];
    LAS unsigned char* qs = lds;
    LAS unsigned char* ablk = lds + 16384;
    LAS unsigned char* ksl = lds + 67584;
    LAS float* red = (LAS float*)(lds + 133120);
    const bool kpersist = (G == NCH * GLA_H);
    const int ipw5 = (NCH * 16 + G - 1) / G, it5a = bx * ipw5, it5b = (it5a + ipw5 < NCH * 16) ? it5a + ipw5 : NCH * 16;
    u32x4 tq2n[2];
#define P5_QLOAD(IT) do { int tdl_ = tid; asm volatile("" : "+v"(tdl_)); const int c_ = (IT) >> 4, hd_ = ((IT) >> 2) & 3, ts_ = (IT) & 3; \
      const bf16_t* qg_ = QKZ + (size_t)(c_ * GC + ts_ * 64 + (tdl_ >> 4)) * 3072 + hd_ * 128 + (tdl_ & 15) * 8; \
      tq2n[0] = *(const u32x4*)qg_; tq2n[1] = *(const u32x4*)(qg_ + (size_t)32 * 3072); } while (0)
    if (it5a < it5b) P5_QLOAD(it5a); else { tq2n[0] = (u32x4){0u, 0u, 0u, 0u}; tq2n[1] = (u32x4){0u, 0u, 0u, 0u}; }
    for (int it = it5a; it < it5b; ++it) {
      const int c = it >> 4, hd = (it >> 2) & 3, ts = it & 3;
      const int t0 = c * GC + ts * 64, ns = (ts + 1) * 64, ntiles = 4 * (ts + 1);
      int tid5 = tid; asm volatile("" : "+v"(tid5));
      const int lane5 = tid5 & 63, r = lane5 & 31, h = lane5 >> 5, fr = lane5 & 15, fq = lane5 >> 4;
      const int srow = tid5 >> 4, sslot = tid5 & 15, sl0 = srow * 256 + ((sslot ^ (srow & 15)) << 4);
      const bf16_t* spn = SB + ((size_t)(c * 4 + hd) * 512 + 64 * wave + fr) * 128 + 8 * fq;
      const bf16_t* vpn = VT + ((size_t)(c * 8) * DINNER + hd * 512 + 64 * wave + fr) * 32 + 8 * fq;
      bf16x8 ring[4][4];
#define P5_AFETCH(SLOT, S) do { if ((S) < 4) { _Pragma("unroll") for (int nt_ = 0; nt_ < 4; ++nt_) ring[SLOT][nt_] = *(const bf16x8*)(spn + nt_ * 16 * 128 + 32 * (S)); } \
        else { _Pragma("unroll") for (int nt_ = 0; nt_ < 4; ++nt_) ring[SLOT][nt_] = *(const bf16x8*)(vpn + (size_t)((S) - 4) * DINNER * 32 + nt_ * 16 * 32); } } while (0)
      P5_AFETCH(0, 0); P5_AFETCH(1, 1); P5_AFETCH(2, 2); P5_AFETCH(3, 3);
      __builtin_amdgcn_sched_barrier(0);
      { u32x4 tq2[2], tk[8];
        const bf16_t* qg = QKZ + (size_t)(t0 + srow) * 3072 + hd * 128 + sslot * 8; const bf16_t* kg = QKZ + (size_t)(c * GC + srow) * 3072 + 512 + hd * 128 + sslot * 8;
#pragma unroll
        for (int i = 0; i < 2; ++i) tq2[i] = tq2n[i];
        (void)qg;
#pragma unroll
        for (int i = 0; i < 8; ++i) { if (!kpersist && 32 * i < ns) tk[i] = *(const u32x4*)(kg + (size_t)i * 32 * 3072); else tk[i] = (u32x4){0u, 0u, 0u, 0u}; }
#pragma unroll
        for (int i = 0; i < 2; ++i) *(LAS u32x4*)(qs + sl0 + i * 8192) = tq2[i];
#pragma unroll
        for (int i = 0; i < 8; ++i) if (!kpersist && 32 * i < ns) *(LAS u32x4*)(ksl + sl0 + i * 8192) = tk[i]; }
      __syncthreads();
#pragma unroll
      for (int rep = 0; rep < 2; ++rep) { const int ti = wave + 8 * rep;
        if (ti < ntiles) { const int st = ti >> 1, tt = ti & 1;
          const LAS unsigned char* ar = ksl + (32 * st + r) * 256; const LAS unsigned char* br = qs + (32 * tt + r) * 256;
          f32x16 acc;
#pragma unroll
          for (int i = 0; i < 16; ++i) acc[i] = 0.f;
#pragma unroll
          for (int ks = 0; ks < 8; ++ks) { const int so = (((2 * ks + h) ^ (r & 15)) << 4); acc = MFMA32(*(const LAS bf16x8*)(ar + so), *(const LAS bf16x8*)(br + so), acc); }
          const int tl = ts * 64 + 32 * tt + r;
#pragma unroll
          for (int i4 = 0; i4 < 4; ++i4) { float v[4];
#pragma unroll
            for (int e = 0; e < 4; ++e) { const int sl = 32 * st + 8 * i4 + 4 * h + e; v[e] = (sl <= tl) ? acc[4 * i4 + e] : 0.f; }
            u32x2 w; w.x = pk2(v[0], v[1]); w.y = pk2(v[2], v[3]);
            *(LAS u32x2*)(ablk + (32 * tt + r) * 528 + (32 * st + 8 * i4 + 4 * h) * 2) = w; } } }
      __syncthreads();
      f32x4 acc[4][4];
#pragma unroll
      for (int a = 0; a < 4; ++a)
#pragma unroll
        for (int b = 0; b < 4; ++b) acc[a][b] = (f32x4){0.f, 0.f, 0.f, 0.f};
      const int nk = 4 + 2 * (ts + 1);
#pragma unroll
      for (int sk = 0; sk < 12; ++sk) {
        if (sk < nk) {
          bf16x8 bfr[4];
          if (sk < 4) { _Pragma("unroll") for (int tt = 0; tt < 4; ++tt) bfr[tt] = *(const LAS bf16x8*)(qs + (16 * tt + fr) * 256 + (((4 * sk + fq) ^ fr) << 4)); }
          else { _Pragma("unroll") for (int tt = 0; tt < 4; ++tt) bfr[tt] = *(const LAS bf16x8*)(ablk + (16 * tt + fr) * 528 + (32 * (sk - 4) + 8 * fq) * 2); }
#pragma unroll
          for (int nt = 0; nt < 4; ++nt)
#pragma unroll
            for (int tt = 0; tt < 4; ++tt) acc[nt][tt] = __builtin_amdgcn_mfma_f32_16x16x32_bf16(ring[sk & 3][nt], bfr[tt], acc[nt][tt], 0, 0, 0);
          __builtin_amdgcn_sched_barrier(0);
          if (sk + 4 < nk) P5_AFETCH(sk & 3, sk + 4);
          __builtin_amdgcn_sched_barrier(0);
        }
      }
#undef P5_AFETCH
      const int nL = 64 * wave + ((fq & 1) ? 16 : 0) + 8 * (fq >> 1);
      u32x4 zz[4][2];
#pragma unroll
      for (int tt = 0; tt < 4; ++tt)
#pragma unroll
        for (int pp = 0; pp < 2; ++pp) zz[tt][pp] = *(const u32x4*)(QKZ + (size_t)(t0 + 16 * tt + fr) * 3072 + 1024 + hd * 512 + nL + 32 * pp);
      __builtin_amdgcn_sched_barrier(0);
      if (it + 1 < it5b) P5_QLOAD(it + 1);
      __builtin_amdgcn_sched_barrier(0);
#pragma unroll
      for (int tt = 0; tt < 4; ++tt) { float sq = 0.f;
#pragma unroll
        for (int nt = 0; nt < 4; ++nt)
#pragma unroll
          for (int i = 0; i < 4; ++i) sq += acc[nt][tt][i] * acc[nt][tt][i];
        sq = xh_sum(x16_sum(sq));
        if (fq == 0) red[wave * 64 + 16 * tt + fr] = sq; }
      __syncthreads();
      float rst[4];
#pragma unroll
      for (int tt = 0; tt < 4; ++tt) { float sq = 0.f;
#pragma unroll
        for (int w = 0; w < 8; ++w) sq += red[w * 64 + 16 * tt + fr];
        rst[tt] = rsqrtf(sq * (1.f / GLA_DVH) + RMS_EPS); }
      f32x4 gg[2][2];
#pragma unroll
      for (int pp = 0; pp < 2; ++pp) { gg[pp][0] = *(const f32x4*)(gout + nL + 32 * pp); gg[pp][1] = *(const f32x4*)(gout + nL + 32 * pp + 4); }
#pragma unroll
      for (int tt = 0; tt < 4; ++tt)
#pragma unroll
        for (int pp = 0; pp < 2; ++pp) {
          float v[8];
#pragma unroll
          for (int i = 0; i < 4; ++i) { const u32x2 r = __builtin_amdgcn_permlane16_swap(__float_as_uint(acc[2 * pp][tt][i]), __float_as_uint(acc[2 * pp + 1][tt][i]), false, false);
            v[i] = __uint_as_float(r[0]); v[4 + i] = __uint_as_float(r[1]); }
          const u32x4 zq = zz[tt][pp];
          const float z[8] = {bf_lo(zq.x), bf_hi(zq.x), bf_lo(zq.y), bf_hi(zq.y), bf_lo(zq.z), bf_hi(zq.z), bf_lo(zq.w), bf_hi(zq.w)};
          float o[8];
#pragma unroll
          for (int e = 0; e < 8; ++e) o[e] = v[e] * rst[tt] * (e < 4 ? gg[pp][0][e] : gg[pp][1][e - 4]) * z[e] * __builtin_amdgcn_rcpf(1.f + __builtin_amdgcn_exp2f(-LOG2E * z[e]));
          u32x4 w4; w4.x = pk2(o[0], o[1]); w4.y = pk2(o[2], o[3]); w4.z = pk2(o[4], o[5]); w4.w = pk2(o[6], o[7]);
          *(u32x4*)(OG + (size_t)(t0 + 16 * tt + fr) * DINNER + hd * 512 + nL + 32 * pp) = w4;
          __builtin_amdgcn_sched_barrier(0); }
    }
#undef P5_QLOAD
    __syncthreads();
    convert_chunk_weights(p.in[I_BWIN], p.in[I_WKV], p.in[I_BNORM], p.in[I_KVNORM], (bf16_t*)(ws + WS_WC), 0, 0, 2048, (LAS float*)(lds + wave * 8448), gw, NGW, lane);
    for (int it = gw; it < 1024; it += NGW) transpose_item(p.in[I_AWOUT], DM, 0, nullptr, 1.f, (bf16_t*)(ws + WS_WOT), DINNER, 0, (LAS float*)(lds + wave * 8448), it >> 5, it & 31, lane);
  }
  SEAM(5);

  if (IN(6)) {
    const auto& p = fresh_params(); unsigned char* ws = p.ws; FRESH_IDS
    pg8::Order S; S.nsub = 1; S.G = G; S.c = bx; S.K = DINNER;
    S.s0 = pg8::Sub{(const char*)(ws + WS_P), (const char*)(ws + WS_WOT), 64, 4, 1, 8}; S.s1 = S.s0;
    pg8::EpiResidual<false> E{(const void*)p.in[I_X], (bf16_t*)(ws + WS_H), (float*)(ws + WS_SSQ)};
    pg8::gemm_phase<pg8::EpiResidual<false>, false, true>(lds, S, E, wave_s, 1);
  }
  SEAM(6);

#pragma unroll 1
  for (int ci = 0; ci < 4; ++ci) {
    const int phG = 7 + 2 * ci, phA = 8 + 2 * ci;
#define CHUNK_IDS int ci_l = ci; asm volatile("" : "+s"(ci_l)); const int g = ci_l < 2 ? ci_l : 2, hbase = ci_l == 3 ? 8 : 0, cwsh = ci_l < 2 ? 11 : 10, cw = 1 << cwsh, dil = 1 << (2 * g), L = SEQ >> (2 * g); \
      const size_t qkstride = ci_l < 2 ? ((size_t)32 << 20) : ((size_t)16 << 20); (void)hbase; (void)L; (void)cw; (void)qkstride;
    if (IN(phG)) {
      const auto& p = fresh_params(); unsigned char* ws = p.ws; FRESH_IDS CHUNK_IDS
      { pg8::Order S; S.nsub = 2; S.G = G; S.c = bx; S.K = DM;
        const int tpb = cw >> 8, nN = (g == 2) ? 3 * tpb : 2 * tpb;
        S.s0 = pg8::Sub{(const char*)(ws + WS_H), (const char*)(ws + WS_WC), 64, nN, 1, 8};
        S.s1 = pg8::Sub{(const char*)(ws + WS_WC) + (size_t)nN * 256 * DM * 2, (const char*)(ws + WS_H), tpb, 64, dil, 6 - 2 * g};
        LAS float* rtab = (LAS float*)(lds + 131072); bool use_tab = false;
        { pg8::Unit u_; int nu = 0; while (nu < 16 && S.next(nu, u_)) ++nu;
          use_tab = nu <= 15;
          if (use_tab) {
            const float* ssqp = (const float*)(ws + WS_SSQ); const int tprsh_ = 6 - 2 * g;
            for (int e = tid; e < nu * 256; e += 512) { const int i_ = e >> 8, r_ = e & 255; (void)S.next(i_, u_);
              int row;
              if (!u_.sub) row = u_.pm * 256 + r_;
              else { const int cc = (u_.pn & ((1 << tprsh_) - 1)) * 256 + r_; row = (u_.pn >> tprsh_) + dil * ((cc & ~15) | pg8::p16(cc & 15)); }
              const f32x4 sq = *(const f32x4*)(ssqp + (size_t)row * 4);
              rtab[e] = rsqrtf(((sq[0] + sq[1]) + (sq[2] + sq[3])) * (1.0f / DM) + RMS_EPS); }
            __syncthreads(); } }
        pg8::EpiChunk E{pg8::EpiRowScale3{(bf16_t*)(ws + WS_QC), (const float*)(ws + WS_SSQ), cw, cwsh - 8, qkstride, 2 * g, use_tab ? rtab : (const LAS float*)nullptr}, pg8::EpiColScale{(bf16_t*)(ws + WS_VTC), (const float*)(ws + WS_SSQ), dil, 6 - 2 * g, cw, use_tab ? rtab : (const LAS float*)nullptr}};
        pg8::gemm_phase<pg8::EpiChunk, true, true>(lds, S, E, wave_s, 1, 0, dil, 1); }
    }
    SEAM(phG);
    if (IN(phA)) {
      const auto& p = fresh_params(); unsigned char* ws = p.ws; FRESH_IDS CHUNK_IDS
      const bf16_t* QC = (const bf16_t*)(ws + WS_QC); const bf16_t* KC = QC + qkstride; const bf16_t* ZC = QC + 2 * qkstride; const bf16_t* VTC = (const bf16_t*)(ws + WS_VTC);
      bf16_t* ORUN = (bf16_t*)p.out; float* LSE = (float*)(ws + WS_LSE);
      int tid_a = tid; asm volatile("" : "+v"(tid_a));
      const int lane_a = tid_a & 63, q = lane_a & 31, h = lane_a >> 5;
      const int bprsh = 6 - 2 * g;
      const int nitems = cw >> 1, ipc = att_ipc << (cwsh - 10);
      const int i0 = bx * ipc, i1 = (i0 + ipc < nitems) ? i0 + ipc : nitems;
      const int krow0 = tid_a >> 4, kslot = tid_a & 15;
      const int klds0 = krow0 * 256 + ((kslot ^ (krow0 & 15)) << 4);
      const int vrow0 = tid_a >> 2, vslot = tid_a & 3, vlds0 = vrow0 * 784 + vslot * 16;
#define ATT_LOADK(IT) do { const int hl_ = (IT) >> 6, rem_ = (IT) & 63, rr_ = rem_ >> bprsh, jb_ = rem_ & ((1 << bprsh) - 1), kb0_ = 256 * jb_ - 128; \
        const bf16_t* kp_ = KC + ((((long)hl_ << 14) + (long)rr_ * L + kb0_ + krow0) << 7) + kslot * 8; const long kst_ = 32 << 7; \
        _Pragma("unroll") for (int i_ = 0; i_ < 12; ++i_) { if (kb0_ + 32 * i_ >= 0) stg[i_] = *(const u32x4*)(kp_ + i_ * kst_); else stg[i_] = (u32x4){0u, 0u, 0u, 0u}; } } while (0)
#define ATT_STOREK() do { _Pragma("unroll") for (int i_ = 0; i_ < 12; ++i_) *(LAS u32x4*)(lds + klds0 + i_ * 8192) = stg[i_]; } while (0)
#define ATT_LOADV(IT) do { const int hl_ = (IT) >> 6, rem_ = (IT) & 63, rr_ = rem_ >> bprsh, jb_ = rem_ & ((1 << bprsh) - 1), kb0_ = 256 * jb_ - 128; \
        const bf16_t* vp_ = VTC + (((long)(((long)rr_ * L + kb0_) >> 5) << cwsh) + hl_ * 128 + vrow0) * 32 + vslot * 8;     \
        _Pragma("unroll") for (int i_ = 0; i_ < 12; ++i_) { if (kb0_ + 32 * i_ >= 0) stg[i_] = *(const u32x4*)(vp_ + (((long)i_ * 32) << cwsh)); else stg[i_] = (u32x4){0u, 0u, 0u, 0u}; } } while (0)
#define ATT_STOREV() do { _Pragma("unroll") for (int i_ = 0; i_ < 12; ++i_) *(LAS u32x4*)(lds + vlds0 + i_ * 64) = stg[i_]; } while (0)
      if (i0 < i1) { u32x4 stg[12]; __syncthreads(); ATT_LOADK(i0); ATT_STOREK(); }
#pragma unroll 1
      for (int it = i0; it < i1; ++it) {
        u32x4 stg[12];
        const int hl = it >> 6, rem = it & 63, rr = rem >> bprsh, jblk = rem & ((1 << bprsh) - 1);
        const int hd = hbase + hl;
        const float slope2 = __builtin_amdgcn_exp2f((float)(g * 16 + hd + 1) * (-8.f / 48.f)) * (float)dil * LOG2E;
        const int jq = 256 * jblk + 32 * wave + q, tq = rr + dil * jq;
        const int kbw = 256 * jblk + 32 * wave - 128;
        int dbase = q + 128 - 4 * h; asm volatile("" : "+v"(dbase));
        bf16x8 qf[8];
        { const bf16_t* qp = QC + ((((size_t)hl << 14) + (size_t)rr * L + jq) << 7) + 8 * h;
#pragma unroll
          for (int s = 0; s < 8; ++s) qf[s] = *(const bf16x8*)(qp + 16 * s); }
        __syncthreads();
        f32x16 S5[5];
        float mx = -1e30f;
#pragma unroll
        for (int kt = 0; kt < 5; ++kt) {
          const int kb = kbw + 32 * kt;
#pragma unroll
          for (int i = 0; i < 16; ++i) S5[kt][i] = 0.f;
          if (kb >= 0) {
            const LAS unsigned char* kr = lds + (32 * wave + 32 * kt + q) * 256;
#pragma unroll
            for (int s = 0; s < 8; ++s) { const bf16x8 kf = *(const LAS bf16x8*)(kr + (((2 * s + h) ^ (q & 15)) << 4)); S5[kt] = MFMA32(kf, qf[s], S5[kt]); }
#pragma unroll
            for (int i = 0; i < 16; ++i) { const int cki = 32 * kt + (i & 3) + 8 * (i >> 2); const int delta = dbase - cki;
              const bool valid = (kt == 0) ? (delta <= 128) : ((kt == 4) ? (delta >= 0) : true);
              const float v = valid ? fmaf(slope2, (float)cki, S5[kt][i]) : -1e30f; S5[kt][i] = v; mx = fmaxf(mx, v); }
          } else {
#pragma unroll
            for (int i = 0; i < 16; ++i) S5[kt][i] = -1e30f;
          }
          __builtin_amdgcn_sched_barrier(0);
        }
        const float hb = slope2 * (float)(4 * h);
        mx += hb; mx = xh_max(mx);
        const float mxa = mx - hb;
        __builtin_amdgcn_sched_barrier(0);
        ATT_LOADV(it);
        __builtin_amdgcn_sched_barrier(0);
        float lsum = 0.f;
        bf16x8 pf[5][2];
#pragma unroll
        for (int kt = 0; kt < 5; ++kt) {
#pragma unroll
          for (int i = 0; i < 16; ++i) { const float pv = __builtin_amdgcn_exp2f(S5[kt][i] - mxa); S5[kt][i] = pv; lsum += pv; }
#pragma unroll
          for (int s2 = 0; s2 < 2; ++s2) { u32x4 w; w.x = pk2(S5[kt][8 * s2], S5[kt][8 * s2 + 1]); w.y = pk2(S5[kt][8 * s2 + 2], S5[kt][8 * s2 + 3]); w.z = pk2(S5[kt][8 * s2 + 4], S5[kt][8 * s2 + 5]); w.w = pk2(S5[kt][8 * s2 + 6], S5[kt][8 * s2 + 7]);
            pf[kt][s2] = __builtin_bit_cast(bf16x8, w); }
          __builtin_amdgcn_sched_barrier(0);
        }
        const float ltot = xh_sum(lsum);
        __syncthreads();
        ATT_STOREV();
        __syncthreads();
        int le = lane_a; asm volatile("" : "+v"(le));
        const int c8 = le & 15, r4 = le >> 4;
        u32x4 ovv[8], zzv[8];
#pragma unroll
        for (int k = 0; k < 8; ++k) { ovv[k] = (u32x4){0u, 0u, 0u, 0u}; zzv[k] = (u32x4){0u, 0u, 0u, 0u}; }
        const int tok0 = rr + dil * (256 * jblk + 32 * wave + r4);
        bf16_t* op0 = ORUN + (size_t)tok0 * DINNER + hd * 128 + c8 * 8; const bf16_t* zp0 = ZC + (size_t)tok0 * 1024 + hl * 128 + c8 * 8;
        const long ostep = (long)dil * 4 * DINNER, zstep = (long)dil * 4 * 1024;
#pragma unroll
        for (int k = 0; k < 8; ++k) { if (g > 0) ovv[k] = *(const u32x4*)(op0 + k * ostep); }
        __builtin_amdgcn_sched_barrier(0);
        f32x16 O[4];
#pragma unroll
        for (int ct = 0; ct < 4; ++ct)
#pragma unroll
          for (int i = 0; i < 16; ++i) O[ct][i] = 0.f;
#pragma unroll
        for (int kt = 0; kt < 5; ++kt) {
          if (kbw + 32 * kt >= 0) {
#pragma unroll
            for (int s2 = 0; s2 < 2; ++s2) { const int ks = 2 * wave + 2 * kt + s2;
#pragma unroll
              for (int ct = 0; ct < 4; ++ct) { const bf16x8 vf = *(const LAS bf16x8*)(lds + (32 * ct + q) * 784 + (16 * ks + 8 * h) * 2); O[ct] = MFMA32(vf, pf[kt][s2], O[ct]); }
              __builtin_amdgcn_sched_barrier(0); }
          }
        }
        const float inv = __builtin_amdgcn_rcpf(ltot); float lse2 = (mx - slope2 * (float)(dbase + 4 * h)) + __builtin_amdgcn_logf(ltot);
        float wo = 0.f, wn = inv;
        float* lsep = LSE + (size_t)tq * 16 + hd;
        if (g > 0) { const float lold = *lsep; const float mm = fmaxf(lold, lse2); const float eo = __builtin_amdgcn_exp2f(lold - mm), en = __builtin_amdgcn_exp2f(lse2 - mm), den = eo + en, rden = __builtin_amdgcn_rcpf(den);
          wo = eo * rden; wn = en * rden * inv; lse2 = mm + __builtin_amdgcn_logf(den); }
        if (g < 2 && h == 0) *lsep = lse2;
#pragma unroll
        for (int k = 0; k < 8; ++k) { if (g == 2) zzv[k] = *(const u32x4*)(zp0 + k * zstep); }
        __builtin_amdgcn_sched_barrier(0);
        __syncthreads();
        { LAS unsigned char* ow = lds + wave * 16896;
          LAS float* wov = (LAS float*)(lds + 135168 + wave * 128);
#pragma unroll
          for (int ct = 0; ct < 4; ++ct)
#pragma unroll
            for (int i4 = 0; i4 < 4; ++i4) *(LAS f32x4*)(ow + q * 528 + (32 * ct + 8 * i4 + 4 * h) * 4) = (f32x4){O[ct][4 * i4] * wn, O[ct][4 * i4 + 1] * wn, O[ct][4 * i4 + 2] * wn, O[ct][4 * i4 + 3] * wn};
          if (h == 0) wov[q] = wo;
          LDS_WAIT();
          __builtin_amdgcn_sched_barrier(0);
          if (it + 1 < i1) ATT_LOADK(it + 1);
          else {
#pragma unroll
            for (int i = 0; i < 12; ++i) stg[i] = (u32x4){0u, 0u, 0u, 0u}; }
          __builtin_amdgcn_sched_barrier(0);
#pragma unroll
          for (int k = 0; k < 8; ++k) { const int row = 4 * k + r4;
            const f32x4 a = *(const LAS f32x4*)(ow + row * 528 + c8 * 32), b = *(const LAS f32x4*)(ow + row * 528 + c8 * 32 + 16);
            float o[8] = {a[0], a[1], a[2], a[3], b[0], b[1], b[2], b[3]};
            if (g > 0) { const float w = wov[row]; const u32x4 ov = ovv[k];
              o[0] += w * bf_lo(ov.x); o[1] += w * bf_hi(ov.x); o[2] += w * bf_lo(ov.y); o[3] += w * bf_hi(ov.y); o[4] += w * bf_lo(ov.z); o[5] += w * bf_hi(ov.z); o[6] += w * bf_lo(ov.w); o[7] += w * bf_hi(ov.w); }
            if (g == 2) { const u32x4 zz = zzv[k];
              const float z[8] = {bf_lo(zz.x), bf_hi(zz.x), bf_lo(zz.y), bf_hi(zz.y), bf_lo(zz.z), bf_hi(zz.z), bf_lo(zz.w), bf_hi(zz.w)};
#pragma unroll
              for (int e = 0; e < 8; ++e) o[e] *= z[e] * __builtin_amdgcn_rcpf(1.f + __builtin_amdgcn_exp2f(-LOG2E * z[e])); }
            u32x4 w4; w4.x = pk2(o[0], o[1]); w4.y = pk2(o[2], o[3]); w4.z = pk2(o[4], o[5]); w4.w = pk2(o[6], o[7]);
            *(u32x4*)(op0 + k * ostep) = w4; } }
        __syncthreads();
        if (it + 1 < i1) ATT_STOREK();
      }
      __syncthreads();
#undef ATT_LOADK
#undef ATT_STOREK
#undef ATT_LOADV
#undef ATT_STOREV
      if (ci_l == 3) { for (int it = gw; it < 1024; it += NGW) transpose_item(p.in[I_BWOUT], DM, 0, nullptr, 1.f, (bf16_t*)(ws + WS_WO2T), DINNER, 0, (LAS float*)(lds + wave * 8448), it >> 5, it & 31, lane); }
      if (ci_l < 3) { const int n_ = ci_l + 1; convert_chunk_weights(p.in[I_BWIN], p.in[I_WKV], p.in[I_BNORM], p.in[I_KVNORM], (bf16_t*)(ws + WS_WC), n_ < 2 ? n_ : 2, n_ == 3 ? 8 : 0, n_ < 2 ? 2048 : 1024, (LAS float*)(lds + wave * 8448), gw, NGW, lane); }
    }
    SEAM(phA);
  }

  if (IN(15)) {
    const auto& p = fresh_params(); unsigned char* ws = p.ws; FRESH_IDS
    pg8::Order S; S.nsub = 1; S.G = G; S.c = bx; S.K = DINNER;
    S.s0 = pg8::Sub{(const char*)p.out, (const char*)(ws + WS_WO2T), 64, 4, 1, 8}; S.s1 = S.s0;
    pg8::EpiFinal E{(const bf16_t*)(ws + WS_H), p.out, p.in[I_FNORM], (float*)(ws + WS_SSQ), (unsigned*)(ws + WS_CTL + 16384)};
    pg8::gemm_phase<pg8::EpiFinal, false, true>(lds, S, E, wave_s, 1);
  }
#undef IN
#undef SEAM
}

extern "C" void kernel_launch(void* const* d_in, const int* in_sizes, int n_in, void* d_out, int out_size, void* d_ws, size_t ws_size, hipStream_t stream) {
  static int grid = 0;
  if (grid == 0) {
    int dev = 0, cus = 0, per_cu = 0;
    if (n_in != 13 || out_size != SEQ * DM || ws_size < 256 * MiB) { fprintf(stderr, "kernel_launch: unexpected problem (n_in %d out %d ws %zu)\n", n_in, out_size, ws_size); grid = -1; return; }
    (void)hipGetDevice(&dev); (void)hipDeviceGetAttribute(&cus, hipDeviceAttributeMultiprocessorCount, dev);
    if (hipFuncSetAttribute((const void*)yoco_fwd, hipFuncAttributeMaxDynamicSharedMemorySize, LDS_BYTES) != hipSuccess) { fprintf(stderr, "kernel_launch: hipFuncSetAttribute failed\n"); grid = -1; return; }
    if (hipOccupancyMaxActiveBlocksPerMultiprocessor(&per_cu, (const void*)yoco_fwd, 512, LDS_BYTES) != hipSuccess || per_cu < 1) { fprintf(stderr, "kernel_launch: occupancy query says %d\n", per_cu); (void)hipGetLastError(); }
    grid = cus;
    if (grid != 256) fprintf(stderr, "kernel_launch: %d CUs; the residual GEMM epilogues assume 256\n", grid);
  }
  if (grid < 0) return;
  if (hipMemsetAsync((char*)d_ws + WS_CTL, 0, 32768, stream) != hipSuccess) { fprintf(stderr, "kernel_launch: memset of barrier words failed\n"); return; }
  Params p{};
  for (int i = 0; i < 13; ++i) p.in[i] = (const float*)d_in[i];
  p.out = (float*)d_out; p.ws = (unsigned char*)d_ws; p.ph_lo = 0; p.ph_hi = NPHASE;
  void* args[] = {&p};
  hipError_t e = hipLaunchCooperativeKernel((void*)yoco_fwd, dim3(grid), dim3(512), args, LDS_BYTES, stream);
  if (e != hipSuccess) fprintf(stderr, "cooperative launch failed: %s (grid %d)\n", hipGetErrorString(e), grid);
}
```
